# Optimizing an MI355X kernel written in HIP

```python
import jax, jax.numpy as jnp
from jax import lax
import numpy as np

D_MODEL = 2048
BATCH = 1
SEQ = 8192
DEPTH = 1
DEC_BATCH = 128
DEC_SEQ = 4
PAST_LEN = 8192
PAGE_SIZE = 128

N_HEADS = 32
HEAD_DIM = 64
N_KV_HEADS = 4
GROUP = N_HEADS // N_KV_HEADS
D_ATTN = N_HEADS * HEAD_DIM
D_KV = N_KV_HEADS * HEAD_DIM
WINDOW = 128
BLOCK = WINDOW
D_CONV = D_MODEL
CONV_WIDTH = 3
D_FF = -(-8 * D_MODEL // (3 * 256)) * 256
ROPE_THETA = 10000.0
EPS = 1e-6
NEG_INF = -1e30
SPLIT_SIZES = (D_ATTN, D_KV, D_KV, D_CONV, D_CONV, D_CONV, D_ATTN, D_CONV)
D_IN = sum(SPLIT_SIZES)

kernel_name = 'hybrid_shortconv_swa_sink_decoder_step'


def _rms_norm(x, g):
    x32 = x.astype(jnp.float32)
    y = x32 * lax.rsqrt(jnp.mean(x32 * x32, axis=-1, keepdims=True) + EPS)
    return (y * g.astype(jnp.float32)).astype(x.dtype)


def _rope(x, pos):
    inv = ROPE_THETA ** (-jnp.arange(0, HEAD_DIM, 2, dtype=jnp.float32) / HEAD_DIM)
    ang = pos.astype(jnp.float32)[:, None] * inv[None, :]
    cos = jnp.cos(ang)[:, None, :]
    sin = jnp.sin(ang)[:, None, :]
    x32 = x.astype(jnp.float32)
    x1, x2 = x32[..., : HEAD_DIM // 2], x32[..., HEAD_DIM // 2:]
    return jnp.concatenate([x1 * cos - x2 * sin, x2 * cos + x1 * sin], axis=-1).astype(x.dtype)


def _project(x, norm_g, w_in, q_g, k_g, pos):
    xn = _rms_norm(x, norm_g)
    z = xn @ w_in
    idx = [int(i) for i in np.cumsum(SPLIT_SIZES)[:-1]]
    q, k, v, h, b, c, ga, gc = jnp.split(z, idx, axis=-1)
    lead = x.shape[:-1]
    q = q.reshape(*lead, N_HEADS, HEAD_DIM)
    k = k.reshape(*lead, N_KV_HEADS, HEAD_DIM)
    v = v.reshape(*lead, N_KV_HEADS, HEAD_DIM)
    q = _rope(_rms_norm(q, q_g), pos)
    k = _rope(_rms_norm(k, k_g), pos)
    u = c * h
    return q, k, v, u, b, ga, gc


def _sink_attention(q, k, v, q_pos, k_pos, sinks):
    s = jnp.einsum('...qkgd,...skd->...kgqs', q, k).astype(jnp.float32) * (HEAD_DIM ** -0.5)
    rel = q_pos[..., :, None] - k_pos[..., None, :]
    valid = (rel >= 0) & (rel < WINDOW) & (k_pos[..., None, :] >= 0)
    s = jnp.where(valid[..., None, None, :, :], s, NEG_INF)
    sink = sinks.astype(jnp.float32).reshape(N_KV_HEADS, GROUP)[:, :, None, None]
    m = jnp.maximum(jnp.max(s, axis=-1, keepdims=True), sink)
    p = jnp.exp(s - m)
    p = p / (jnp.sum(p, axis=-1, keepdims=True) + jnp.exp(sink - m))
    return jnp.einsum('...kgqs,...skd->...qkgd', p.astype(v.dtype), v)


def _causal_conv(u_ext, w):
    t = u_ext.shape[1] - (CONV_WIDTH - 1)
    out = w[0] * u_ext[:, 0:t]
    for j in range(1, CONV_WIDTH):
        out = out + w[j] * u_ext[:, j:j + t]
    return out


def _merge_out(attn, conv, b, ga, gc, w_out):
    mix = jax.nn.sigmoid(ga) * attn + jax.nn.sigmoid(gc) * (b * conv)
    return mix @ w_out


def _ffn(x, norm_g, w_gate_up, w_down):
    h = _rms_norm(x, norm_g) @ w_gate_up
    g, u = jnp.split(h, 2, axis=-1)
    return (jax.nn.silu(g) * u) @ w_down


def _prompt_layer(x, norm_mix, w_in, q_norm, k_norm, sinks, conv_w, w_out, norm_ffn, w_gate_up, w_down):
    bsz, t, _ = x.shape
    pos = jnp.arange(t, dtype=jnp.int32)
    q, k, v, u, b, ga, gc = _project(x, norm_mix, w_in, q_norm, k_norm, pos)
    nb = t // BLOCK
    qb = q.reshape(bsz, nb, BLOCK, N_KV_HEADS, GROUP, HEAD_DIM)

    def band(a):
        ab = a.reshape(bsz, nb, BLOCK, N_KV_HEADS, HEAD_DIM)
        prev = jnp.pad(ab[:, :-1], ((0, 0), (1, 0), (0, 0), (0, 0), (0, 0)))
        return jnp.concatenate([prev, ab], axis=2)

    q_pos = pos.reshape(nb, BLOCK)
    k_pos = jnp.concatenate([q_pos - BLOCK, q_pos], axis=1)
    attn = _sink_attention(qb, band(k), band(v), q_pos, k_pos, sinks).reshape(bsz, t, D_ATTN)
    u_ext = jnp.pad(u, ((0, 0), (CONV_WIDTH - 1, 0), (0, 0)))
    conv = _causal_conv(u_ext, conv_w)
    y = x + _merge_out(attn, conv, b, ga, gc, w_out)
    y = y + _ffn(y, norm_ffn, w_gate_up, w_down)
    w_buf = min(WINDOW, t)
    return y, k[:, t - w_buf:], v[:, t - w_buf:], u_ext[:, -(CONV_WIDTH - 1):]


def _sample_layer(x, k_buf, v_buf, conv_buf, norm_mix, w_in, q_norm, k_norm, sinks, conv_w, w_out, norm_ffn, w_gate_up, w_down):
    nseq, t, _ = x.shape
    w_buf = k_buf.shape[1]
    pos = PAST_LEN + jnp.arange(t, dtype=jnp.int32)
    q, k, v, u, b, ga, gc = _project(x, norm_mix, w_in, q_norm, k_norm, pos)
    k_all = jnp.concatenate([k_buf.astype(k.dtype), k], axis=1)
    v_all = jnp.concatenate([v_buf.astype(v.dtype), v], axis=1)
    k_pos = jnp.concatenate([PAST_LEN - w_buf + jnp.arange(w_buf, dtype=jnp.int32), pos])
    qg = q.reshape(nseq, t, N_KV_HEADS, GROUP, HEAD_DIM)
    attn = _sink_attention(qg, k_all, v_all, pos, k_pos, sinks).reshape(nseq, t, D_ATTN)
    u_ext = jnp.concatenate([conv_buf.astype(u.dtype), u], axis=1)
    conv = _causal_conv(u_ext, conv_w)
    y = x + _merge_out(attn, conv, b, ga, gc, w_out)
    y = y + _ffn(y, norm_ffn, w_gate_up, w_down)
    return y, k_all[:, -w_buf:], v_all[:, -w_buf:], u_ext[:, -(CONV_WIDTH - 1):]


def setup_inputs(seed: int = 0) -> dict:
    key = jax.random.key(seed)
    ks = jax.random.split(key, 16)
    f32 = jnp.float32
    w_buf = min(WINDOW, PAST_LEN)
    nrm = lambda k, shape: jax.random.normal(k, shape, dtype=f32)
    return {
        'x_prompt': nrm(ks[0], (BATCH, SEQ, D_MODEL)),
        'x_sample': nrm(ks[1], (DEC_BATCH, DEC_SEQ, D_MODEL)),
        'cache_k_win': nrm(ks[2], (DEPTH, DEC_BATCH, w_buf, N_KV_HEADS, HEAD_DIM)),
        'cache_v_win': nrm(ks[3], (DEPTH, DEC_BATCH, w_buf, N_KV_HEADS, HEAD_DIM)),
        'state_conv': nrm(ks[4], (DEPTH, DEC_BATCH, CONV_WIDTH - 1, D_CONV)),
        'norm_mix': 1.0 + 0.1 * nrm(ks[5], (DEPTH, D_MODEL)),
        'w_in': nrm(ks[6], (DEPTH, D_MODEL, D_IN)) * D_MODEL ** -0.5,
        'q_norm': 1.0 + 0.1 * nrm(ks[7], (DEPTH, HEAD_DIM)),
        'k_norm': 1.0 + 0.1 * nrm(ks[8], (DEPTH, HEAD_DIM)),
        'sinks': 0.5 * nrm(ks[9], (DEPTH, N_HEADS)),
        'conv_w': nrm(ks[10], (DEPTH, CONV_WIDTH, D_CONV)) * CONV_WIDTH ** -0.5,
        'w_out': nrm(ks[11], (DEPTH, D_ATTN, D_MODEL)) * D_ATTN ** -0.5,
        'norm_ffn': 1.0 + 0.1 * nrm(ks[12], (DEPTH, D_MODEL)),
        'w_gate_up': nrm(ks[13], (DEPTH, D_MODEL, 2 * D_FF)) * D_MODEL ** -0.5,
        'w_down': nrm(ks[14], (DEPTH, D_FF, D_MODEL)) * D_FF ** -0.5,
    }


def reference(x_prompt, x_sample, cache_k_win, cache_v_win, state_conv, norm_mix, w_in, q_norm, k_norm, sinks, conv_w, w_out, norm_ffn, w_gate_up, w_down):
    yp, ys = x_prompt, x_sample
    pk, pv, pc, sk, sv, sc = [], [], [], [], [], []
    for l in range(DEPTH):
        params = (norm_mix[l], w_in[l], q_norm[l], k_norm[l], sinks[l], conv_w[l],
                  w_out[l], norm_ffn[l], w_gate_up[l], w_down[l])
        yp, k_new, v_new, c_new = _prompt_layer(yp, *params)
        pk.append(k_new); pv.append(v_new); pc.append(c_new)
        ys, k_s, v_s, c_s = _sample_layer(ys, cache_k_win[l], cache_v_win[l], state_conv[l], *params)
        sk.append(k_s); sv.append(v_s); sc.append(c_s)
    return (yp, ys, jnp.stack(pk), jnp.stack(pv), jnp.stack(pc), jnp.stack(sk), jnp.stack(sv), jnp.stack(sc))
```

```cpp
#include <hip/hip_runtime.h>
#include <hip/hip_cooperative_groups.h>
#include <cstdio>
namespace cg = cooperative_groups;

#define LAS __attribute__((address_space(3)))
#define DI __device__ __forceinline__
typedef unsigned short bf16_t;
typedef short bf16x8 __attribute__((ext_vector_type(8)));
typedef short s16x4 __attribute__((ext_vector_type(4)));
typedef float f32x4 __attribute__((ext_vector_type(4)));
typedef float f32x16 __attribute__((ext_vector_type(16)));
typedef unsigned u32x4 __attribute__((ext_vector_type(4)));
typedef unsigned u32x2 __attribute__((ext_vector_type(2)));

constexpr int DM = 2048, TP = 8192, TS = 512, MT = TP + TS, DIN = 12800, DFF = 5632, NGU = 2 * DFF;
constexpr float EPS = 1e-6f;
constexpr int NPOS = 8196;
constexpr size_t O_YP = 0, O_YS = (size_t)TP * DM, O_PK = O_YS + (size_t)TS * DM, O_PV = O_PK + 32768, O_PC = O_PV + 32768,
                 O_SK = O_PC + 4096, O_SV = O_SK + 4194304, O_SC = O_SV + 4194304;
constexpr size_t WS_WIN = 0, WS_WOUT = WS_WIN + (size_t)DIN * DM * 2, WS_WGU = WS_WOUT + (size_t)DM * DM * 2, WS_WDN = WS_WGU + (size_t)NGU * DM * 2,
                 WS_XN = WS_WDN + (size_t)DM * DFF * 2, WS_Q = WS_XN + (size_t)MT * DM * 2, WS_K = WS_Q + (size_t)MT * DM * 2, WS_V = WS_K + (size_t)MT * 256 * 2,
                 WS_U = WS_V + (size_t)MT * 256 * 2, WS_BG = WS_U + (size_t)MT * DM * 2, WS_SGA = WS_BG + (size_t)MT * DM * 2, WS_COS = WS_SGA + (size_t)MT * DM * 2,
                 WS_SIN = WS_COS + (size_t)NPOS * 32 * 4, WS_SSQ = WS_SIN + (size_t)NPOS * 32 * 4, WS_END = WS_SSQ + (size_t)MT * 32 * 4;
constexpr size_t WS_MIX = WS_XN, WS_A2 = WS_Q, WS_HID = WS_U;
static_assert((size_t)MT * DFF * 2 <= 3 * (size_t)MT * DM * 2, "hidden fits in U|BG|SGA");

struct Params {
    const float *xp, *xs, *ck, *cv, *sconv, *norm_mix, *w_in, *q_norm, *k_norm, *sinks, *conv_w, *w_out, *norm_ffn, *w_gu, *w_dn;
    float* out; unsigned char* ws;
};

DI unsigned f2bf(float f) { unsigned u = __float_as_uint(f); u += 0x7FFFu + ((u >> 16) & 1u); return u >> 16; }
DI unsigned pk2(float lo, float hi) { return f2bf(lo) | (f2bf(hi) << 16); }
DI u32x2 pk4(f32x4 v) { u32x2 r; r.x = pk2(v[0], v[1]); r.y = pk2(v[2], v[3]); return r; }
DI float bf_lo(unsigned w) { return __uint_as_float(w << 16); }
DI float bf_hi(unsigned w) { return __uint_as_float(w & 0xffff0000u); }
DI f32x4 unpk4(u32x2 w) { return (f32x4){bf_lo(w.x), bf_hi(w.x), bf_lo(w.y), bf_hi(w.y)}; }
DI float sigmoidf_(float x) { return __builtin_amdgcn_rcpf(1.0f + __builtin_amdgcn_exp2f(-1.44269504089f * x)); }
DI float wave_sum(float v) {
#pragma unroll
    for (int o = 1; o < 64; o <<= 1) v += __shfl_xor(v, o);
    return v;
}

namespace pg8 {
constexpr int BM = 256, BK = 64, HALF = 128, HTB = HALF * BK * 2, STAGE_BYTES = 8 * HTB, NXCD = 8, WGM = 8;
DI int lds_byte(int r, int c) { const int st = (r >> 4) * 2 + (c >> 5), rr = r & 15, cc = c & 31, ob = rr * 64 + cc * 2; return st * 1024 + (ob ^ (((ob >> 9) & 1) << 5)); }
DI void stage_rc(int b, int& R, int& C) { const int st = b / 1024, sb = b % 1024, swz = sb ^ (((sb >> 9) & 1) << 5); R = (st >> 1) * 16 + swz / 64; C = (st & 1) * 32 + (swz % 64) / 2; }
struct Unit { int pm, pn; };
struct Gemm { const bf16_t* A; const bf16_t* Bt; int M, N, K; };
struct StaticOrder {
    int nM, nN, nwg, G, c;
    DI void init(int M, int N, int G_, int c_) { nM = M / BM; nN = N / BM; nwg = nM * nN; G = G_; c = c_; }
    DI bool next(int i, Unit& u) const {
        const long L = (long)i * G + c; if (L >= nwg) return false;
        int wgid = (int)L; { const int q = nwg / NXCD, r = nwg % NXCD, xcd = wgid % NXCD, off = wgid / NXCD; wgid = (xcd < r ? xcd * (q + 1) : r * (q + 1) + (xcd - r) * q) + off; }
        const int nig = WGM * nN, gid = wgid / nig, fm = gid * WGM, gsz = (nM - fm) < WGM ? (nM - fm) : WGM;
        u.pm = fm + ((wgid % nig) % gsz); u.pn = (wgid % nig) / gsz; return true;
    }
};

template <class Epi>
DI void gemm_phase(LAS unsigned char* lds, const Gemm g, const StaticOrder& S, const Epi& E) {
    const int tid = threadIdx.x, wid = __builtin_amdgcn_readfirstlane(tid >> 6), lane = tid & 63, wr = wid >> 2, wc = wid & 3, fr = lane & 15, fq = lane >> 4;
    const int K = g.K, nt = K / BK;
    unsigned voffA[2];
#pragma unroll
    for (int i = 0; i < 2; ++i) { int R, C; stage_rc(tid * 16 + i * 8192, R, C); voffA[i] = (unsigned)(R * K + C) * 2u; }
    const size_t kstep = (size_t)(BK * 2);
    const size_t hstep = (size_t)HALF * K * 2;
    const size_t tstep = 2 * hstep;
    const unsigned ldsw = (unsigned)wid * 1024u;
    const int aoff = lds_byte(wr * 64 + fr, fq * 8), boff = lds_byte(wc * 32 + fr, fq * 8);
#define PG8_SA(b, h) (((b) * 2 + (h)) * HTB)
#define PG8_SB(b, h) ((4 + (b) * 2 + (h)) * HTB)
#define PG8_STAGE(bufoff, gbase) do { _Pragma("unroll") for (int _i = 0; _i < 2; ++_i) \
        __builtin_amdgcn_global_load_lds((const unsigned*)((const char*)(gbase) + voffA[_i]), (LAS unsigned*)(lds + (bufoff) + ldsw + _i * 8192), 16, 0, 0); } while (0)
#define PG8_LDA(dst, b, h) do { _Pragma("unroll") for (int m = 0; m < 4; ++m) _Pragma("unroll") for (int k = 0; k < 2; ++k) dst[m][k] = *(const LAS bf16x8*)(lds + PG8_SA(b, h) + aoff + m * 2048 + k * 1024); } while (0)
#define PG8_LDB(dst, b, h) do { _Pragma("unroll") for (int n = 0; n < 2; ++n) _Pragma("unroll") for (int k = 0; k < 2; ++k) dst[n][k] = *(const LAS bf16x8*)(lds + PG8_SB(b, h) + boff + n * 2048 + k * 1024); } while (0)
#define PG8_MMA(ai, bj, At, Bt) do { __builtin_amdgcn_s_setprio(1); _Pragma("unroll") for (int m = 0; m < 4; ++m) _Pragma("unroll") for (int n = 0; n < 2; ++n) _Pragma("unroll") for (int k = 0; k < 2; ++k) \
        acc[ai][bj][m][n] = __builtin_amdgcn_mfma_f32_16x16x32_bf16(Bt[n][k], At[m][k], acc[ai][bj][m][n], 0, 0, 0); __builtin_amdgcn_s_setprio(0); } while (0)
#define PG8_WAIT_V(n) asm volatile("s_waitcnt vmcnt(" #n ")" ::: "memory")
#define PG8_WAIT_L(n) asm volatile("s_waitcnt lgkmcnt(" #n ")" ::: "memory")
#define PG8_BAR __builtin_amdgcn_s_barrier()
#define PG8_SCHED __builtin_amdgcn_sched_barrier(0)
    Unit cur, nxt; int ui = 0;
    if (!S.next(0, cur)) return;
    f32x4 acc[2][2][4][2];
#pragma unroll
    for (int a = 0; a < 2; ++a)
#pragma unroll
        for (int b = 0; b < 2; ++b)
#pragma unroll
            for (int m = 0; m < 4; ++m)
#pragma unroll
                for (int n = 0; n < 2; ++n) acc[a][b][m][n] = (f32x4){0.f, 0.f, 0.f, 0.f};
    bf16x8 At[4][2], B0[2][2], B1[2][2];
    const char* cA = (const char*)g.A + (size_t)cur.pm * tstep; const char* cB = (const char*)g.Bt + (size_t)cur.pn * tstep;
    PG8_STAGE(PG8_SB(0, 0), cB); PG8_STAGE(PG8_SA(0, 0), cA); PG8_STAGE(PG8_SB(0, 1), cB + hstep); PG8_STAGE(PG8_SA(0, 1), cA + hstep);
    if (wr == 1) PG8_BAR;
    PG8_WAIT_V(4); PG8_BAR;
    PG8_STAGE(PG8_SB(1, 0), cB + kstep); PG8_STAGE(PG8_SA(1, 0), cA + kstep); PG8_STAGE(PG8_SB(1, 1), cB + hstep + kstep);
    PG8_WAIT_V(6); PG8_BAR;
    for (;;) {
        const bool has_next = S.next(ui + 1, nxt);
        const char* nA = has_next ? (const char*)g.A + (size_t)nxt.pm * tstep : cA; const char* nB = has_next ? (const char*)g.Bt + (size_t)nxt.pn * tstep : cB;
        for (int t = 0; t < nt; t += 2) {
            const bool last = (t == nt - 2);
            const char* a1 = cA + (size_t)(t + 1) * kstep;
            const char* a2 = last ? nA : cA + (size_t)(t + 2) * kstep; const char* b2 = last ? nB : cB + (size_t)(t + 2) * kstep;
            const char* a3 = a2 + kstep; const char* b3 = b2 + kstep;
            PG8_LDB(B0, 0, 0); PG8_SCHED; PG8_LDA(At, 0, 0); PG8_STAGE(PG8_SA(1, 1), a1 + hstep);
            PG8_WAIT_L(8); PG8_BAR; PG8_WAIT_L(0); PG8_MMA(0, 0, At, B0); PG8_BAR; PG8_SCHED;
            PG8_LDB(B1, 0, 1); PG8_STAGE(PG8_SB(0, 0), b2);
            PG8_BAR; PG8_WAIT_L(0); PG8_MMA(0, 1, At, B1); PG8_BAR;
            PG8_LDA(At, 0, 1); PG8_STAGE(PG8_SA(0, 0), a2);
            PG8_BAR; PG8_WAIT_L(0); PG8_MMA(1, 0, At, B0); PG8_BAR; PG8_SCHED;
            PG8_STAGE(PG8_SB(0, 1), b2 + hstep);
            PG8_WAIT_V(6); PG8_BAR; PG8_MMA(1, 1, At, B1); PG8_BAR;
            PG8_LDB(B0, 1, 0); PG8_SCHED; PG8_LDA(At, 1, 0); PG8_STAGE(PG8_SA(0, 1), a2 + hstep);
            PG8_WAIT_L(8); PG8_BAR; PG8_WAIT_L(0); PG8_MMA(0, 0, At, B0); PG8_BAR; PG8_SCHED;
            PG8_LDB(B1, 1, 1); PG8_STAGE(PG8_SB(1, 0), b3);
            PG8_BAR; PG8_WAIT_L(0); PG8_MMA(0, 1, At, B1); PG8_BAR;
            PG8_LDA(At, 1, 1); PG8_STAGE(PG8_SA(1, 0), a3);
            PG8_BAR; PG8_WAIT_L(0); PG8_MMA(1, 0, At, B0); PG8_BAR; PG8_SCHED;
            PG8_STAGE(PG8_SB(1, 1), b3 + hstep);
            PG8_WAIT_V(6); PG8_BAR; PG8_MMA(1, 1, At, B1); PG8_BAR;
        }
        E(acc, cur, wr, wc, fr, fq);
        if (!has_next) break;
#pragma unroll
        for (int a = 0; a < 2; ++a)
#pragma unroll
            for (int b = 0; b < 2; ++b)
#pragma unroll
                for (int m = 0; m < 4; ++m)
#pragma unroll
                    for (int n = 0; n < 2; ++n) acc[a][b][m][n] = (f32x4){0.f, 0.f, 0.f, 0.f};
        cur = nxt; cA = nA; cB = nB; ++ui;
    }
    PG8_WAIT_V(0);
    if (wr == 0) PG8_BAR;
    PG8_BAR;
#undef PG8_SA
#undef PG8_SB
#undef PG8_STAGE
#undef PG8_LDA
#undef PG8_LDB
#undef PG8_MMA
#undef PG8_WAIT_V
#undef PG8_WAIT_L
#undef PG8_BAR
#undef PG8_SCHED
}
}

typedef f32x4 AccT[2][2][4][2];

DI int src_col_in(int R) {
    const int pn = R >> 8, c = R & 255, bj = c >> 7, wc = (c >> 5) & 3, r5 = c & 31;
    if (pn < 8) return (4 * pn + wc) * 64 + 32 * bj + r5;
    if (pn == 8) return 2048 + wc * 64 + 32 * bj + r5;
    if (pn == 9) return 2304 + c;
    if (pn < 26) return (bj ? 6656 : 2560) + 128 * (pn - 10) + (c & 127);
    if (pn < 42) return (bj ? 10752 : 4608) + 128 * (pn - 26) + (c & 127);
    return 8704 + 256 * (pn - 42) + c;
}
DI int src_col_gu(int R) { const int t = R >> 8, c = R & 255; return ((c >> 7) ? DFF : 0) + 128 * t + (c & 127); }

struct Epi1 {
    bf16_t *Q, *Kb, *Vb, *U, *BG, *SGA; const float *qg, *kg, *cosT, *sinT; float* out;
    DI void side_kv(float* pwin, float* swin, int row, int col, f32x4 v) const {
        if (row >= TP - 128 && row < TP) *(f32x4*)(pwin + (size_t)(row - (TP - 128)) * 256 + col) = v;
        if (row >= TP) { const int b = (row - TP) >> 2, i = (row - TP) & 3; *(f32x4*)(swin + (size_t)b * 32768 + (size_t)(124 + i) * 256 + col) = v; }
    }
    DI void operator()(const AccT& acc, const pg8::Unit& u, int wr, int wc, int fr, int fq) const {
        const int pn = u.pn, row0 = u.pm * 256 + wr * 64 + fr;
        if (pn < 9) {
            const float* g = pn < 8 ? qg : kg;
            f32x4 gv[2][2];
#pragma unroll
            for (int bj = 0; bj < 2; ++bj)
#pragma unroll
                for (int n = 0; n < 2; ++n) gv[bj][n] = *(const f32x4*)(g + 32 * bj + 16 * n + 4 * fq);
#pragma unroll
            for (int ai = 0; ai < 2; ++ai)
#pragma unroll
                for (int m = 0; m < 4; ++m) {
                    const int row = row0 + 128 * ai + 16 * m;
                    const int pos = row < TP ? row : TP + ((row - TP) & 3);
                    float ssq = 0.f;
#pragma unroll
                    for (int bj = 0; bj < 2; ++bj)
#pragma unroll
                        for (int n = 0; n < 2; ++n) { const f32x4 x = acc[ai][bj][m][n]; ssq += (x[0] * x[0] + x[1] * x[1]) + (x[2] * x[2] + x[3] * x[3]); }
                    ssq += __shfl_xor(ssq, 16); ssq += __shfl_xor(ssq, 32);
                    const float rs = 1.0f / sqrtf(ssq * (1.0f / 64.0f) + EPS);
#pragma unroll
                    for (int n = 0; n < 2; ++n) {
                        const f32x4 cs = *(const f32x4*)(cosT + (size_t)pos * 32 + 16 * n + 4 * fq), sn = *(const f32x4*)(sinT + (size_t)pos * 32 + 16 * n + 4 * fq);
                        const f32x4 y1 = acc[ai][0][m][n] * rs * gv[0][n], y2 = acc[ai][1][m][n] * rs * gv[1][n];
                        const f32x4 o1 = y1 * cs - y2 * sn, o2 = y2 * cs + y1 * sn;
                        const int d = 16 * n + 4 * fq;
                        if (pn < 8) {
                            bf16_t* qp = Q + (size_t)row * DM + (4 * pn + wc) * 64 + d;
                            *(u32x2*)qp = pk4(o1); *(u32x2*)(qp + 32) = pk4(o2);
                        } else {
                            bf16_t* kp = Kb + (size_t)row * 256 + wc * 64 + d;
                            *(u32x2*)kp = pk4(o1); *(u32x2*)(kp + 32) = pk4(o2);
                            side_kv(out + O_PK, out + O_SK, row, wc * 64 + d, o1); side_kv(out + O_PK, out + O_SK, row, wc * 64 + d + 32, o2);
                        }
                    }
                }
        } else if (pn == 9) {
#pragma unroll
            for (int ai = 0; ai < 2; ++ai)
#pragma unroll
                for (int m = 0; m < 4; ++m) {
                    const int row = row0 + 128 * ai + 16 * m;
#pragma unroll
                    for (int bj = 0; bj < 2; ++bj)
#pragma unroll
                        for (int n = 0; n < 2; ++n) { const int col = 128 * bj + 32 * wc + 16 * n + 4 * fq; const f32x4 v = acc[ai][bj][m][n];
                            *(u32x2*)(Vb + (size_t)row * 256 + col) = pk4(v); side_kv(out + O_PV, out + O_SV, row, col, v); }
                }
        } else if (pn < 26) {
            const int t = pn - 10;
#pragma unroll
            for (int ai = 0; ai < 2; ++ai)
#pragma unroll
                for (int m = 0; m < 4; ++m) {
                    const int row = row0 + 128 * ai + 16 * m;
#pragma unroll
                    for (int n = 0; n < 2; ++n) { const int col = 128 * t + 32 * wc + 16 * n + 4 * fq; const f32x4 v = acc[ai][0][m][n] * acc[ai][1][m][n];
                        *(u32x2*)(U + (size_t)row * DM + col) = pk4(v);
                        if (row >= TP - 2 && row < TP) *(f32x4*)(out + O_PC + (size_t)(row - (TP - 2)) * DM + col) = v;
                        if (row >= TP && ((row - TP) & 3) >= 2) { const int b = (row - TP) >> 2, i = (row - TP) & 3; *(f32x4*)(out + O_SC + (size_t)b * 4096 + (size_t)(i - 2) * DM + col) = v; } }
                }
        } else if (pn < 42) {
            const int t = pn - 26;
#pragma unroll
            for (int ai = 0; ai < 2; ++ai)
#pragma unroll
                for (int m = 0; m < 4; ++m) {
                    const int row = row0 + 128 * ai + 16 * m;
#pragma unroll
                    for (int n = 0; n < 2; ++n) { const int col = 128 * t + 32 * wc + 16 * n + 4 * fq; const f32x4 b = acc[ai][0][m][n], gc = acc[ai][1][m][n];
                        f32x4 v; v[0] = b[0] * sigmoidf_(gc[0]); v[1] = b[1] * sigmoidf_(gc[1]); v[2] = b[2] * sigmoidf_(gc[2]); v[3] = b[3] * sigmoidf_(gc[3]);
                        *(u32x2*)(BG + (size_t)row * DM + col) = pk4(v); }
                }
        } else {
#pragma unroll
            for (int ai = 0; ai < 2; ++ai)
#pragma unroll
                for (int m = 0; m < 4; ++m) {
                    const int row = row0 + 128 * ai + 16 * m;
#pragma unroll
                    for (int bj = 0; bj < 2; ++bj)
#pragma unroll
                        for (int n = 0; n < 2; ++n) { const int col = 256 * (pn - 42) + 128 * bj + 32 * wc + 16 * n + 4 * fq; const f32x4 a = acc[ai][bj][m][n];
                            f32x4 v; v[0] = sigmoidf_(a[0]); v[1] = sigmoidf_(a[1]); v[2] = sigmoidf_(a[2]); v[3] = sigmoidf_(a[3]);
                            *(u32x2*)(SGA + (size_t)row * DM + col) = pk4(v); }
                }
        }
    }
};

struct Epi3 {
    const float *xp, *xs, *gffn; float* Y; bf16_t* A2; float* SSQ;
    DI void operator()(const AccT& acc, const pg8::Unit& u, int wr, int wc, int fr, int fq) const {
        const int row0 = u.pm * 256 + wr * 64 + fr, col0 = u.pn * 256 + wc * 32 + 4 * fq;
        const float* xb = u.pm < 32 ? xp : xs - (size_t)TP * DM;
        f32x4 gv[2][2];
#pragma unroll
        for (int bj = 0; bj < 2; ++bj)
#pragma unroll
            for (int n = 0; n < 2; ++n) gv[bj][n] = *(const f32x4*)(gffn + col0 + 128 * bj + 16 * n);
#pragma unroll
        for (int ai = 0; ai < 2; ++ai)
#pragma unroll
            for (int m = 0; m < 4; ++m) {
                const int row = row0 + 128 * ai + 16 * m; float ssq = 0.f;
#pragma unroll
                for (int bj = 0; bj < 2; ++bj)
#pragma unroll
                    for (int n = 0; n < 2; ++n) { const size_t off = (size_t)row * DM + col0 + 128 * bj + 16 * n;
                        const f32x4 y = *(const f32x4*)(xb + off) + acc[ai][bj][m][n];
                        ssq += (y[0] * y[0] + y[1] * y[1]) + (y[2] * y[2] + y[3] * y[3]);
                        *(f32x4*)(Y + off) = y; *(u32x2*)(A2 + off) = pk4(y * gv[bj][n]); }
                ssq += __shfl_xor(ssq, 16); ssq += __shfl_xor(ssq, 32);
                if (fq == 0) SSQ[(size_t)row * 32 + u.pn * 4 + wc] = ssq;
            }
    }
};

struct Epi4 {
    const float* SSQ; bf16_t* HID;
    DI void operator()(const AccT& acc, const pg8::Unit& u, int wr, int wc, int fr, int fq) const {
        const int row0 = u.pm * 256 + wr * 64 + fr, col0 = u.pn * 128 + wc * 32 + 4 * fq;
#pragma unroll
        for (int ai = 0; ai < 2; ++ai)
#pragma unroll
            for (int m = 0; m < 4; ++m) {
                const int row = row0 + 128 * ai + 16 * m;
                const f32x4* sp = (const f32x4*)(SSQ + (size_t)row * 32); f32x4 s4 = sp[0];
#pragma unroll
                for (int k = 1; k < 8; ++k) s4 += sp[k];
                const float rstd = 1.0f / sqrtf(((s4[0] + s4[1]) + (s4[2] + s4[3])) * (1.0f / DM) + EPS);
#pragma unroll
                for (int n = 0; n < 2; ++n) { const f32x4 g = acc[ai][0][m][n] * rstd, up = acc[ai][1][m][n] * rstd;
                    f32x4 h; h[0] = g[0] * sigmoidf_(g[0]) * up[0]; h[1] = g[1] * sigmoidf_(g[1]) * up[1]; h[2] = g[2] * sigmoidf_(g[2]) * up[2]; h[3] = g[3] * sigmoidf_(g[3]) * up[3];
                    *(u32x2*)(HID + (size_t)row * DFF + col0 + 16 * n) = pk4(h); }
            }
    }
};

struct Epi5 {
    float* Y;
    DI void operator()(const AccT& acc, const pg8::Unit& u, int wr, int wc, int fr, int fq) const {
        const int row0 = u.pm * 256 + wr * 64 + fr, col0 = u.pn * 256 + wc * 32 + 4 * fq;
#pragma unroll
        for (int ai = 0; ai < 2; ++ai)
#pragma unroll
            for (int m = 0; m < 4; ++m) {
                const int row = row0 + 128 * ai + 16 * m;
#pragma unroll
                for (int bj = 0; bj < 2; ++bj)
#pragma unroll
                    for (int n = 0; n < 2; ++n) { float* yp = Y + (size_t)row * DM + col0 + 128 * bj + 16 * n; *(f32x4*)yp = *(const f32x4*)yp + acc[ai][bj][m][n]; }
            }
    }
};

DI void p0_transpose_item(const float* W, int K, int N, bf16_t* WT, int src_n0, int dst_n0, int k0, LAS float* scr, int lane) {
#pragma unroll 8
    for (int i = 0; i < 32; ++i) { const int kk = 2 * i + (lane >> 5); scr[kk * 33 + (lane & 31)] = W[(size_t)(k0 + kk) * N + src_n0 + (lane & 31)]; }
    asm volatile("s_waitcnt lgkmcnt(0)" ::: "memory");
    const int c = lane & 7;
#pragma unroll
    for (int j = 0; j < 4; ++j) { const int n = (lane >> 3) + 8 * j; const LAS float* s = scr + (8 * c) * 33 + n;
        u32x4 o; o.x = pk2(s[0 * 33], s[1 * 33]); o.y = pk2(s[2 * 33], s[3 * 33]); o.z = pk2(s[4 * 33], s[5 * 33]); o.w = pk2(s[6 * 33], s[7 * 33]);
        *(u32x4*)(WT + (size_t)(dst_n0 + n) * K + k0 + 8 * c) = o; }
    asm volatile("s_waitcnt lgkmcnt(0)" ::: "memory");
}

DI void p0_prologue(const Params& p, LAS unsigned char* lds, int wid, int lane) {
    LAS float* scr = (LAS float*)(lds + wid * 8704);
    const int gw = blockIdx.x * 8 + wid, NGW = gridDim.x * 8;
    bf16_t* WinT = (bf16_t*)(p.ws + WS_WIN); bf16_t* WoutT = (bf16_t*)(p.ws + WS_WOUT); bf16_t* WguT = (bf16_t*)(p.ws + WS_WGU); bf16_t* WdnT = (bf16_t*)(p.ws + WS_WDN);
    constexpr int I_IN = (DM / 64) * (DIN / 32), I_OUT = (DM / 64) * (DM / 32), I_GU = (DM / 64) * (NGU / 32), I_DN = (DFF / 64) * (DM / 32);
    constexpr int NITEMS = I_IN + I_OUT + I_GU + I_DN;
    for (int it = gw; it < NITEMS; it += NGW) {
        int r = it;
        if (r < I_IN) { const int nblk = DIN / 32, kb = r / nblk, nb = r % nblk; p0_transpose_item(p.w_in, DM, DIN, WinT, src_col_in(32 * nb), 32 * nb, 64 * kb, scr, lane); continue; } r -= I_IN;
        if (r < I_OUT) { const int nblk = DM / 32, kb = r / nblk, nb = r % nblk; p0_transpose_item(p.w_out, DM, DM, WoutT, 32 * nb, 32 * nb, 64 * kb, scr, lane); continue; } r -= I_OUT;
        if (r < I_GU) { const int nblk = NGU / 32, kb = r / nblk, nb = r % nblk; p0_transpose_item(p.w_gu, DM, NGU, WguT, src_col_gu(32 * nb), 32 * nb, 64 * kb, scr, lane); continue; } r -= I_GU;
        { const int nblk = DM / 32, kb = r / nblk, nb = r % nblk; p0_transpose_item(p.w_dn, DFF, DM, WdnT, 32 * nb, 32 * nb, 64 * kb, scr, lane); }
    }
    bf16_t* XN = (bf16_t*)(p.ws + WS_XN);
    for (int m = gw; m < MT; m += NGW) {
        const float* xrow = m < TP ? p.xp + (size_t)m * DM : p.xs + (size_t)(m - TP) * DM;
        const f32x4* xr = (const f32x4*)xrow + lane; f32x4 v[8]; float s = 0.f;
#pragma unroll
        for (int j = 0; j < 8; ++j) { v[j] = xr[64 * j]; s += (v[j][0] * v[j][0] + v[j][1] * v[j][1]) + (v[j][2] * v[j][2] + v[j][3] * v[j][3]); }
        const float rstd = 1.0f / sqrtf(wave_sum(s) * (1.0f / DM) + EPS);
        u32x2* o8 = (u32x2*)(XN + (size_t)m * DM) + lane;
#pragma unroll
        for (int j = 0; j < 8; ++j) { const f32x4 gv = ((const f32x4*)p.norm_mix)[64 * j + lane]; o8[64 * j] = pk4(v[j] * rstd * gv); }
    }
    float* cosT = (float*)(p.ws + WS_COS); float* sinT = (float*)(p.ws + WS_SIN);
    const int gt = blockIdx.x * 512 + threadIdx.x, GT = gridDim.x * 512;
    for (int idx = gt; idx < NPOS * 32; idx += GT) {
        const int pos = idx >> 5, i = idx & 31;
        const float inv = __builtin_amdgcn_exp2f(-(float)i * (13.287712379549449f / 32.0f));
        const float ang = (float)pos * inv;
        const double rev = (double)ang * 0.15915494309189535; const float fr = (float)(rev - __builtin_floor(rev));
        cosT[idx] = __builtin_amdgcn_cosf(fr); sinT[idx] = __builtin_amdgcn_sinf(fr);
    }
    for (int idx = gt; idx < 128 * 7936; idx += GT) {
        const int b = idx / 7936, e = idx - b * 7936;
        ((f32x4*)(p.out + O_SK + (size_t)b * 32768))[e] = ((const f32x4*)(p.ck + (size_t)b * 32768 + 1024))[e];
        ((f32x4*)(p.out + O_SV + (size_t)b * 32768))[e] = ((const f32x4*)(p.cv + (size_t)b * 32768 + 1024))[e];
    }
}

#define MFMA32(a, b, c) __builtin_amdgcn_mfma_f32_32x32x16_bf16((a), (b), (c), 0, 0, 0)
DI int crow(int reg, int h) { return (reg & 3) + 8 * (reg >> 2) + 4 * h; }
DI bf16x8 pack8(const f32x16& x, int s) {
    u32x4 p; p.x = pk2(x[8 * s], x[8 * s + 1]); p.y = pk2(x[8 * s + 2], x[8 * s + 3]); p.z = pk2(x[8 * s + 4], x[8 * s + 5]); p.w = pk2(x[8 * s + 6], x[8 * s + 7]);
    return __builtin_bit_cast(bf16x8, p);
}
DI bf16x8 cvt8(f32x4 a, f32x4 b) { u32x4 p; p.x = pk2(a[0], a[1]); p.y = pk2(a[2], a[3]); p.z = pk2(b[0], b[1]); p.w = pk2(b[2], b[3]); return __builtin_bit_cast(bf16x8, p); }

constexpr int KS_STRIDE = 72, VT_STRIDE = 260, VT_OFF = 256 * KS_STRIDE * 2;

template <bool SAMPLE>
DI void attn_chunk(const Params& p, LAS unsigned char* lds, int qb, int c, int kvh, int head_w, int b_s, int lane) {
    const bf16_t* Q = (const bf16_t*)(p.ws + WS_Q); const bf16_t* Kb = (const bf16_t*)(p.ws + WS_K); const bf16_t* Vb = (const bf16_t*)(p.ws + WS_V);
    const bf16_t* U = (const bf16_t*)(p.ws + WS_U); const bf16_t* BG = (const bf16_t*)(p.ws + WS_BG); const bf16_t* SGA = (const bf16_t*)(p.ws + WS_SGA);
    bf16_t* MIX = (bf16_t*)(p.ws + WS_MIX);
    const int r = lane & 31, g = lane >> 5;
    int tok, head, itok = 0;
    if (SAMPLE) { itok = r >> 3; head = kvh * 8 + (r & 7); tok = TP + 4 * b_s + itok; }
    else { head = head_w; tok = 128 * qb + 32 * c + r; }
    const LAS bf16_t* Ks = (const LAS bf16_t*)lds; const LAS bf16_t* Vt = (const LAS bf16_t*)(lds + VT_OFF);
    bf16x8 qf[4];
#pragma unroll
    for (int ks = 0; ks < 4; ++ks) qf[ks] = *(const bf16x8*)(Q + (size_t)tok * DM + head * 64 + 16 * ks + 8 * g);
    f32x16 s[5];
#pragma unroll
    for (int kbr = 0; kbr < 5; ++kbr) {
#pragma unroll
        for (int i = 0; i < 16; ++i) s[kbr][i] = 0.f;
#pragma unroll
        for (int ks = 0; ks < 4; ++ks) {
            bf16x8 a;
            if (SAMPLE) {
                if (kbr < 4) { const float* kp = p.ck + ((size_t)(b_s * 128 + 32 * kbr + r) * 4 + kvh) * 64 + 16 * ks + 8 * g; a = cvt8(*(const f32x4*)kp, *(const f32x4*)(kp + 4)); }
                else { u32x4 z = (u32x4){0u, 0u, 0u, 0u}; if (r < 4) z = *(const u32x4*)(Kb + (size_t)(TP + 4 * b_s + r) * 256 + kvh * 64 + 16 * ks + 8 * g); a = __builtin_bit_cast(bf16x8, z); }
            } else a = *(const LAS bf16x8*)(Ks + (32 * (c + kbr) + r) * KS_STRIDE + 16 * ks + 8 * g);
            s[kbr] = MFMA32(a, qf[ks], s[kbr]);
        }
    }
    const float sc = 0.125f * 1.44269504089f;
    const float sink2 = p.sinks[head] * 1.44269504089f;
    float mx = sink2;
#pragma unroll
    for (int kbr = 0; kbr < 5; ++kbr)
#pragma unroll
        for (int i = 0; i < 16; ++i) {
            const int kr = crow(i, g); bool valid;
            if (SAMPLE) valid = kbr < 4 ? (32 * kbr + kr > itok) : (kr <= itok);
            else { valid = kbr == 0 ? (kr > r) : (kbr == 4 ? (kr <= r) : true); if (qb == 0 && c + kbr < 4) valid = false; }
            const float t = valid ? s[kbr][i] * sc : -1e30f; s[kbr][i] = t; mx = fmaxf(mx, t);
        }
    mx = fmaxf(mx, __shfl_xor(mx, 32));
    float sum = 0.f;
#pragma unroll
    for (int kbr = 0; kbr < 5; ++kbr)
#pragma unroll
        for (int i = 0; i < 16; ++i) { const float e = __builtin_amdgcn_exp2f(s[kbr][i] - mx); s[kbr][i] = e; sum += e; }
    sum += __shfl_xor(sum, 32);
    const float inv = 1.0f / (sum + __builtin_amdgcn_exp2f(sink2 - mx));
    f32x16 o[2];
#pragma unroll
    for (int dt = 0; dt < 2; ++dt)
#pragma unroll
        for (int i = 0; i < 16; ++i) o[dt][i] = 0.f;
#pragma unroll
    for (int kbr = 0; kbr < 5; ++kbr)
#pragma unroll
        for (int kk = 0; kk < 2; ++kk) {
            const bf16x8 pb = pack8(s[kbr], kk);
#pragma unroll
            for (int dt = 0; dt < 2; ++dt) {
                bf16x8 a; const int d = 32 * dt + r;
                if (SAMPLE) {
                    if (kbr < 4) { float f[8];
#pragma unroll
                        for (int j = 0; j < 8; ++j) { const int key = 32 * kbr + 16 * kk + 8 * (j >> 2) + 4 * g + (j & 3); f[j] = p.cv[((size_t)(b_s * 128 + key) * 4 + kvh) * 64 + d]; }
                        a = cvt8((f32x4){f[0], f[1], f[2], f[3]}, (f32x4){f[4], f[5], f[6], f[7]});
                    } else { u32x4 z = (u32x4){0u, 0u, 0u, 0u};
                        if (kk == 0 && g == 0) { const bf16_t* vp = Vb + (size_t)(TP + 4 * b_s) * 256 + kvh * 64 + d; z.x = (unsigned)vp[0] | ((unsigned)vp[256] << 16); z.y = (unsigned)vp[512] | ((unsigned)vp[768] << 16); }
                        a = __builtin_bit_cast(bf16x8, z); }
                } else {
                    const LAS bf16_t* vp = Vt + d * VT_STRIDE + 32 * (c + kbr) + 16 * kk + 4 * g;
                    const s16x4 lo = *(const LAS s16x4*)vp, hi = *(const LAS s16x4*)(vp + 8);
                    a = __builtin_shufflevector(lo, hi, 0, 1, 2, 3, 4, 5, 6, 7);
                }
                o[dt] = MFMA32(a, pb, o[dt]);
            }
        }
#pragma unroll
    for (int dt = 0; dt < 2; ++dt)
#pragma unroll
        for (int i4 = 0; i4 < 4; ++i4) {
            const int col = head * 64 + 32 * dt + 8 * i4 + 4 * g;
            const f32x4 at = (f32x4){o[dt][4 * i4], o[dt][4 * i4 + 1], o[dt][4 * i4 + 2], o[dt][4 * i4 + 3]} * inv;
            const size_t off = (size_t)tok * DM + col;
            const f32x4 sga = unpk4(*(const u32x2*)(SGA + off)), bg = unpk4(*(const u32x2*)(BG + off)), u0 = unpk4(*(const u32x2*)(U + off));
            f32x4 u1, u2;
            if (SAMPLE) {
                u1 = itok >= 1 ? unpk4(*(const u32x2*)(U + off - DM)) : *(const f32x4*)(p.sconv + (size_t)b_s * 4096 + DM + col);
                u2 = itok >= 2 ? unpk4(*(const u32x2*)(U + off - 2 * DM)) : *(const f32x4*)(p.sconv + (size_t)b_s * 4096 + (size_t)itok * DM + col);
            } else {
                u1 = tok >= 1 ? unpk4(*(const u32x2*)(U + off - DM)) : (f32x4){0.f, 0.f, 0.f, 0.f};
                u2 = tok >= 2 ? unpk4(*(const u32x2*)(U + off - 2 * DM)) : (f32x4){0.f, 0.f, 0.f, 0.f};
            }
            const f32x4 w0 = *(const f32x4*)(p.conv_w + col), w1 = *(const f32x4*)(p.conv_w + DM + col), w2 = *(const f32x4*)(p.conv_w + 2 * DM + col);
            const f32x4 conv = w0 * u2 + w1 * u1 + w2 * u0;
            *(u32x2*)(MIX + off) = pk4(sga * at + bg * conv);
        }
}

DI void p2_attention(const Params& p, LAS unsigned char* lds, int tid, int wid, int lane) {
    const bf16_t* Kb = (const bf16_t*)(p.ws + WS_K); const bf16_t* Vb = (const bf16_t*)(p.ws + WS_V);
    LAS bf16_t* Ks = (LAS bf16_t*)lds; LAS bf16_t* Vt = (LAS bf16_t*)(lds + VT_OFF);
    for (int item = blockIdx.x; item < 256; item += gridDim.x) {
        const int qb = item >> 2, kvh = item & 3;
        __syncthreads();
#pragma unroll
        for (int i = 0; i < 4; ++i) {
            const int e = tid + 512 * i, row = e >> 3, c8 = e & 7, tok = 128 * (qb - 1) + row;
            u32x4 kv = (u32x4){0u, 0u, 0u, 0u}, vv = (u32x4){0u, 0u, 0u, 0u};
            if (tok >= 0) { kv = *(const u32x4*)(Kb + (size_t)tok * 256 + kvh * 64 + 8 * c8); vv = *(const u32x4*)(Vb + (size_t)tok * 256 + kvh * 64 + 8 * c8); }
            *(LAS u32x4*)(Ks + row * KS_STRIDE + 8 * c8) = kv;
#pragma unroll
            for (int jj = 0; jj < 8; ++jj) Vt[(8 * c8 + jj) * VT_STRIDE + row] = (bf16_t)(vv[jj >> 1] >> (16 * (jj & 1)));
        }
        __syncthreads();
        for (int c = 0; c < 4; ++c) attn_chunk<false>(p, lds, qb, c, kvh, kvh * 8 + wid, 0, lane);
    }
    if (wid < 2)
        for (int it = blockIdx.x * 2 + wid; it < 512; it += gridDim.x * 2) attn_chunk<true>(p, lds, 0, 0, it & 3, 0, it >> 2, lane);
}

constexpr int LDS_BYTES = pg8::STAGE_BYTES;

__global__ void __launch_bounds__(512, 2) fwd_megakernel(Params p) {
    extern __shared__ __attribute__((aligned(16))) unsigned char lds_raw[];
    LAS unsigned char* lds = (LAS unsigned char*)lds_raw;
    cg::grid_group grid = cg::this_grid();
    const int tid = threadIdx.x, wid = __builtin_amdgcn_readfirstlane(tid >> 6), lane = tid & 63;
    const int G = gridDim.x, bid = blockIdx.x;
    unsigned char* ws = p.ws;

    p0_prologue(p, lds, wid, lane);
    grid.sync();
    {
        pg8::Gemm g{(const bf16_t*)(ws + WS_XN), (const bf16_t*)(ws + WS_WIN), MT, DIN, DM}; pg8::StaticOrder S; S.init(MT, DIN, G, bid);
        Epi1 E{(bf16_t*)(ws + WS_Q), (bf16_t*)(ws + WS_K), (bf16_t*)(ws + WS_V), (bf16_t*)(ws + WS_U), (bf16_t*)(ws + WS_BG), (bf16_t*)(ws + WS_SGA),
               p.q_norm, p.k_norm, (const float*)(ws + WS_COS), (const float*)(ws + WS_SIN), p.out};
        pg8::gemm_phase<Epi1>(lds, g, S, E);
    }
    grid.sync();
    p2_attention(p, lds, tid, wid, lane);
    grid.sync();
    {
        pg8::Gemm g{(const bf16_t*)(ws + WS_MIX), (const bf16_t*)(ws + WS_WOUT), MT, DM, DM}; pg8::StaticOrder S; S.init(MT, DM, G, bid);
        Epi3 E{p.xp, p.xs, p.norm_ffn, p.out, (bf16_t*)(ws + WS_A2), (float*)(ws + WS_SSQ)};
        pg8::gemm_phase<Epi3>(lds, g, S, E);
    }
    grid.sync();
    {
        pg8::Gemm g{(const bf16_t*)(ws + WS_A2), (const bf16_t*)(ws + WS_WGU), MT, NGU, DM}; pg8::StaticOrder S; S.init(MT, NGU, G, bid);
        Epi4 E{(const float*)(ws + WS_SSQ), (bf16_t*)(ws + WS_HID)};
        pg8::gemm_phase<Epi4>(lds, g, S, E);
    }
    grid.sync();
    {
        pg8::Gemm g{(const bf16_t*)(ws + WS_HID), (const bf16_t*)(ws + WS_WDN), MT, DM, DFF}; pg8::StaticOrder S; S.init(MT, DM, G, bid);
        Epi5 E{p.out};
        pg8::gemm_phase<Epi5>(lds, g, S, E);
    }
}

extern "C" void kernel_launch(void* const* d_in, const int* in_sizes, int n_in, void* d_out, int out_size, void* d_ws, size_t ws_size, hipStream_t stream) {
    static int grid = 0;
    if (!grid) {
        int dev = 0, cus = 0, per_cu = 0;
        (void)hipGetDevice(&dev);
        (void)hipDeviceGetAttribute(&cus, hipDeviceAttributeMultiprocessorCount, dev);
        (void)hipFuncSetAttribute((const void*)fwd_megakernel, hipFuncAttributeMaxDynamicSharedMemorySize, LDS_BYTES);
        (void)hipOccupancyMaxActiveBlocksPerMultiprocessor(&per_cu, (const void*)fwd_megakernel, 512, LDS_BYTES);
        if (per_cu < 1) per_cu = 1;
        grid = cus * per_cu;
        if (ws_size < WS_END) fprintf(stderr, "kernel_launch: workspace too small (%zu < %zu)\n", ws_size, (size_t)WS_END);
    }
    Params p{};
    p.xp = (const float*)d_in[0]; p.xs = (const float*)d_in[1]; p.ck = (const float*)d_in[2]; p.cv = (const float*)d_in[3]; p.sconv = (const float*)d_in[4];
    p.norm_mix = (const float*)d_in[5]; p.w_in = (const float*)d_in[6]; p.q_norm = (const float*)d_in[7]; p.k_norm = (const float*)d_in[8]; p.sinks = (const float*)d_in[9];
    p.conv_w = (const float*)d_in[10]; p.w_out = (const float*)d_in[11]; p.norm_ffn = (const float*)d_in[12]; p.w_gu = (const float*)d_in[13]; p.w_dn = (const float*)d_in[14];
    p.out = (float*)d_out; p.ws = (unsigned char*)d_ws;
    void* args[] = {&p};
    hipError_t e = hipLaunchCooperativeKernel((const void*)fwd_megakernel, dim3(grid), dim3(512), args, LDS_BYTES, stream);
    if (e != hipSuccess) fprintf(stderr, "cooperative launch failed: %s (grid %d)\n", hipGetErrorString(e), grid);
}
```

```cpp
#include <hip/hip_runtime.h>
#include <hip/hip_cooperative_groups.h>
#include <cstdio>
namespace cg = cooperative_groups;
#define REP_P0 1
#define REP_P1 1
#define REP_P2 1
#define REP_P3 1
#define REP_P4 1
#define REP_SYNC 0

#define LAS __attribute__((address_space(3)))
#define DI __device__ __forceinline__
typedef unsigned short bf16_t;
typedef short bf16x8 __attribute__((ext_vector_type(8)));
typedef short s16x4 __attribute__((ext_vector_type(4)));
typedef float f32x4 __attribute__((ext_vector_type(4)));
typedef float f32x16 __attribute__((ext_vector_type(16)));
typedef unsigned u32x4 __attribute__((ext_vector_type(4)));
typedef unsigned u32x2 __attribute__((ext_vector_type(2)));

constexpr int DM = 2048, TP = 8192, TS = 512, MT = TP + TS, DIN = 12800, DFF = 5632, NGU = 2 * DFF;
constexpr float EPS = 1e-6f;
constexpr int NPOS = 8196;
constexpr size_t O_YP = 0, O_YS = (size_t)TP * DM, O_PK = O_YS + (size_t)TS * DM, O_PV = O_PK + 32768, O_PC = O_PV + 32768,
                 O_SK = O_PC + 4096, O_SV = O_SK + 4194304, O_SC = O_SV + 4194304;
constexpr size_t WS_WIN = 0, WS_WOUT = WS_WIN + (size_t)DIN * DM * 2, WS_WGU = WS_WOUT + (size_t)DM * DM * 2, WS_WDN = WS_WGU + (size_t)NGU * DM * 2,
                 WS_XN = WS_WDN + (size_t)DM * DFF * 2, WS_Q = WS_XN + (size_t)MT * DM * 2, WS_K = WS_Q + (size_t)MT * DM * 2, WS_V = WS_K + (size_t)MT * 256 * 2,
                 WS_U = WS_V + (size_t)MT * 256 * 2, WS_BG = WS_U + (size_t)MT * DM * 2, WS_SGA = WS_BG + (size_t)MT * DM * 2, WS_COS = WS_SGA + (size_t)MT * DM * 2,
                 WS_SIN = WS_COS + (size_t)NPOS * 32 * 4, WS_SSQ = WS_SIN + (size_t)NPOS * 32 * 4, WS_BAR = WS_SSQ + (size_t)MT * 32 * 4, WS_END = WS_BAR + 16384;
constexpr size_t WS_MIX = WS_XN, WS_A2 = WS_Q, WS_HID = WS_U;
static_assert((size_t)MT * DFF * 2 <= 3 * (size_t)MT * DM * 2, "hidden fits in U|BG|SGA");

struct Params {
    const float *xp, *xs, *ck, *cv, *sconv, *norm_mix, *w_in, *q_norm, *k_norm, *sinks, *conv_w, *w_out, *norm_ffn, *w_gu, *w_dn;
    float* out; unsigned char* ws; long never;
};

typedef float f32x2 __attribute__((ext_vector_type(2)));
typedef __bf16 bf16x2v __attribute__((ext_vector_type(2)));
DI unsigned pk2(float lo, float hi) { const f32x2 f = {lo, hi}; return __builtin_bit_cast(unsigned, __builtin_convertvector(f, bf16x2v)); }
DI u32x2 pk4(f32x4 v) { u32x2 r; r.x = pk2(v[0], v[1]); r.y = pk2(v[2], v[3]); return r; }
DI float bf_lo(unsigned w) { return __uint_as_float(w << 16); }
DI float bf_hi(unsigned w) { return __uint_as_float(w & 0xffff0000u); }
DI f32x4 unpk4(u32x2 w) { return (f32x4){bf_lo(w.x), bf_hi(w.x), bf_lo(w.y), bf_hi(w.y)}; }
DI float sigmoidf_(float x) { return __builtin_amdgcn_rcpf(1.0f + __builtin_amdgcn_exp2f(-1.44269504089f * x)); }
DI float wave_sum(float v) {
#pragma unroll
    for (int o = 1; o < 64; o <<= 1) v += __shfl_xor(v, o);
    return v;
}


#define XB_TMO      128
#define XB_XCNT(j)  (256  + 64 * (j))
#define XB_XSUB(j)  (1280 + 64 * (j))
#define XB_XGEN(j)  (2304 + 64 * (j))
#define XB_TOP      3328
#define XB_TOPGEN   3392
#define XCD_BAR_WORDS 3456
#define XB_SPIN_CAP (1u << 20)
DI unsigned xb_ld(unsigned* p)              { return __hip_atomic_load(p, __ATOMIC_RELAXED, __HIP_MEMORY_SCOPE_AGENT); }
DI unsigned xb_add(unsigned* p, unsigned v) { return __hip_atomic_fetch_add(p, v, __ATOMIC_RELAXED, __HIP_MEMORY_SCOPE_AGENT); }
DI unsigned xb_xcc_id() { return (unsigned)__builtin_amdgcn_s_getreg((3 << 11) | 20) & 0xFu; }
#define XB_SPIN(cond, bar) do { unsigned _sp = 0; while (cond) { __builtin_amdgcn_s_sleep(1); \
    if ((++_sp & 255u) == 0u) { if (xb_ld(&(bar)[XB_TMO])) break; if (_sp > XB_SPIN_CAP) { atomicAdd(&(bar)[XB_TMO], 1u); break; } } } } while (0)
struct XcdBarrier { unsigned* bar; unsigned x; volatile LAS unsigned* st; };
DI XcdBarrier xcd_barrier_post(unsigned* bar, volatile LAS unsigned* st) {
    XcdBarrier b; b.bar = bar; b.x = xb_xcc_id(); b.st = st;
    if (threadIdx.x == 0) (void)xb_add(&bar[XB_XCNT(b.x)], 1u);
    return b;
}
DI void xcd_barrier_complete(unsigned* bar, unsigned x, unsigned& nloc, unsigned& nx) {
    const unsigned G = gridDim.x * gridDim.y * gridDim.z;
    unsigned sum, cnt, mine, sp = 0u;
    for (;;) {
        sum = 0u; cnt = 0u; mine = 0u;
#pragma unroll
        for (unsigned j = 0; j < 16; ++j) { const unsigned c = xb_ld(&bar[XB_XCNT(j)]); sum += c; cnt += (c > 0u) ? 1u : 0u; mine = (j == x) ? c : mine; }
        if (sum == G) break;
        __builtin_amdgcn_s_sleep(1);
        if ((++sp & 255u) == 0u) { if (xb_ld(&bar[XB_TMO])) break; if (sp > XB_SPIN_CAP) { atomicAdd(&bar[XB_TMO], 1u); break; } }
    }
    nloc = mine > 0u ? mine : 1u; nx = cnt > 0u ? cnt : 1u;
}
DI void xcd_barrier(const XcdBarrier& b) {
    asm volatile("s_waitcnt vmcnt(0)" ::: "memory");
    __syncthreads();
    if (threadIdx.x == 0) {
        unsigned* bar = b.bar;
        __builtin_amdgcn_s_waitcnt(0);
        unsigned nloc = b.st[0], nx = b.st[1];
        if (nloc == 0u) { xcd_barrier_complete(bar, b.x, nloc, nx); b.st[0] = nloc; b.st[1] = nx; }
        const unsigned old = xb_add(&bar[XB_XSUB(b.x)], 1u);
        const unsigned gen = old / nloc;
        if (old + 1u == (gen + 1u) * nloc) {
            __builtin_amdgcn_fence(__ATOMIC_RELEASE, "agent");
            asm volatile("s_waitcnt vmcnt(0)" ::: "memory");
            const unsigned og = xb_add(&bar[XB_TOP], 1u);
            const unsigned tg = og / nx;
            if (og + 1u == (tg + 1u) * nx) xb_add(&bar[XB_TOPGEN], 1u);
            else XB_SPIN(xb_ld(&bar[XB_TOPGEN]) == tg, bar);
            __builtin_amdgcn_fence(__ATOMIC_ACQUIRE, "agent");
            xb_add(&bar[XB_XGEN(b.x)], 1u);
            asm volatile("s_waitcnt vmcnt(0)" ::: "memory");
        } else {
            XB_SPIN(xb_ld(&bar[XB_XGEN(b.x)]) == gen, bar);
            __builtin_amdgcn_fence(__ATOMIC_ACQUIRE, "agent");
            asm volatile("s_waitcnt vmcnt(0)" ::: "memory");
        }
    }
    __syncthreads();
}

namespace pg8 {
constexpr int BM = 256, BK = 64, HALF = 128, HTB = HALF * BK * 2, STAGE_BYTES = 8 * HTB, NXCD = 8, WGM = 8;
DI int lds_byte(int r, int c) { const int st = (r >> 4) * 2 + (c >> 5), rr = r & 15, cc = c & 31, ob = rr * 64 + cc * 2; return st * 1024 + (ob ^ (((ob >> 9) & 1) << 5)); }
DI void stage_rc(int b, int& R, int& C) { const int st = b / 1024, sb = b % 1024, swz = sb ^ (((sb >> 9) & 1) << 5); R = (st >> 1) * 16 + swz / 64; C = (st & 1) * 32 + (swz % 64) / 2; }
struct Unit { int pm, pn; };
struct Gemm { const bf16_t* A; const bf16_t* Bt; int M, N, K; };
struct StaticOrder {
    int nM, nN, nwg, G, c;
    DI void init(int M, int N, int G_, int c_) { nM = M / BM; nN = N / BM; nwg = nM * nN; G = G_; c = c_; }
    DI bool next(int i, Unit& u) const {
        const long L = (long)i * G + c; if (L >= nwg) return false;
        int wgid = (int)L; { const int q = nwg / NXCD, r = nwg % NXCD, xcd = wgid % NXCD, off = wgid / NXCD; wgid = (xcd < r ? xcd * (q + 1) : r * (q + 1) + (xcd - r) * q) + off; }
        const int nig = WGM * nN, gid = wgid / nig, fm = gid * WGM, gsz = (nM - fm) < WGM ? (nM - fm) : WGM;
        u.pm = fm + ((wgid % nig) % gsz); u.pn = (wgid % nig) / gsz; return true;
    }
};

template <class Epi>
DI void gemm_phase(LAS unsigned char* lds, const Gemm g, const StaticOrder& S, const Epi& E) {
    const int tid = threadIdx.x, wid = __builtin_amdgcn_readfirstlane(tid >> 6), lane = tid & 63, wr = wid >> 2, wc = wid & 3, fr = lane & 15, fq = lane >> 4;
    const int K = g.K, nt = K / BK;
    unsigned voffA[2];
#pragma unroll
    for (int i = 0; i < 2; ++i) { int R, C; stage_rc(tid * 16 + i * 8192, R, C); voffA[i] = (unsigned)(R * K + C) * 2u; }
    const size_t kstep = (size_t)(BK * 2);
    const size_t hstep = (size_t)HALF * K * 2;
    const size_t tstep = 2 * hstep;
    const unsigned ldsw = (unsigned)wid * 1024u;
    const int aoff = lds_byte(wr * 64 + fr, fq * 8), boff = lds_byte(wc * 32 + fr, fq * 8);
#define PG8_SA(b, h) (((b) * 2 + (h)) * HTB)
#define PG8_SB(b, h) ((4 + (b) * 2 + (h)) * HTB)
#define PG8_STAGE(bufoff, gbase) do { _Pragma("unroll") for (int _i = 0; _i < 2; ++_i) \
        __builtin_amdgcn_global_load_lds((const unsigned*)((const char*)(gbase) + voffA[_i]), (LAS unsigned*)(lds + (bufoff) + ldsw + _i * 8192), 16, 0, 0); } while (0)
#define PG8_LDA(dst, b, h) do { _Pragma("unroll") for (int m = 0; m < 4; ++m) _Pragma("unroll") for (int k = 0; k < 2; ++k) dst[m][k] = *(const LAS bf16x8*)(lds + PG8_SA(b, h) + aoff + m * 2048 + k * 1024); } while (0)
#define PG8_LDB(dst, b, h) do { _Pragma("unroll") for (int n = 0; n < 2; ++n) _Pragma("unroll") for (int k = 0; k < 2; ++k) dst[n][k] = *(const LAS bf16x8*)(lds + PG8_SB(b, h) + boff + n * 2048 + k * 1024); } while (0)
#define PG8_MMA(ai, bj, At, Bt) do { __builtin_amdgcn_s_setprio(1); _Pragma("unroll") for (int m = 0; m < 4; ++m) _Pragma("unroll") for (int n = 0; n < 2; ++n) _Pragma("unroll") for (int k = 0; k < 2; ++k) \
        acc[ai][bj][m][n] = __builtin_amdgcn_mfma_f32_16x16x32_bf16(Bt[n][k], At[m][k], acc[ai][bj][m][n], 0, 0, 0); __builtin_amdgcn_s_setprio(0); } while (0)
#define PG8_WAIT_V(n) asm volatile("s_waitcnt vmcnt(" #n ")" ::: "memory")
#define PG8_WAIT_L(n) asm volatile("s_waitcnt lgkmcnt(" #n ")" ::: "memory")
#define PG8_BAR __builtin_amdgcn_s_barrier()
#define PG8_SCHED __builtin_amdgcn_sched_barrier(0)
    Unit cur, nxt; int ui = 0;
    if (!S.next(0, cur)) return;
    f32x4 acc[2][2][4][2];
#pragma unroll
    for (int a = 0; a < 2; ++a)
#pragma unroll
        for (int b = 0; b < 2; ++b)
#pragma unroll
            for (int m = 0; m < 4; ++m)
#pragma unroll
                for (int n = 0; n < 2; ++n) acc[a][b][m][n] = (f32x4){0.f, 0.f, 0.f, 0.f};
    bf16x8 At[4][2], B0[2][2], B1[2][2];
    const char* cA = (const char*)g.A + (size_t)cur.pm * tstep; const char* cB = (const char*)g.Bt + (size_t)cur.pn * tstep;
    PG8_STAGE(PG8_SB(0, 0), cB); PG8_STAGE(PG8_SA(0, 0), cA); PG8_STAGE(PG8_SB(0, 1), cB + hstep); PG8_STAGE(PG8_SA(0, 1), cA + hstep);
    if (wr == 1) PG8_BAR;
    PG8_WAIT_V(4); PG8_BAR;
    PG8_STAGE(PG8_SB(1, 0), cB + kstep); PG8_STAGE(PG8_SA(1, 0), cA + kstep); PG8_STAGE(PG8_SB(1, 1), cB + hstep + kstep);
    PG8_WAIT_V(6); PG8_BAR;
    for (;;) {
        const bool has_next = S.next(ui + 1, nxt);
        const char* nA = has_next ? (const char*)g.A + (size_t)nxt.pm * tstep : cA; const char* nB = has_next ? (const char*)g.Bt + (size_t)nxt.pn * tstep : cB;
        for (int t = 0; t < nt; t += 2) {
            const bool last = (t == nt - 2);
            const char* a1 = cA + (size_t)(t + 1) * kstep;
            const char* a2 = last ? nA : cA + (size_t)(t + 2) * kstep; const char* b2 = last ? nB : cB + (size_t)(t + 2) * kstep;
            const char* a3 = a2 + kstep; const char* b3 = b2 + kstep;
            PG8_LDB(B0, 0, 0); PG8_SCHED; PG8_LDA(At, 0, 0); PG8_STAGE(PG8_SA(1, 1), a1 + hstep);
            PG8_WAIT_L(8); PG8_BAR; PG8_WAIT_L(0); PG8_MMA(0, 0, At, B0); PG8_BAR; PG8_SCHED;
            PG8_LDB(B1, 0, 1); PG8_STAGE(PG8_SB(0, 0), b2);
            PG8_BAR; PG8_WAIT_L(0); PG8_MMA(0, 1, At, B1); PG8_BAR;
            PG8_LDA(At, 0, 1); PG8_STAGE(PG8_SA(0, 0), a2);
            PG8_BAR; PG8_WAIT_L(0); PG8_MMA(1, 0, At, B0); PG8_BAR; PG8_SCHED;
            PG8_STAGE(PG8_SB(0, 1), b2 + hstep);
            PG8_WAIT_V(6); PG8_BAR; PG8_MMA(1, 1, At, B1); PG8_BAR;
            PG8_LDB(B0, 1, 0); PG8_SCHED; PG8_LDA(At, 1, 0); PG8_STAGE(PG8_SA(0, 1), a2 + hstep);
            PG8_WAIT_L(8); PG8_BAR; PG8_WAIT_L(0); PG8_MMA(0, 0, At, B0); PG8_BAR; PG8_SCHED;
            PG8_LDB(B1, 1, 1); PG8_STAGE(PG8_SB(1, 0), b3);
            PG8_BAR; PG8_WAIT_L(0); PG8_MMA(0, 1, At, B1); PG8_BAR;
            PG8_LDA(At, 1, 1); PG8_STAGE(PG8_SA(1, 0), a3);
            PG8_BAR; PG8_WAIT_L(0); PG8_MMA(1, 0, At, B0); PG8_BAR; PG8_SCHED;
            PG8_STAGE(PG8_SB(1, 1), b3 + hstep);
            PG8_WAIT_V(6); PG8_BAR; PG8_MMA(1, 1, At, B1); PG8_BAR;
        }
        E(acc, cur, wr, wc, fr, fq);
        if (!has_next) break;
#pragma unroll
        for (int a = 0; a < 2; ++a)
#pragma unroll
            for (int b = 0; b < 2; ++b)
#pragma unroll
                for (int m = 0; m < 4; ++m)
#pragma unroll
                    for (int n = 0; n < 2; ++n) acc[a][b][m][n] = (f32x4){0.f, 0.f, 0.f, 0.f};
        cur = nxt; cA = nA; cB = nB; ++ui;
    }
    PG8_WAIT_V(0);
    if (wr == 0) PG8_BAR;
    PG8_BAR;
#undef PG8_SA
#undef PG8_SB
#undef PG8_STAGE
#undef PG8_LDA
#undef PG8_LDB
#undef PG8_MMA
#undef PG8_WAIT_V
#undef PG8_WAIT_L
#undef PG8_BAR
#undef PG8_SCHED
}
}

typedef f32x4 AccT[2][2][4][2];

DI int src_col_in(int R) {
    const int pn = R >> 8, c = R & 255, bj = c >> 7, wc = (c >> 5) & 3, r5 = c & 31;
    if (pn < 8) return (4 * pn + wc) * 64 + 32 * bj + r5;
    if (pn == 8) return 2048 + wc * 64 + 32 * bj + r5;
    if (pn == 9) return 2304 + c;
    if (pn < 26) return (bj ? 6656 : 2560) + 128 * (pn - 10) + (c & 127);
    if (pn < 42) return (bj ? 10752 : 4608) + 128 * (pn - 26) + (c & 127);
    return 8704 + 256 * (pn - 42) + c;
}
DI int src_col_gu(int R) { const int t = R >> 8, c = R & 255; return ((c >> 7) ? DFF : 0) + 128 * t + (c & 127); }

struct Epi1 {
    bf16_t *Q, *Kb, *Vb, *U, *BG, *SGA; const float *qg, *kg, *cosT, *sinT; float* out;
    DI void side_kv(float* pwin, float* swin, int row, int col, f32x4 v) const {
        if (row >= TP - 128 && row < TP) *(f32x4*)(pwin + (size_t)(row - (TP - 128)) * 256 + col) = v;
        if (row >= TP) { const int b = (row - TP) >> 2, i = (row - TP) & 3; *(f32x4*)(swin + (size_t)b * 32768 + (size_t)(124 + i) * 256 + col) = v; }
    }
    DI void operator()(const AccT& acc, const pg8::Unit& u, int wr, int wc, int fr, int fq) const {
        asm volatile("" : "+v"(fr), "+v"(fq));
        const int pn = u.pn, row0 = u.pm * 256 + wr * 64 + fr;
        if (pn < 9) {
            const float* g = pn < 8 ? qg : kg;
            f32x4 gv[2][2];
#pragma unroll
            for (int bj = 0; bj < 2; ++bj)
#pragma unroll
                for (int n = 0; n < 2; ++n) gv[bj][n] = *(const f32x4*)(g + 32 * bj + 16 * n + 4 * fq);
#pragma unroll
            for (int ai = 0; ai < 2; ++ai)
#pragma unroll
                for (int m = 0; m < 4; ++m) {
                    const int row = row0 + 128 * ai + 16 * m;
                    const int pos = row < TP ? row : TP + ((row - TP) & 3);
                    float ssq = 0.f;
#pragma unroll
                    for (int bj = 0; bj < 2; ++bj)
#pragma unroll
                        for (int n = 0; n < 2; ++n) { const f32x4 x = acc[ai][bj][m][n]; ssq += (x[0] * x[0] + x[1] * x[1]) + (x[2] * x[2] + x[3] * x[3]); }
                    ssq += __shfl_xor(ssq, 16); ssq += __shfl_xor(ssq, 32);
                    const float rs = 1.0f / sqrtf(ssq * (1.0f / 64.0f) + EPS);
#pragma unroll
                    for (int n = 0; n < 2; ++n) {
                        const f32x4 cs = *(const f32x4*)(cosT + (size_t)pos * 32 + 16 * n + 4 * fq), sn = *(const f32x4*)(sinT + (size_t)pos * 32 + 16 * n + 4 * fq);
                        const f32x4 y1 = acc[ai][0][m][n] * rs * gv[0][n], y2 = acc[ai][1][m][n] * rs * gv[1][n];
                        const f32x4 o1 = y1 * cs - y2 * sn, o2 = y2 * cs + y1 * sn;
                        const int d = 16 * n + 4 * fq;
                        if (pn < 8) {
                            bf16_t* qp = Q + (size_t)row * DM + (4 * pn + wc) * 64 + d;
                            *(u32x2*)qp = pk4(o1); *(u32x2*)(qp + 32) = pk4(o2);
                        } else {
                            bf16_t* kp = Kb + (size_t)row * 256 + wc * 64 + d;
                            *(u32x2*)kp = pk4(o1); *(u32x2*)(kp + 32) = pk4(o2);
                            side_kv(out + O_PK, out + O_SK, row, wc * 64 + d, o1); side_kv(out + O_PK, out + O_SK, row, wc * 64 + d + 32, o2);
                        }
                    }
                }
        } else if (pn == 9) {
#pragma unroll
            for (int ai = 0; ai < 2; ++ai)
#pragma unroll
                for (int m = 0; m < 4; ++m) {
                    const int row = row0 + 128 * ai + 16 * m;
#pragma unroll
                    for (int bj = 0; bj < 2; ++bj)
#pragma unroll
                        for (int n = 0; n < 2; ++n) { const int col = 128 * bj + 32 * wc + 16 * n + 4 * fq; const f32x4 v = acc[ai][bj][m][n];
                            *(u32x2*)(Vb + (size_t)row * 256 + col) = pk4(v); side_kv(out + O_PV, out + O_SV, row, col, v); }
                }
        } else if (pn < 26) {
            const int t = pn - 10;
#pragma unroll
            for (int ai = 0; ai < 2; ++ai)
#pragma unroll
                for (int m = 0; m < 4; ++m) {
                    const int row = row0 + 128 * ai + 16 * m;
#pragma unroll
                    for (int n = 0; n < 2; ++n) { const int col = 128 * t + 32 * wc + 16 * n + 4 * fq; const f32x4 v = acc[ai][0][m][n] * acc[ai][1][m][n];
                        *(u32x2*)(U + (size_t)row * DM + col) = pk4(v);
                        if (row >= TP - 2 && row < TP) *(f32x4*)(out + O_PC + (size_t)(row - (TP - 2)) * DM + col) = v;
                        if (row >= TP && ((row - TP) & 3) >= 2) { const int b = (row - TP) >> 2, i = (row - TP) & 3; *(f32x4*)(out + O_SC + (size_t)b * 4096 + (size_t)(i - 2) * DM + col) = v; } }
                }
        } else if (pn < 42) {
            const int t = pn - 26;
#pragma unroll
            for (int ai = 0; ai < 2; ++ai)
#pragma unroll
                for (int m = 0; m < 4; ++m) {
                    const int row = row0 + 128 * ai + 16 * m;
#pragma unroll
                    for (int n = 0; n < 2; ++n) { const int col = 128 * t + 32 * wc + 16 * n + 4 * fq; const f32x4 b = acc[ai][0][m][n], gc = acc[ai][1][m][n];
                        f32x4 v; v[0] = b[0] * sigmoidf_(gc[0]); v[1] = b[1] * sigmoidf_(gc[1]); v[2] = b[2] * sigmoidf_(gc[2]); v[3] = b[3] * sigmoidf_(gc[3]);
                        *(u32x2*)(BG + (size_t)row * DM + col) = pk4(v); }
                }
        } else {
#pragma unroll
            for (int ai = 0; ai < 2; ++ai)
#pragma unroll
                for (int m = 0; m < 4; ++m) {
                    const int row = row0 + 128 * ai + 16 * m;
#pragma unroll
                    for (int bj = 0; bj < 2; ++bj)
#pragma unroll
                        for (int n = 0; n < 2; ++n) { const int col = 256 * (pn - 42) + 128 * bj + 32 * wc + 16 * n + 4 * fq; const f32x4 a = acc[ai][bj][m][n];
                            f32x4 v; v[0] = sigmoidf_(a[0]); v[1] = sigmoidf_(a[1]); v[2] = sigmoidf_(a[2]); v[3] = sigmoidf_(a[3]);
                            *(u32x2*)(SGA + (size_t)row * DM + col) = pk4(v); }
                }
        }
    }
};

struct Epi3 {
    const float *xp, *xs, *gffn; float* Y; bf16_t* A2; float* SSQ;
    DI void operator()(const AccT& acc, const pg8::Unit& u, int wr, int wc, int fr, int fq) const {
        asm volatile("" : "+v"(fr), "+v"(fq));
        const int row0 = u.pm * 256 + wr * 64 + fr, col0 = u.pn * 256 + wc * 32 + 4 * fq;
        const float* xb = u.pm < 32 ? xp : xs - (size_t)TP * DM;
        f32x4 gv[2][2];
#pragma unroll
        for (int bj = 0; bj < 2; ++bj)
#pragma unroll
            for (int n = 0; n < 2; ++n) gv[bj][n] = *(const f32x4*)(gffn + col0 + 128 * bj + 16 * n);
#pragma unroll
        for (int ai = 0; ai < 2; ++ai)
#pragma unroll
            for (int m = 0; m < 4; ++m) {
                const int row = row0 + 128 * ai + 16 * m; float ssq = 0.f;
#pragma unroll
                for (int bj = 0; bj < 2; ++bj)
#pragma unroll
                    for (int n = 0; n < 2; ++n) { const size_t off = (size_t)row * DM + col0 + 128 * bj + 16 * n;
                        const f32x4 y = *(const f32x4*)(xb + off) + acc[ai][bj][m][n];
                        ssq += (y[0] * y[0] + y[1] * y[1]) + (y[2] * y[2] + y[3] * y[3]);
                        *(f32x4*)(Y + off) = y; *(u32x2*)(A2 + off) = pk4(y * gv[bj][n]); }
                ssq += __shfl_xor(ssq, 16); ssq += __shfl_xor(ssq, 32);
                if (fq == 0) SSQ[(size_t)row * 32 + u.pn * 4 + wc] = ssq;
            }
    }
};

struct Epi4 {
    const float* SSQ; bf16_t* HID;
    DI void operator()(const AccT& acc, const pg8::Unit& u, int wr, int wc, int fr, int fq) const {
        asm volatile("" : "+v"(fr), "+v"(fq));
        const int row0 = u.pm * 256 + wr * 64 + fr, col0 = u.pn * 128 + wc * 32 + 4 * fq;
#pragma unroll
        for (int ai = 0; ai < 2; ++ai)
#pragma unroll
            for (int m = 0; m < 4; ++m) {
                const int row = row0 + 128 * ai + 16 * m;
                const f32x4* sp = (const f32x4*)(SSQ + (size_t)row * 32); f32x4 s4 = sp[0];
#pragma unroll
                for (int k = 1; k < 8; ++k) s4 += sp[k];
                const float rstd = 1.0f / sqrtf(((s4[0] + s4[1]) + (s4[2] + s4[3])) * (1.0f / DM) + EPS);
#pragma unroll
                for (int n = 0; n < 2; ++n) { const f32x4 g = acc[ai][0][m][n] * rstd, up = acc[ai][1][m][n] * rstd;
                    f32x4 h; h[0] = g[0] * sigmoidf_(g[0]) * up[0]; h[1] = g[1] * sigmoidf_(g[1]) * up[1]; h[2] = g[2] * sigmoidf_(g[2]) * up[2]; h[3] = g[3] * sigmoidf_(g[3]) * up[3];
                    *(u32x2*)(HID + (size_t)row * DFF + col0 + 16 * n) = pk4(h); }
            }
    }
};

struct Epi5 {
    float* Y;
    DI void operator()(const AccT& acc, const pg8::Unit& u, int wr, int wc, int fr, int fq) const {
        asm volatile("" : "+v"(fr), "+v"(fq));
        const int row0 = u.pm * 256 + wr * 64 + fr, col0 = u.pn * 256 + wc * 32 + 4 * fq;
#pragma unroll
        for (int ai = 0; ai < 2; ++ai)
#pragma unroll
            for (int m = 0; m < 4; ++m) {
                const int row = row0 + 128 * ai + 16 * m;
#pragma unroll
                for (int bj = 0; bj < 2; ++bj)
#pragma unroll
                    for (int n = 0; n < 2; ++n) { float* yp = Y + (size_t)row * DM + col0 + 128 * bj + 16 * n; *(f32x4*)yp = *(const f32x4*)yp + acc[ai][bj][m][n]; }
            }
    }
};

DI void p0_transpose_item(const float* W, int K, int N, bf16_t* WT, int src_n0, int dst_n0, int k0, LAS float* scr, int lane) {
#pragma unroll 8
    for (int i = 0; i < 32; ++i) { const int kk = 2 * i + (lane >> 5); scr[kk * 33 + (lane & 31)] = W[(size_t)(k0 + kk) * N + src_n0 + (lane & 31)]; }
    asm volatile("s_waitcnt lgkmcnt(0)" ::: "memory");
    const int c = lane & 7;
#pragma unroll
    for (int j = 0; j < 4; ++j) { const int n = (lane >> 3) + 8 * j; const LAS float* s = scr + (8 * c) * 33 + n;
        u32x4 o; o.x = pk2(s[0 * 33], s[1 * 33]); o.y = pk2(s[2 * 33], s[3 * 33]); o.z = pk2(s[4 * 33], s[5 * 33]); o.w = pk2(s[6 * 33], s[7 * 33]);
        *(u32x4*)(WT + (size_t)(dst_n0 + n) * K + k0 + 8 * c) = o; }
    asm volatile("s_waitcnt lgkmcnt(0)" ::: "memory");
}

DI void p0_prologue(const Params& p, LAS unsigned char* lds, int wid, int lane) {
    LAS float* scr = (LAS float*)(lds + wid * 8704);
    const int gw = blockIdx.x * 8 + wid, NGW = gridDim.x * 8;
    bf16_t* WinT = (bf16_t*)(p.ws + WS_WIN); bf16_t* WoutT = (bf16_t*)(p.ws + WS_WOUT); bf16_t* WguT = (bf16_t*)(p.ws + WS_WGU); bf16_t* WdnT = (bf16_t*)(p.ws + WS_WDN);
    constexpr int I_IN = (DM / 64) * (DIN / 32), I_OUT = (DM / 64) * (DM / 32), I_GU = (DM / 64) * (NGU / 32), I_DN = (DFF / 64) * (DM / 32);
    constexpr int NITEMS = I_IN + I_OUT + I_GU + I_DN;
    for (int it = gw; it < NITEMS; it += NGW) {
        int r = it;
        if (r < I_IN) { const int nblk = DIN / 32, kb = r / nblk, nb = r % nblk; p0_transpose_item(p.w_in, DM, DIN, WinT, src_col_in(32 * nb), 32 * nb, 64 * kb, scr, lane); continue; } r -= I_IN;
        if (r < I_OUT) { const int nblk = DM / 32, kb = r / nblk, nb = r % nblk; p0_transpose_item(p.w_out, DM, DM, WoutT, 32 * nb, 32 * nb, 64 * kb, scr, lane); continue; } r -= I_OUT;
        if (r < I_GU) { const int nblk = NGU / 32, kb = r / nblk, nb = r % nblk; p0_transpose_item(p.w_gu, DM, NGU, WguT, src_col_gu(32 * nb), 32 * nb, 64 * kb, scr, lane); continue; } r -= I_GU;
        { const int nblk = DM / 32, kb = r / nblk, nb = r % nblk; p0_transpose_item(p.w_dn, DFF, DM, WdnT, 32 * nb, 32 * nb, 64 * kb, scr, lane); }
    }
    bf16_t* XN = (bf16_t*)(p.ws + WS_XN);
    for (int m = gw; m < MT; m += NGW) {
        const float* xrow = m < TP ? p.xp + (size_t)m * DM : p.xs + (size_t)(m - TP) * DM;
        const f32x4* xr = (const f32x4*)xrow + lane; f32x4 v[8]; float s = 0.f;
#pragma unroll
        for (int j = 0; j < 8; ++j) { v[j] = xr[64 * j]; s += (v[j][0] * v[j][0] + v[j][1] * v[j][1]) + (v[j][2] * v[j][2] + v[j][3] * v[j][3]); }
        const float rstd = 1.0f / sqrtf(wave_sum(s) * (1.0f / DM) + EPS);
        u32x2* o8 = (u32x2*)(XN + (size_t)m * DM) + lane;
#pragma unroll
        for (int j = 0; j < 8; ++j) { const f32x4 gv = ((const f32x4*)p.norm_mix)[64 * j + lane]; o8[64 * j] = pk4(v[j] * rstd * gv); }
    }
    float* cosT = (float*)(p.ws + WS_COS); float* sinT = (float*)(p.ws + WS_SIN);
    const int gt = blockIdx.x * 512 + threadIdx.x, GT = gridDim.x * 512;
    for (int idx = gt; idx < NPOS * 32; idx += GT) {
        const int pos = idx >> 5, i = idx & 31;
        const float inv = __builtin_amdgcn_exp2f(-(float)i * (13.287712379549449f / 32.0f));
        const float ang = (float)pos * inv;
        const double rev = (double)ang * 0.15915494309189535; const float fr = (float)(rev - __builtin_floor(rev));
        cosT[idx] = __builtin_amdgcn_cosf(fr); sinT[idx] = __builtin_amdgcn_sinf(fr);
    }
    for (int idx = gt; idx < 128 * 7936; idx += GT) {
        const int b = idx / 7936, e = idx - b * 7936;
        ((f32x4*)(p.out + O_SK + (size_t)b * 32768))[e] = ((const f32x4*)(p.ck + (size_t)b * 32768 + 1024))[e];
        ((f32x4*)(p.out + O_SV + (size_t)b * 32768))[e] = ((const f32x4*)(p.cv + (size_t)b * 32768 + 1024))[e];
    }
}

#define MFMA32(a, b, c) __builtin_amdgcn_mfma_f32_32x32x16_bf16((a), (b), (c), 0, 0, 0)
DI int crow(int reg, int h) { return (reg & 3) + 8 * (reg >> 2) + 4 * h; }
DI bf16x8 pack8(const f32x16& x, int s) {
    u32x4 p; p.x = pk2(x[8 * s], x[8 * s + 1]); p.y = pk2(x[8 * s + 2], x[8 * s + 3]); p.z = pk2(x[8 * s + 4], x[8 * s + 5]); p.w = pk2(x[8 * s + 6], x[8 * s + 7]);
    return __builtin_bit_cast(bf16x8, p);
}
DI bf16x8 cvt8(f32x4 a, f32x4 b) { u32x4 p; p.x = pk2(a[0], a[1]); p.y = pk2(a[2], a[3]); p.z = pk2(b[0], b[1]); p.w = pk2(b[2], b[3]); return __builtin_bit_cast(bf16x8, p); }

constexpr int KS_STRIDE = 72, VT_STRIDE = 260, VT_OFF = 256 * KS_STRIDE * 2;

template <bool SAMPLE>
DI void attn_chunk(const Params& p, LAS unsigned char* lds, int qb, int c, int kvh, int head_w, int b_s, int lane) {
    const bf16_t* Q = (const bf16_t*)(p.ws + WS_Q); const bf16_t* Kb = (const bf16_t*)(p.ws + WS_K); const bf16_t* Vb = (const bf16_t*)(p.ws + WS_V);
    const bf16_t* U = (const bf16_t*)(p.ws + WS_U); const bf16_t* BG = (const bf16_t*)(p.ws + WS_BG); const bf16_t* SGA = (const bf16_t*)(p.ws + WS_SGA);
    bf16_t* MIX = (bf16_t*)(p.ws + WS_MIX);
    const int r = lane & 31, g = lane >> 5;
    int tok, head, itok = 0;
    if (SAMPLE) { itok = r >> 3; head = kvh * 8 + (r & 7); tok = TP + 4 * b_s + itok; }
    else { head = head_w; tok = 128 * qb + 32 * c + r; }
    const LAS bf16_t* Ks = (const LAS bf16_t*)lds; const LAS bf16_t* Vt = (const LAS bf16_t*)(lds + VT_OFF);
    bf16x8 qf[4];
#pragma unroll
    for (int ks = 0; ks < 4; ++ks) qf[ks] = *(const bf16x8*)(Q + (size_t)tok * DM + head * 64 + 16 * ks + 8 * g);
    f32x16 s[5];
#pragma unroll
    for (int kbr = 0; kbr < 5; ++kbr) {
#pragma unroll
        for (int i = 0; i < 16; ++i) s[kbr][i] = 0.f;
#pragma unroll
        for (int ks = 0; ks < 4; ++ks) {
            bf16x8 a;
            if (SAMPLE) {
                if (kbr < 4) { const float* kp = p.ck + ((size_t)(b_s * 128 + 32 * kbr + r) * 4 + kvh) * 64 + 16 * ks + 8 * g; a = cvt8(*(const f32x4*)kp, *(const f32x4*)(kp + 4)); }
                else { u32x4 z = (u32x4){0u, 0u, 0u, 0u}; if (r < 4) z = *(const u32x4*)(Kb + (size_t)(TP + 4 * b_s + r) * 256 + kvh * 64 + 16 * ks + 8 * g); a = __builtin_bit_cast(bf16x8, z); }
            } else a = *(const LAS bf16x8*)(Ks + (32 * (c + kbr) + r) * KS_STRIDE + 16 * ks + 8 * g);
            s[kbr] = MFMA32(a, qf[ks], s[kbr]);
        }
    }
    const float sc = 0.125f * 1.44269504089f;
    const float sink2 = p.sinks[head] * 1.44269504089f;
    float mx = sink2;
#pragma unroll
    for (int kbr = 0; kbr < 5; ++kbr)
#pragma unroll
        for (int i = 0; i < 16; ++i) {
            const int kr = crow(i, g); bool valid;
            if (SAMPLE) valid = kbr < 4 ? (32 * kbr + kr > itok) : (kr <= itok);
            else { valid = kbr == 0 ? (kr > r) : (kbr == 4 ? (kr <= r) : true); if (qb == 0 && c + kbr < 4) valid = false; }
            const float t = valid ? s[kbr][i] * sc : -1e30f; s[kbr][i] = t; mx = fmaxf(mx, t);
        }
    mx = fmaxf(mx, __shfl_xor(mx, 32));
    float sum = 0.f;
#pragma unroll
    for (int kbr = 0; kbr < 5; ++kbr)
#pragma unroll
        for (int i = 0; i < 16; ++i) { const float e = __builtin_amdgcn_exp2f(s[kbr][i] - mx); s[kbr][i] = e; sum += e; }
    sum += __shfl_xor(sum, 32);
    const float inv = 1.0f / (sum + __builtin_amdgcn_exp2f(sink2 - mx));
    f32x16 o[2];
#pragma unroll
    for (int dt = 0; dt < 2; ++dt)
#pragma unroll
        for (int i = 0; i < 16; ++i) o[dt][i] = 0.f;
#pragma unroll
    for (int kbr = 0; kbr < 5; ++kbr)
#pragma unroll
        for (int kk = 0; kk < 2; ++kk) {
            const bf16x8 pb = pack8(s[kbr], kk);
#pragma unroll
            for (int dt = 0; dt < 2; ++dt) {
                bf16x8 a; const int d = 32 * dt + r;
                if (SAMPLE) {
                    if (kbr < 4) { float f[8];
#pragma unroll
                        for (int j = 0; j < 8; ++j) { const int key = 32 * kbr + 16 * kk + 8 * (j >> 2) + 4 * g + (j & 3); f[j] = p.cv[((size_t)(b_s * 128 + key) * 4 + kvh) * 64 + d]; }
                        a = cvt8((f32x4){f[0], f[1], f[2], f[3]}, (f32x4){f[4], f[5], f[6], f[7]});
                    } else { u32x4 z = (u32x4){0u, 0u, 0u, 0u};
                        if (kk == 0 && g == 0) { const bf16_t* vp = Vb + (size_t)(TP + 4 * b_s) * 256 + kvh * 64 + d; z.x = (unsigned)vp[0] | ((unsigned)vp[256] << 16); z.y = (unsigned)vp[512] | ((unsigned)vp[768] << 16); }
                        a = __builtin_bit_cast(bf16x8, z); }
                } else {
                    const LAS bf16_t* vp = Vt + d * VT_STRIDE + 32 * (c + kbr) + 16 * kk + 4 * g;
                    const s16x4 lo = *(const LAS s16x4*)vp, hi = *(const LAS s16x4*)(vp + 8);
                    a = __builtin_shufflevector(lo, hi, 0, 1, 2, 3, 4, 5, 6, 7);
                }
                o[dt] = MFMA32(a, pb, o[dt]);
            }
        }
#pragma unroll
    for (int dt = 0; dt < 2; ++dt)
#pragma unroll
        for (int i4 = 0; i4 < 4; ++i4) {
            const int col = head * 64 + 32 * dt + 8 * i4 + 4 * g;
            const f32x4 at = (f32x4){o[dt][4 * i4], o[dt][4 * i4 + 1], o[dt][4 * i4 + 2], o[dt][4 * i4 + 3]} * inv;
            const size_t off = (size_t)tok * DM + col;
            const f32x4 sga = unpk4(*(const u32x2*)(SGA + off)), bg = unpk4(*(const u32x2*)(BG + off)), u0 = unpk4(*(const u32x2*)(U + off));
            f32x4 u1, u2;
            if (SAMPLE) {
                u1 = itok >= 1 ? unpk4(*(const u32x2*)(U + off - DM)) : *(const f32x4*)(p.sconv + (size_t)b_s * 4096 + DM + col);
                u2 = itok >= 2 ? unpk4(*(const u32x2*)(U + off - 2 * DM)) : *(const f32x4*)(p.sconv + (size_t)b_s * 4096 + (size_t)itok * DM + col);
            } else {
                u1 = tok >= 1 ? unpk4(*(const u32x2*)(U + off - DM)) : (f32x4){0.f, 0.f, 0.f, 0.f};
                u2 = tok >= 2 ? unpk4(*(const u32x2*)(U + off - 2 * DM)) : (f32x4){0.f, 0.f, 0.f, 0.f};
            }
            const f32x4 w0 = *(const f32x4*)(p.conv_w + col), w1 = *(const f32x4*)(p.conv_w + DM + col), w2 = *(const f32x4*)(p.conv_w + 2 * DM + col);
            const f32x4 conv = w0 * u2 + w1 * u1 + w2 * u0;
            *(u32x2*)(MIX + off) = pk4(sga * at + bg * conv);
        }
}

DI void p2_attention(const Params& p, LAS unsigned char* lds, int tid, int wid, int lane) {
    const bf16_t* Kb = (const bf16_t*)(p.ws + WS_K); const bf16_t* Vb = (const bf16_t*)(p.ws + WS_V);
    LAS bf16_t* Ks = (LAS bf16_t*)lds; LAS bf16_t* Vt = (LAS bf16_t*)(lds + VT_OFF);
    for (int item = blockIdx.x; item < 256; item += gridDim.x) {
        const int qb = item >> 2, kvh = item & 3;
        __syncthreads();
#pragma unroll
        for (int i = 0; i < 4; ++i) {
            const int e = tid + 512 * i, row = e >> 3, c8 = e & 7, tok = 128 * (qb - 1) + row;
            u32x4 kv = (u32x4){0u, 0u, 0u, 0u}, vv = (u32x4){0u, 0u, 0u, 0u};
            if (tok >= 0) { kv = *(const u32x4*)(Kb + (size_t)tok * 256 + kvh * 64 + 8 * c8); vv = *(const u32x4*)(Vb + (size_t)tok * 256 + kvh * 64 + 8 * c8); }
            *(LAS u32x4*)(Ks + row * KS_STRIDE + 8 * c8) = kv;
#pragma unroll
            for (int jj = 0; jj < 8; ++jj) Vt[(8 * c8 + jj) * VT_STRIDE + row] = (bf16_t)(vv[jj >> 1] >> (16 * (jj & 1)));
        }
        __syncthreads();
        for (int c = 0; c < 4; ++c) attn_chunk<false>(p, lds, qb, c, kvh, kvh * 8 + wid, 0, lane);
    }
    if (wid < 2)
        for (int it = blockIdx.x * 2 + wid; it < 512; it += gridDim.x * 2) attn_chunk<true>(p, lds, 0, 0, it & 3, 0, it >> 2, lane);
}

constexpr int LDS_BYTES = pg8::STAGE_BYTES + 16;

__global__ void __launch_bounds__(512, 2) fwd_megakernel(Params p) {
    extern __shared__ __attribute__((aligned(16))) unsigned char lds_raw[];
    LAS unsigned char* lds = (LAS unsigned char*)lds_raw;
    cg::grid_group grid = cg::this_grid();
    if (p.never) grid.sync();
    if (threadIdx.x < 4) ((LAS unsigned*)(lds + pg8::STAGE_BYTES))[threadIdx.x] = 0u;
    __syncthreads();
    const XcdBarrier xb = xcd_barrier_post((unsigned*)(p.ws + WS_BAR), (volatile LAS unsigned*)(lds + pg8::STAGE_BYTES));
    const int tid = threadIdx.x, wid = __builtin_amdgcn_readfirstlane(tid >> 6), lane = tid & 63;
    const int G = gridDim.x, bid = blockIdx.x;
    unsigned char* ws = p.ws;

    for (int rep = 0; rep < REP_P0; ++rep) p0_prologue(p, lds, wid, lane);
    for (int rep = 0; rep < REP_SYNC; ++rep) xcd_barrier(xb);
    xcd_barrier(xb);
    {
        pg8::Gemm g{(const bf16_t*)(ws + WS_XN), (const bf16_t*)(ws + WS_WIN), MT, DIN, DM}; pg8::StaticOrder S; S.init(MT, DIN, G, bid);
        Epi1 E{(bf16_t*)(ws + WS_Q), (bf16_t*)(ws + WS_K), (bf16_t*)(ws + WS_V), (bf16_t*)(ws + WS_U), (bf16_t*)(ws + WS_BG), (bf16_t*)(ws + WS_SGA),
               p.q_norm, p.k_norm, (const float*)(ws + WS_COS), (const float*)(ws + WS_SIN), p.out};
        for (int rep = 0; rep < REP_P1; ++rep) pg8::gemm_phase<Epi1>(lds, g, S, E);
    }
    xcd_barrier(xb);
    for (int rep = 0; rep < REP_P2; ++rep) p2_attention(p, lds, tid, wid, lane);
    xcd_barrier(xb);
    {
        pg8::Gemm g{(const bf16_t*)(ws + WS_MIX), (const bf16_t*)(ws + WS_WOUT), MT, DM, DM}; pg8::StaticOrder S; S.init(MT, DM, G, bid);
        Epi3 E{p.xp, p.xs, p.norm_ffn, p.out, (bf16_t*)(ws + WS_A2), (float*)(ws + WS_SSQ)};
        for (int rep = 0; rep < REP_P3; ++rep) pg8::gemm_phase<Epi3>(lds, g, S, E);
    }
    xcd_barrier(xb);
    {
        pg8::Gemm g{(const bf16_t*)(ws + WS_A2), (const bf16_t*)(ws + WS_WGU), MT, NGU, DM}; pg8::StaticOrder S; S.init(MT, NGU, G, bid);
        Epi4 E{(const float*)(ws + WS_SSQ), (bf16_t*)(ws + WS_HID)};
        for (int rep = 0; rep < REP_P4; ++rep) pg8::gemm_phase<Epi4>(lds, g, S, E);
    }
    xcd_barrier(xb);
    {
        pg8::Gemm g{(const bf16_t*)(ws + WS_HID), (const bf16_t*)(ws + WS_WDN), MT, DM, DFF}; pg8::StaticOrder S; S.init(MT, DM, G, bid);
        Epi5 E{p.out};
        pg8::gemm_phase<Epi5>(lds, g, S, E);
    }
}

extern "C" void kernel_launch(void* const* d_in, const int* in_sizes, int n_in, void* d_out, int out_size, void* d_ws, size_t ws_size, hipStream_t stream) {
    static int grid = 0;
    if (!grid) {
        int dev = 0, cus = 0, per_cu = 0;
        (void)hipGetDevice(&dev);
        (void)hipDeviceGetAttribute(&cus, hipDeviceAttributeMultiprocessorCount, dev);
        (void)hipFuncSetAttribute((const void*)fwd_megakernel, hipFuncAttributeMaxDynamicSharedMemorySize, LDS_BYTES);
        (void)hipOccupancyMaxActiveBlocksPerMultiprocessor(&per_cu, (const void*)fwd_megakernel, 512, LDS_BYTES);
        if (per_cu < 1) per_cu = 1;
        grid = cus * per_cu;
        if (ws_size < WS_END) fprintf(stderr, "kernel_launch: workspace too small (%zu < %zu)\n", ws_size, (size_t)WS_END);
    }
    Params p{};
    p.xp = (const float*)d_in[0]; p.xs = (const float*)d_in[1]; p.ck = (const float*)d_in[2]; p.cv = (const float*)d_in[3]; p.sconv = (const float*)d_in[4];
    p.norm_mix = (const float*)d_in[5]; p.w_in = (const float*)d_in[6]; p.q_norm = (const float*)d_in[7]; p.k_norm = (const float*)d_in[8]; p.sinks = (const float*)d_in[9];
    p.conv_w = (const float*)d_in[10]; p.w_out = (const float*)d_in[11]; p.norm_ffn = (const float*)d_in[12]; p.w_gu = (const float*)d_in[13]; p.w_dn = (const float*)d_in[14];
    p.out = (float*)d_out; p.ws = (unsigned char*)d_ws;
    p.never = 0;
    (void)hipMemsetAsync((char*)d_ws + WS_BAR, 0, 16384, stream);
    void* args[] = {&p};
    hipError_t e = hipLaunchCooperativeKernel((const void*)fwd_megakernel, dim3(grid), dim3(512), args, LDS_BYTES, stream);
    if (e != hipSuccess) fprintf(stderr, "cooperative launch failed: %s (grid %d)\n", hipGetErrorString(e), grid);
}
```

```cpp
#include <hip/hip_runtime.h>
#include <hip/hip_cooperative_groups.h>
#include <cstdio>
namespace cg = cooperative_groups;
#define REP_P0 1
#define REP_P1 1
#define REP_P2 1
#define REP_P3 1
#define REP_P4 1
#define REP_SYNC 0

#define LAS __attribute__((address_space(3)))
#define DI __device__ __forceinline__
typedef unsigned short bf16_t;
typedef short bf16x8 __attribute__((ext_vector_type(8)));
typedef short s16x4 __attribute__((ext_vector_type(4)));
typedef float f32x4 __attribute__((ext_vector_type(4)));
typedef float f32x16 __attribute__((ext_vector_type(16)));
typedef unsigned u32x4 __attribute__((ext_vector_type(4)));
typedef unsigned u32x2 __attribute__((ext_vector_type(2)));

constexpr int DM = 2048, TP = 8192, TS = 512, MT = TP + TS, DIN = 12800, DFF = 5632, NGU = 2 * DFF;
constexpr float EPS = 1e-6f;
constexpr int NPOS = 8196;
constexpr size_t O_YP = 0, O_YS = (size_t)TP * DM, O_PK = O_YS + (size_t)TS * DM, O_PV = O_PK + 32768, O_PC = O_PV + 32768,
                 O_SK = O_PC + 4096, O_SV = O_SK + 4194304, O_SC = O_SV + 4194304;
constexpr size_t WS_WIN = 0, WS_WOUT = WS_WIN + (size_t)DIN * DM * 2, WS_WGU = WS_WOUT + (size_t)DM * DM * 2, WS_WDN = WS_WGU + (size_t)NGU * DM * 2,
                 WS_XN = WS_WDN + (size_t)DM * DFF * 2, WS_Q = WS_XN + (size_t)MT * DM * 2, WS_K = WS_Q + (size_t)MT * DM * 2, WS_V = WS_K + (size_t)MT * 256 * 2,
                 WS_U = WS_V + (size_t)MT * 256 * 2, WS_BG = WS_U + (size_t)MT * DM * 2, WS_SGA = WS_BG + (size_t)MT * DM * 2, WS_COS = WS_SGA + (size_t)MT * DM * 2,
                 WS_SIN = WS_COS + (size_t)NPOS * 32 * 4, WS_SSQ = WS_SIN + (size_t)NPOS * 32 * 4, WS_BAR = WS_SSQ + (size_t)MT * 32 * 4, WS_END = WS_BAR + 16384;
constexpr size_t WS_MIX = WS_XN, WS_A2 = WS_Q, WS_HID = WS_U;
static_assert((size_t)MT * DFF * 2 <= 3 * (size_t)MT * DM * 2, "hidden fits in U|BG|SGA");

struct Params {
    const float *xp, *xs, *ck, *cv, *sconv, *norm_mix, *w_in, *q_norm, *k_norm, *sinks, *conv_w, *w_out, *norm_ffn, *w_gu, *w_dn;
    float* out; unsigned char* ws; long never;
};

typedef float f32x2 __attribute__((ext_vector_type(2)));
typedef __bf16 bf16x2v __attribute__((ext_vector_type(2)));
DI unsigned pk2(float lo, float hi) { const f32x2 f = {lo, hi}; return __builtin_bit_cast(unsigned, __builtin_convertvector(f, bf16x2v)); }
DI u32x2 pk4(f32x4 v) { u32x2 r; r.x = pk2(v[0], v[1]); r.y = pk2(v[2], v[3]); return r; }
DI float bf_lo(unsigned w) { return __uint_as_float(w << 16); }
DI float bf_hi(unsigned w) { return __uint_as_float(w & 0xffff0000u); }
DI f32x4 unpk4(u32x2 w) { return (f32x4){bf_lo(w.x), bf_hi(w.x), bf_lo(w.y), bf_hi(w.y)}; }
DI float sigmoidf_(float x) { return __builtin_amdgcn_rcpf(1.0f + __builtin_amdgcn_exp2f(-1.44269504089f * x)); }
DI float wave_sum(float v) {
#pragma unroll
    for (int o = 1; o < 64; o <<= 1) v += __shfl_xor(v, o);
    return v;
}


#define XB_TMO      128
#define XB_XCNT(j)  (256  + 64 * (j))
#define XB_XSUB(j)  (1280 + 64 * (j))
#define XB_XGEN(j)  (2304 + 64 * (j))
#define XB_TOP      3328
#define XB_TOPGEN   3392
#define XCD_BAR_WORDS 3456
#define XB_SPIN_CAP (1u << 20)
DI unsigned xb_ld(unsigned* p)              { return __hip_atomic_load(p, __ATOMIC_RELAXED, __HIP_MEMORY_SCOPE_AGENT); }
DI unsigned xb_add(unsigned* p, unsigned v) { return __hip_atomic_fetch_add(p, v, __ATOMIC_RELAXED, __HIP_MEMORY_SCOPE_AGENT); }
DI unsigned xb_xcc_id() { return (unsigned)__builtin_amdgcn_s_getreg((3 << 11) | 20) & 0xFu; }
#define XB_SPIN(cond, bar) do { unsigned _sp = 0; while (cond) { __builtin_amdgcn_s_sleep(1); \
    if ((++_sp & 255u) == 0u) { if (xb_ld(&(bar)[XB_TMO])) break; if (_sp > XB_SPIN_CAP) { atomicAdd(&(bar)[XB_TMO], 1u); break; } } } } while (0)
struct XcdBarrier { unsigned* bar; unsigned x; volatile LAS unsigned* st; };
DI XcdBarrier xcd_barrier_post(unsigned* bar, volatile LAS unsigned* st) {
    XcdBarrier b; b.bar = bar; b.x = xb_xcc_id(); b.st = st;
    if (threadIdx.x == 0) (void)xb_add(&bar[XB_XCNT(b.x)], 1u);
    return b;
}
DI void xcd_barrier_complete(unsigned* bar, unsigned x, unsigned& nloc, unsigned& nx) {
    const unsigned G = gridDim.x * gridDim.y * gridDim.z;
    unsigned sum, cnt, mine, sp = 0u;
    for (;;) {
        sum = 0u; cnt = 0u; mine = 0u;
#pragma unroll
        for (unsigned j = 0; j < 16; ++j) { const unsigned c = xb_ld(&bar[XB_XCNT(j)]); sum += c; cnt += (c > 0u) ? 1u : 0u; mine = (j == x) ? c : mine; }
        if (sum == G) break;
        __builtin_amdgcn_s_sleep(1);
        if ((++sp & 255u) == 0u) { if (xb_ld(&bar[XB_TMO])) break; if (sp > XB_SPIN_CAP) { atomicAdd(&bar[XB_TMO], 1u); break; } }
    }
    nloc = mine > 0u ? mine : 1u; nx = cnt > 0u ? cnt : 1u;
}
DI void xcd_barrier(const XcdBarrier& b) {
    asm volatile("s_waitcnt vmcnt(0)" ::: "memory");
    __syncthreads();
    if (threadIdx.x == 0) {
        unsigned* bar = b.bar;
        __builtin_amdgcn_s_waitcnt(0);
        unsigned nloc = b.st[0], nx = b.st[1];
        if (nloc == 0u) { xcd_barrier_complete(bar, b.x, nloc, nx); b.st[0] = nloc; b.st[1] = nx; }
        const unsigned old = xb_add(&bar[XB_XSUB(b.x)], 1u);
        const unsigned gen = old / nloc;
        if (old + 1u == (gen + 1u) * nloc) {
            __builtin_amdgcn_fence(__ATOMIC_RELEASE, "agent");
            asm volatile("s_waitcnt vmcnt(0)" ::: "memory");
            const unsigned og = xb_add(&bar[XB_TOP], 1u);
            const unsigned tg = og / nx;
            if (og + 1u == (tg + 1u) * nx) xb_add(&bar[XB_TOPGEN], 1u);
            else XB_SPIN(xb_ld(&bar[XB_TOPGEN]) == tg, bar);
            __builtin_amdgcn_fence(__ATOMIC_ACQUIRE, "agent");
            xb_add(&bar[XB_XGEN(b.x)], 1u);
            asm volatile("s_waitcnt vmcnt(0)" ::: "memory");
        } else {
            XB_SPIN(xb_ld(&bar[XB_XGEN(b.x)]) == gen, bar);
            __builtin_amdgcn_fence(__ATOMIC_ACQUIRE, "agent");
            asm volatile("s_waitcnt vmcnt(0)" ::: "memory");
        }
    }
    __syncthreads();
}

namespace pg8 {
constexpr int BM = 256, BK = 64, HALF = 128, HTB = HALF * BK * 2, STAGE_BYTES = 8 * HTB, NXCD = 8, WGM = 8;
DI int lds_byte(int r, int c) { const int st = (r >> 4) * 2 + (c >> 5), rr = r & 15, cc = c & 31, ob = rr * 64 + cc * 2; return st * 1024 + (ob ^ (((ob >> 9) & 1) << 5)); }
DI void stage_rc(int b, int& R, int& C) { const int st = b / 1024, sb = b % 1024, swz = sb ^ (((sb >> 9) & 1) << 5); R = (st >> 1) * 16 + swz / 64; C = (st & 1) * 32 + (swz % 64) / 2; }
struct Unit { int pm, pn; };
struct Gemm { const bf16_t* A; const bf16_t* Bt; int M, N, K; };
struct StaticOrder {
    int nM, nN, nwg, G, c;
    DI void init(int M, int N, int G_, int c_) { nM = M / BM; nN = N / BM; nwg = nM * nN; G = G_; c = c_; }
    DI bool next(int i, Unit& u) const {
        const long L = (long)i * G + c; if (L >= nwg) return false;
        int wgid = (int)L; { const int q = nwg / NXCD, r = nwg % NXCD, xcd = wgid % NXCD, off = wgid / NXCD; wgid = (xcd < r ? xcd * (q + 1) : r * (q + 1) + (xcd - r) * q) + off; }
        const int nig = WGM * nN, gid = wgid / nig, fm = gid * WGM, gsz = (nM - fm) < WGM ? (nM - fm) : WGM;
        u.pm = fm + ((wgid % nig) % gsz); u.pn = (wgid % nig) / gsz; return true;
    }
};

template <class Epi>
DI void gemm_phase(LAS unsigned char* lds, const Gemm g, const StaticOrder& S, const Epi& E) {
    const int tid = threadIdx.x, wid = __builtin_amdgcn_readfirstlane(tid >> 6), lane = tid & 63, wr = wid >> 2, wc = wid & 3, fr = lane & 15, fq = lane >> 4;
    const int K = g.K, nt = K / BK;
    unsigned voffA[2];
#pragma unroll
    for (int i = 0; i < 2; ++i) { int R, C; stage_rc(tid * 16 + i * 8192, R, C); voffA[i] = (unsigned)(R * K + C) * 2u; }
    const size_t kstep = (size_t)(BK * 2);
    const size_t hstep = (size_t)HALF * K * 2;
    const size_t tstep = 2 * hstep;
    const unsigned ldsw = (unsigned)wid * 1024u;
    const int aoff = lds_byte(wr * 64 + fr, fq * 8), boff = lds_byte(wc * 32 + fr, fq * 8);
#define PG8_SA(b, h) (((b) * 2 + (h)) * HTB)
#define PG8_SB(b, h) ((4 + (b) * 2 + (h)) * HTB)
#define PG8_STAGE(bufoff, gbase) do { _Pragma("unroll") for (int _i = 0; _i < 2; ++_i) \
        __builtin_amdgcn_global_load_lds((const unsigned*)((const char*)(gbase) + voffA[_i]), (LAS unsigned*)(lds + (bufoff) + ldsw + _i * 8192), 16, 0, 0); } while (0)
#define PG8_LDA(dst, b, h) do { _Pragma("unroll") for (int m = 0; m < 4; ++m) _Pragma("unroll") for (int k = 0; k < 2; ++k) dst[m][k] = *(const LAS bf16x8*)(lds + PG8_SA(b, h) + aoff + m * 2048 + k * 1024); } while (0)
#define PG8_LDB(dst, b, h) do { _Pragma("unroll") for (int n = 0; n < 2; ++n) _Pragma("unroll") for (int k = 0; k < 2; ++k) dst[n][k] = *(const LAS bf16x8*)(lds + PG8_SB(b, h) + boff + n * 2048 + k * 1024); } while (0)
#define PG8_MMA(ai, bj, At, Bt) do { __builtin_amdgcn_s_setprio(1); _Pragma("unroll") for (int m = 0; m < 4; ++m) _Pragma("unroll") for (int n = 0; n < 2; ++n) _Pragma("unroll") for (int k = 0; k < 2; ++k) \
        acc[ai][bj][m][n] = __builtin_amdgcn_mfma_f32_16x16x32_bf16(Bt[n][k], At[m][k], acc[ai][bj][m][n], 0, 0, 0); __builtin_amdgcn_s_setprio(0); } while (0)
#define PG8_WAIT_V(n) asm volatile("s_waitcnt vmcnt(" #n ")" ::: "memory")
#define PG8_WAIT_L(n) asm volatile("s_waitcnt lgkmcnt(" #n ")" ::: "memory")
#define PG8_BAR __builtin_amdgcn_s_barrier()
#define PG8_SCHED __builtin_amdgcn_sched_barrier(0)
    Unit cur, nxt; int ui = 0;
    if (!S.next(0, cur)) return;
    f32x4 acc[2][2][4][2];
#pragma unroll
    for (int a = 0; a < 2; ++a)
#pragma unroll
        for (int b = 0; b < 2; ++b)
#pragma unroll
            for (int m = 0; m < 4; ++m)
#pragma unroll
                for (int n = 0; n < 2; ++n) acc[a][b][m][n] = (f32x4){0.f, 0.f, 0.f, 0.f};
    bf16x8 At[4][2], B0[2][2], B1[2][2];
    const char* cA = (const char*)g.A + (size_t)cur.pm * tstep; const char* cB = (const char*)g.Bt + (size_t)cur.pn * tstep;
    PG8_STAGE(PG8_SB(0, 0), cB); PG8_STAGE(PG8_SA(0, 0), cA); PG8_STAGE(PG8_SB(0, 1), cB + hstep); PG8_STAGE(PG8_SA(0, 1), cA + hstep);
    if (wr == 1) PG8_BAR;
    PG8_WAIT_V(4); PG8_BAR;
    PG8_STAGE(PG8_SB(1, 0), cB + kstep); PG8_STAGE(PG8_SA(1, 0), cA + kstep); PG8_STAGE(PG8_SB(1, 1), cB + hstep + kstep);
    PG8_WAIT_V(6); PG8_BAR;
    for (;;) {
        const bool has_next = S.next(ui + 1, nxt);
        const char* nA = has_next ? (const char*)g.A + (size_t)nxt.pm * tstep : cA; const char* nB = has_next ? (const char*)g.Bt + (size_t)nxt.pn * tstep : cB;
        for (int t = 0; t < nt; t += 2) {
            const bool last = (t == nt - 2);
            const char* a1 = cA + (size_t)(t + 1) * kstep;
            const char* a2 = last ? nA : cA + (size_t)(t + 2) * kstep; const char* b2 = last ? nB : cB + (size_t)(t + 2) * kstep;
            const char* a3 = a2 + kstep; const char* b3 = b2 + kstep;
            PG8_LDB(B0, 0, 0); PG8_SCHED; PG8_LDA(At, 0, 0); PG8_STAGE(PG8_SA(1, 1), a1 + hstep);
            PG8_WAIT_L(8); PG8_BAR; PG8_WAIT_L(0); PG8_MMA(0, 0, At, B0); PG8_BAR; PG8_SCHED;
            PG8_LDB(B1, 0, 1); PG8_STAGE(PG8_SB(0, 0), b2);
            PG8_BAR; PG8_WAIT_L(0); PG8_MMA(0, 1, At, B1); PG8_BAR;
            PG8_LDA(At, 0, 1); PG8_STAGE(PG8_SA(0, 0), a2);
            PG8_BAR; PG8_WAIT_L(0); PG8_MMA(1, 0, At, B0); PG8_BAR; PG8_SCHED;
            PG8_STAGE(PG8_SB(0, 1), b2 + hstep);
            PG8_WAIT_V(6); PG8_BAR; PG8_MMA(1, 1, At, B1); PG8_BAR;
            PG8_LDB(B0, 1, 0); PG8_SCHED; PG8_LDA(At, 1, 0); PG8_STAGE(PG8_SA(0, 1), a2 + hstep);
            PG8_WAIT_L(8); PG8_BAR; PG8_WAIT_L(0); PG8_MMA(0, 0, At, B0); PG8_BAR; PG8_SCHED;
            PG8_LDB(B1, 1, 1); PG8_STAGE(PG8_SB(1, 0), b3);
            PG8_BAR; PG8_WAIT_L(0); PG8_MMA(0, 1, At, B1); PG8_BAR;
            PG8_LDA(At, 1, 1); PG8_STAGE(PG8_SA(1, 0), a3);
            PG8_BAR; PG8_WAIT_L(0); PG8_MMA(1, 0, At, B0); PG8_BAR; PG8_SCHED;
            PG8_STAGE(PG8_SB(1, 1), b3 + hstep);
            PG8_WAIT_V(6); PG8_BAR; PG8_MMA(1, 1, At, B1); PG8_BAR;
        }
        E(acc, cur, wr, wc, fr, fq);
        if (!has_next) break;
#pragma unroll
        for (int a = 0; a < 2; ++a)
#pragma unroll
            for (int b = 0; b < 2; ++b)
#pragma unroll
                for (int m = 0; m < 4; ++m)
#pragma unroll
                    for (int n = 0; n < 2; ++n) acc[a][b][m][n] = (f32x4){0.f, 0.f, 0.f, 0.f};
        cur = nxt; cA = nA; cB = nB; ++ui;
    }
    PG8_WAIT_V(0);
    if (wr == 0) PG8_BAR;
    PG8_BAR;
#undef PG8_SA
#undef PG8_SB
#undef PG8_STAGE
#undef PG8_LDA
#undef PG8_LDB
#undef PG8_MMA
#undef PG8_WAIT_V
#undef PG8_WAIT_L
#undef PG8_BAR
#undef PG8_SCHED
}
}

typedef f32x4 AccT[2][2][4][2];

DI int src_col_in(int R) {
    const int pn = R >> 8, c = R & 255, bj = c >> 7, wc = (c >> 5) & 3, r5 = c & 31;
    if (pn < 8) return (4 * pn + wc) * 64 + 32 * bj + r5;
    if (pn == 8) return 2048 + wc * 64 + 32 * bj + r5;
    if (pn == 9) return 2304 + c;
    if (pn < 26) return (bj ? 6656 : 2560) + 128 * (pn - 10) + (c & 127);
    if (pn < 42) return (bj ? 10752 : 4608) + 128 * (pn - 26) + (c & 127);
    return 8704 + 256 * (pn - 42) + c;
}
DI int src_col_gu(int R) { const int t = R >> 8, c = R & 255; return ((c >> 7) ? DFF : 0) + 128 * t + (c & 127); }

DI unsigned bperm(int src4, unsigned v) { return (unsigned)__builtin_amdgcn_ds_bpermute(src4, (int)v); }
DI u32x2 perm2(int src4, u32x2 v) { u32x2 r; r.x = bperm(src4, v.x); r.y = bperm(src4, v.y); return r; }
DI f32x4 perm4(int src4, f32x4 v) { f32x4 r; r[0] = __uint_as_float(bperm(src4, __float_as_uint(v[0]))); r[1] = __uint_as_float(bperm(src4, __float_as_uint(v[1])));
    r[2] = __uint_as_float(bperm(src4, __float_as_uint(v[2]))); r[3] = __uint_as_float(bperm(src4, __float_as_uint(v[3]))); return r; }

struct Epi1 {
    bf16_t *Q, *Kb, *Vb, *U, *BG, *SGA; const float *qg, *kg, *cosT, *sinT; float* out;
    DI void side_kv(float* pwin, float* swin, int row, int col, f32x4 v) const {
        if (row >= TP - 128 && row < TP) *(f32x4*)(pwin + (size_t)(row - (TP - 128)) * 256 + col) = v;
        if (row >= TP) { const int b = (row - TP) >> 2, i = (row - TP) & 3; *(f32x4*)(swin + (size_t)b * 32768 + (size_t)(124 + i) * 256 + col) = v; }
    }
    DI void operator()(const AccT& acc, const pg8::Unit& u, int wr, int wc, int fr, int fq) const {
        asm volatile("" : "+v"(fr), "+v"(fq));
        const int lane = fr + 16 * fq, tr = lane >> 2, tq = lane & 3, src4 = (tr + 16 * tq) * 4;
        const int pn = u.pn, row0 = u.pm * 256 + wr * 64 + fr, rowT0 = u.pm * 256 + wr * 64 + tr;
        const bool side = u.pm >= 31;
        if (pn < 9) {
            const float* g = pn < 8 ? qg : kg;
            f32x4 gv[2][2];
#pragma unroll
            for (int bj = 0; bj < 2; ++bj)
#pragma unroll
                for (int n = 0; n < 2; ++n) gv[bj][n] = *(const f32x4*)(g + 32 * bj + 16 * n + 4 * fq);
#pragma unroll
            for (int aim = 0; aim < 4; ++aim) {
                const int ai = aim >> 1, mh = (aim & 1) * 2;
                f32x4 cs[4][2], sn[4][2];
#pragma unroll
                for (int m = mh; m < mh + 2; ++m) {
                    const int row = row0 + 128 * ai + 16 * m;
                    const int pos = row < TP ? row : TP + ((row - TP) & 3);
#pragma unroll
                    for (int n = 0; n < 2; ++n) { cs[m][n] = *(const f32x4*)(cosT + (size_t)pos * 32 + 16 * n + 4 * fq); sn[m][n] = *(const f32x4*)(sinT + (size_t)pos * 32 + 16 * n + 4 * fq); }
                }
#pragma unroll
                for (int m = mh; m < mh + 2; ++m) {
                    const int rowT = rowT0 + 128 * ai + 16 * m;
                    float ssq = 0.f;
#pragma unroll
                    for (int bj = 0; bj < 2; ++bj)
#pragma unroll
                        for (int n = 0; n < 2; ++n) { const f32x4 x = acc[ai][bj][m][n]; ssq += (x[0] * x[0] + x[1] * x[1]) + (x[2] * x[2] + x[3] * x[3]); }
                    ssq += __shfl_xor(ssq, 16); ssq += __shfl_xor(ssq, 32);
                    const float rs = __builtin_amdgcn_rsqf(ssq * (1.0f / 64.0f) + EPS);
#pragma unroll
                    for (int n = 0; n < 2; ++n) {
                        const f32x4 y1 = acc[ai][0][m][n] * rs * gv[0][n], y2 = acc[ai][1][m][n] * rs * gv[1][n];
                        const f32x4 o1 = y1 * cs[m][n] - y2 * sn[m][n], o2 = y2 * cs[m][n] + y1 * sn[m][n];
                        const int d = 16 * n + 4 * tq;
                        const u32x2 w1 = perm2(src4, pk4(o1)), w2 = perm2(src4, pk4(o2));
                        if (pn < 8) {
                            bf16_t* qp = Q + (size_t)rowT * DM + (4 * pn + wc) * 64 + d;
                            *(u32x2*)qp = w1; *(u32x2*)(qp + 32) = w2;
                        } else {
                            bf16_t* kp = Kb + (size_t)rowT * 256 + wc * 64 + d;
                            *(u32x2*)kp = w1; *(u32x2*)(kp + 32) = w2;
                            if (side) { const f32x4 t1 = perm4(src4, o1), t2 = perm4(src4, o2);
                                side_kv(out + O_PK, out + O_SK, rowT, wc * 64 + d, t1); side_kv(out + O_PK, out + O_SK, rowT, wc * 64 + d + 32, t2); }
                        }
                    }
                }
            }
        } else if (pn == 9) {
#pragma unroll
            for (int ai = 0; ai < 2; ++ai)
#pragma unroll
                for (int m = 0; m < 4; ++m) {
                    const int rowT = rowT0 + 128 * ai + 16 * m;
#pragma unroll
                    for (int bj = 0; bj < 2; ++bj)
#pragma unroll
                        for (int n = 0; n < 2; ++n) { const int col = 128 * bj + 32 * wc + 16 * n + 4 * tq; const f32x4 v = acc[ai][bj][m][n];
                            *(u32x2*)(Vb + (size_t)rowT * 256 + col) = perm2(src4, pk4(v));
                            if (side) side_kv(out + O_PV, out + O_SV, rowT, col, perm4(src4, v)); }
                }
        } else if (pn < 26) {
            const int t = pn - 10;
#pragma unroll
            for (int ai = 0; ai < 2; ++ai)
#pragma unroll
                for (int m = 0; m < 4; ++m) {
                    const int rowT = rowT0 + 128 * ai + 16 * m;
#pragma unroll
                    for (int n = 0; n < 2; ++n) { const int col = 128 * t + 32 * wc + 16 * n + 4 * tq; const f32x4 v = acc[ai][0][m][n] * acc[ai][1][m][n];
                        *(u32x2*)(U + (size_t)rowT * DM + col) = perm2(src4, pk4(v));
                        if (side) { const f32x4 vt = perm4(src4, v);
                            if (rowT >= TP - 2 && rowT < TP) *(f32x4*)(out + O_PC + (size_t)(rowT - (TP - 2)) * DM + col) = vt;
                            if (rowT >= TP && ((rowT - TP) & 3) >= 2) { const int b = (rowT - TP) >> 2, i = (rowT - TP) & 3; *(f32x4*)(out + O_SC + (size_t)b * 4096 + (size_t)(i - 2) * DM + col) = vt; } } }
                }
        } else if (pn < 42) {
            const int t = pn - 26;
#pragma unroll
            for (int ai = 0; ai < 2; ++ai)
#pragma unroll
                for (int m = 0; m < 4; ++m) {
                    const int rowT = rowT0 + 128 * ai + 16 * m;
#pragma unroll
                    for (int n = 0; n < 2; ++n) { const int col = 128 * t + 32 * wc + 16 * n + 4 * tq; const f32x4 b = acc[ai][0][m][n], gc = acc[ai][1][m][n];
                        f32x4 v; v[0] = b[0] * sigmoidf_(gc[0]); v[1] = b[1] * sigmoidf_(gc[1]); v[2] = b[2] * sigmoidf_(gc[2]); v[3] = b[3] * sigmoidf_(gc[3]);
                        *(u32x2*)(BG + (size_t)rowT * DM + col) = perm2(src4, pk4(v)); }
                }
        } else {
#pragma unroll
            for (int ai = 0; ai < 2; ++ai)
#pragma unroll
                for (int m = 0; m < 4; ++m) {
                    const int rowT = rowT0 + 128 * ai + 16 * m;
#pragma unroll
                    for (int bj = 0; bj < 2; ++bj)
#pragma unroll
                        for (int n = 0; n < 2; ++n) { const int col = 256 * (pn - 42) + 128 * bj + 32 * wc + 16 * n + 4 * tq; const f32x4 a = acc[ai][bj][m][n];
                            f32x4 v; v[0] = sigmoidf_(a[0]); v[1] = sigmoidf_(a[1]); v[2] = sigmoidf_(a[2]); v[3] = sigmoidf_(a[3]);
                            *(u32x2*)(SGA + (size_t)rowT * DM + col) = perm2(src4, pk4(v)); }
                }
        }
    }
};

struct Epi3 {
    const float *xp, *xs, *gffn; float* Y; bf16_t* A2; float* SSQ;
    DI void operator()(const AccT& acc, const pg8::Unit& u, int wr, int wc, int fr, int fq) const {
        asm volatile("" : "+v"(fr), "+v"(fq));
        const int lane = fr + 16 * fq, tr = lane >> 2, tq = lane & 3, src4 = (tr + 16 * tq) * 4;
        const int rowT0 = u.pm * 256 + wr * 64 + tr, colT0 = u.pn * 256 + wc * 32 + 4 * tq;
        const float* xb = u.pm < 32 ? xp : xs - (size_t)TP * DM;
        f32x4 gv[2][2];
#pragma unroll
        for (int bj = 0; bj < 2; ++bj)
#pragma unroll
            for (int n = 0; n < 2; ++n) gv[bj][n] = *(const f32x4*)(gffn + colT0 + 128 * bj + 16 * n);
#pragma unroll
        for (int aim = 0; aim < 4; ++aim) {
            const int ai = aim >> 1, mh = (aim & 1) * 2;
            f32x4 xv[4][2][2];
#pragma unroll
            for (int m = mh; m < mh + 2; ++m)
#pragma unroll
                for (int bj = 0; bj < 2; ++bj)
#pragma unroll
                    for (int n = 0; n < 2; ++n) xv[m][bj][n] = *(const f32x4*)(xb + (size_t)(rowT0 + 128 * ai + 16 * m) * DM + colT0 + 128 * bj + 16 * n);
#pragma unroll
            for (int m = mh; m < mh + 2; ++m) {
                const int rowT = rowT0 + 128 * ai + 16 * m; float ssq = 0.f;
#pragma unroll
                for (int bj = 0; bj < 2; ++bj)
#pragma unroll
                    for (int n = 0; n < 2; ++n) { const size_t off = (size_t)rowT * DM + colT0 + 128 * bj + 16 * n;
                        const f32x4 y = xv[m][bj][n] + perm4(src4, acc[ai][bj][m][n]);
                        ssq += (y[0] * y[0] + y[1] * y[1]) + (y[2] * y[2] + y[3] * y[3]);
                        *(f32x4*)(Y + off) = y; *(u32x2*)(A2 + off) = pk4(y * gv[bj][n]); }
                ssq += __shfl_xor(ssq, 1); ssq += __shfl_xor(ssq, 2);
                if (tq == 0) SSQ[(size_t)rowT * 32 + u.pn * 4 + wc] = ssq;
            }
        }
    }
};

struct Epi4 {
    const float* SSQ; bf16_t* HID;
    DI void operator()(const AccT& acc, const pg8::Unit& u, int wr, int wc, int fr, int fq) const {
        asm volatile("" : "+v"(fr), "+v"(fq));
        const int lane = fr + 16 * fq, tr = lane >> 2, tq = lane & 3, src4 = (tr + 16 * tq) * 4;
        const int row0 = u.pm * 256 + wr * 64 + fr, rowT0 = u.pm * 256 + wr * 64 + tr, colT0 = u.pn * 128 + wc * 32 + 4 * tq;
#pragma unroll
        for (int ai = 0; ai < 2; ++ai) {
            f32x4 sp[4][2];
#pragma unroll
            for (int m = 0; m < 4; ++m) { const f32x4* q = (const f32x4*)(SSQ + (size_t)(row0 + 128 * ai + 16 * m) * 32 + 8 * fq); sp[m][0] = q[0]; sp[m][1] = q[1]; }
#pragma unroll
            for (int m = 0; m < 4; ++m) {
                const int rowT = rowT0 + 128 * ai + 16 * m;
                const f32x4 s4 = sp[m][0] + sp[m][1];
                float ss = (s4[0] + s4[1]) + (s4[2] + s4[3]);
                ss += __shfl_xor(ss, 16); ss += __shfl_xor(ss, 32);
                const float rstd = __builtin_amdgcn_rsqf(ss * (1.0f / DM) + EPS);
#pragma unroll
                for (int n = 0; n < 2; ++n) { const f32x4 g = acc[ai][0][m][n] * rstd, up = acc[ai][1][m][n] * rstd;
                    f32x4 h; h[0] = g[0] * sigmoidf_(g[0]) * up[0]; h[1] = g[1] * sigmoidf_(g[1]) * up[1]; h[2] = g[2] * sigmoidf_(g[2]) * up[2]; h[3] = g[3] * sigmoidf_(g[3]) * up[3];
                    *(u32x2*)(HID + (size_t)rowT * DFF + colT0 + 16 * n) = perm2(src4, pk4(h)); }
            }
        }
    }
};

struct Epi5 {
    float* Y;
    DI void operator()(const AccT& acc, const pg8::Unit& u, int wr, int wc, int fr, int fq) const {
        asm volatile("" : "+v"(fr), "+v"(fq));
        const int lane = fr + 16 * fq, tr = lane >> 2, tq = lane & 3, src4 = (tr + 16 * tq) * 4;
        const int rowT0 = u.pm * 256 + wr * 64 + tr, colT0 = u.pn * 256 + wc * 32 + 4 * tq;
#pragma unroll
        for (int aim = 0; aim < 4; ++aim) {
            const int ai = aim >> 1, mh = (aim & 1) * 2;
            f32x4 yv[4][2][2];
#pragma unroll
            for (int m = mh; m < mh + 2; ++m)
#pragma unroll
                for (int bj = 0; bj < 2; ++bj)
#pragma unroll
                    for (int n = 0; n < 2; ++n) yv[m][bj][n] = *(const f32x4*)(Y + (size_t)(rowT0 + 128 * ai + 16 * m) * DM + colT0 + 128 * bj + 16 * n);
#pragma unroll
            for (int m = mh; m < mh + 2; ++m)
#pragma unroll
                for (int bj = 0; bj < 2; ++bj)
#pragma unroll
                    for (int n = 0; n < 2; ++n) *(f32x4*)(Y + (size_t)(rowT0 + 128 * ai + 16 * m) * DM + colT0 + 128 * bj + 16 * n) = yv[m][bj][n] + perm4(src4, acc[ai][bj][m][n]);
        }
    }
};

DI void p0_transpose_item(const float* W, int K, int N, bf16_t* WT, int src_n0, int dst_n0, int k0, LAS float* scr, int lane) {
#pragma unroll 8
    for (int i = 0; i < 32; ++i) { const int kk = 2 * i + (lane >> 5); scr[kk * 33 + (lane & 31)] = W[(size_t)(k0 + kk) * N + src_n0 + (lane & 31)]; }
    asm volatile("s_waitcnt lgkmcnt(0)" ::: "memory");
    const int c = lane & 7;
#pragma unroll
    for (int j = 0; j < 4; ++j) { const int n = (lane >> 3) + 8 * j; const LAS float* s = scr + (8 * c) * 33 + n;
        u32x4 o; o.x = pk2(s[0 * 33], s[1 * 33]); o.y = pk2(s[2 * 33], s[3 * 33]); o.z = pk2(s[4 * 33], s[5 * 33]); o.w = pk2(s[6 * 33], s[7 * 33]);
        *(u32x4*)(WT + (size_t)(dst_n0 + n) * K + k0 + 8 * c) = o; }
    asm volatile("s_waitcnt lgkmcnt(0)" ::: "memory");
}

DI void p0_prologue(const Params& p, LAS unsigned char* lds, int wid, int lane) {
    LAS float* scr = (LAS float*)(lds + wid * 8704);
    const int gw = blockIdx.x * 8 + wid, NGW = gridDim.x * 8;
    bf16_t* WinT = (bf16_t*)(p.ws + WS_WIN); bf16_t* WoutT = (bf16_t*)(p.ws + WS_WOUT); bf16_t* WguT = (bf16_t*)(p.ws + WS_WGU); bf16_t* WdnT = (bf16_t*)(p.ws + WS_WDN);
    constexpr int I_IN = (DM / 64) * (DIN / 32), I_OUT = (DM / 64) * (DM / 32), I_GU = (DM / 64) * (NGU / 32), I_DN = (DFF / 64) * (DM / 32);
    constexpr int NITEMS = I_IN + I_OUT + I_GU + I_DN;
    for (int it = gw; it < NITEMS; it += NGW) {
        int r = it;
        if (r < I_IN) { const int nblk = DIN / 32, kb = r / nblk, nb = r % nblk; p0_transpose_item(p.w_in, DM, DIN, WinT, src_col_in(32 * nb), 32 * nb, 64 * kb, scr, lane); continue; } r -= I_IN;
        if (r < I_OUT) { const int nblk = DM / 32, kb = r / nblk, nb = r % nblk; p0_transpose_item(p.w_out, DM, DM, WoutT, 32 * nb, 32 * nb, 64 * kb, scr, lane); continue; } r -= I_OUT;
        if (r < I_GU) { const int nblk = NGU / 32, kb = r / nblk, nb = r % nblk; p0_transpose_item(p.w_gu, DM, NGU, WguT, src_col_gu(32 * nb), 32 * nb, 64 * kb, scr, lane); continue; } r -= I_GU;
        { const int nblk = DM / 32, kb = r / nblk, nb = r % nblk; p0_transpose_item(p.w_dn, DFF, DM, WdnT, 32 * nb, 32 * nb, 64 * kb, scr, lane); }
    }
    bf16_t* XN = (bf16_t*)(p.ws + WS_XN);
    for (int m = gw; m < MT; m += NGW) {
        const float* xrow = m < TP ? p.xp + (size_t)m * DM : p.xs + (size_t)(m - TP) * DM;
        const f32x4* xr = (const f32x4*)xrow + lane; f32x4 v[8]; float s = 0.f;
#pragma unroll
        for (int j = 0; j < 8; ++j) { v[j] = xr[64 * j]; s += (v[j][0] * v[j][0] + v[j][1] * v[j][1]) + (v[j][2] * v[j][2] + v[j][3] * v[j][3]); }
        const float rstd = 1.0f / sqrtf(wave_sum(s) * (1.0f / DM) + EPS);
        u32x2* o8 = (u32x2*)(XN + (size_t)m * DM) + lane;
#pragma unroll
        for (int j = 0; j < 8; ++j) { const f32x4 gv = ((const f32x4*)p.norm_mix)[64 * j + lane]; o8[64 * j] = pk4(v[j] * rstd * gv); }
    }
    float* cosT = (float*)(p.ws + WS_COS); float* sinT = (float*)(p.ws + WS_SIN);
    const int gt = blockIdx.x * 512 + threadIdx.x, GT = gridDim.x * 512;
    for (int idx = gt; idx < NPOS * 32; idx += GT) {
        const int pos = idx >> 5, i = idx & 31;
        const float inv = __builtin_amdgcn_exp2f(-(float)i * (13.287712379549449f / 32.0f));
        const float ang = (float)pos * inv;
        const double rev = (double)ang * 0.15915494309189535; const float fr = (float)(rev - __builtin_floor(rev));
        cosT[idx] = __builtin_amdgcn_cosf(fr); sinT[idx] = __builtin_amdgcn_sinf(fr);
    }
    for (int idx = gt; idx < 128 * 7936; idx += GT) {
        const int b = idx / 7936, e = idx - b * 7936;
        ((f32x4*)(p.out + O_SK + (size_t)b * 32768))[e] = ((const f32x4*)(p.ck + (size_t)b * 32768 + 1024))[e];
        ((f32x4*)(p.out + O_SV + (size_t)b * 32768))[e] = ((const f32x4*)(p.cv + (size_t)b * 32768 + 1024))[e];
    }
}

#define MFMA32(a, b, c) __builtin_amdgcn_mfma_f32_32x32x16_bf16((a), (b), (c), 0, 0, 0)
DI int crow(int reg, int h) { return (reg & 3) + 8 * (reg >> 2) + 4 * h; }
DI bf16x8 pack8(const f32x16& x, int s) {
    u32x4 p; p.x = pk2(x[8 * s], x[8 * s + 1]); p.y = pk2(x[8 * s + 2], x[8 * s + 3]); p.z = pk2(x[8 * s + 4], x[8 * s + 5]); p.w = pk2(x[8 * s + 6], x[8 * s + 7]);
    return __builtin_bit_cast(bf16x8, p);
}
DI bf16x8 cvt8(f32x4 a, f32x4 b) { u32x4 p; p.x = pk2(a[0], a[1]); p.y = pk2(a[2], a[3]); p.z = pk2(b[0], b[1]); p.w = pk2(b[2], b[3]); return __builtin_bit_cast(bf16x8, p); }

constexpr int KS_STRIDE = 72, VT_STRIDE = 260, VT_OFF = 256 * KS_STRIDE * 2;

template <bool SAMPLE>
DI void attn_chunk(const Params& p, LAS unsigned char* lds, int qb, int c, int kvh, int head_w, int b_s, int lane) {
    const bf16_t* Q = (const bf16_t*)(p.ws + WS_Q); const bf16_t* Kb = (const bf16_t*)(p.ws + WS_K); const bf16_t* Vb = (const bf16_t*)(p.ws + WS_V);
    const bf16_t* U = (const bf16_t*)(p.ws + WS_U); const bf16_t* BG = (const bf16_t*)(p.ws + WS_BG); const bf16_t* SGA = (const bf16_t*)(p.ws + WS_SGA);
    bf16_t* MIX = (bf16_t*)(p.ws + WS_MIX);
    const int r = lane & 31, g = lane >> 5;
    int tok, head, itok = 0;
    if (SAMPLE) { itok = r >> 3; head = kvh * 8 + (r & 7); tok = TP + 4 * b_s + itok; }
    else { head = head_w; tok = 128 * qb + 32 * c + r; }
    const LAS bf16_t* Ks = (const LAS bf16_t*)lds; const LAS bf16_t* Vt = (const LAS bf16_t*)(lds + VT_OFF);
    bf16x8 qf[4];
#pragma unroll
    for (int ks = 0; ks < 4; ++ks) qf[ks] = *(const bf16x8*)(Q + (size_t)tok * DM + head * 64 + 16 * ks + 8 * g);
    f32x16 s[5];
#pragma unroll
    for (int kbr = 0; kbr < 5; ++kbr) {
#pragma unroll
        for (int i = 0; i < 16; ++i) s[kbr][i] = 0.f;
#pragma unroll
        for (int ks = 0; ks < 4; ++ks) {
            bf16x8 a;
            if (SAMPLE) {
                if (kbr < 4) { const float* kp = p.ck + ((size_t)(b_s * 128 + 32 * kbr + r) * 4 + kvh) * 64 + 16 * ks + 8 * g; a = cvt8(*(const f32x4*)kp, *(const f32x4*)(kp + 4)); }
                else { u32x4 z = (u32x4){0u, 0u, 0u, 0u}; if (r < 4) z = *(const u32x4*)(Kb + (size_t)(TP + 4 * b_s + r) * 256 + kvh * 64 + 16 * ks + 8 * g); a = __builtin_bit_cast(bf16x8, z); }
            } else a = *(const LAS bf16x8*)(Ks + (32 * (c + kbr) + r) * KS_STRIDE + 16 * ks + 8 * g);
            s[kbr] = MFMA32(a, qf[ks], s[kbr]);
        }
    }
    const float sc = 0.125f * 1.44269504089f;
    const float sink2 = p.sinks[head] * 1.44269504089f;
    float mx = sink2;
#pragma unroll
    for (int kbr = 0; kbr < 5; ++kbr)
#pragma unroll
        for (int i = 0; i < 16; ++i) {
            const int kr = crow(i, g); bool valid;
            if (SAMPLE) valid = kbr < 4 ? (32 * kbr + kr > itok) : (kr <= itok);
            else { valid = kbr == 0 ? (kr > r) : (kbr == 4 ? (kr <= r) : true); if (qb == 0 && c + kbr < 4) valid = false; }
            const float t = valid ? s[kbr][i] * sc : -1e30f; s[kbr][i] = t; mx = fmaxf(mx, t);
        }
    mx = fmaxf(mx, __shfl_xor(mx, 32));
    float sum = 0.f;
#pragma unroll
    for (int kbr = 0; kbr < 5; ++kbr)
#pragma unroll
        for (int i = 0; i < 16; ++i) { const float e = __builtin_amdgcn_exp2f(s[kbr][i] - mx); s[kbr][i] = e; sum += e; }
    sum += __shfl_xor(sum, 32);
    const float inv = 1.0f / (sum + __builtin_amdgcn_exp2f(sink2 - mx));
    f32x16 o[2];
#pragma unroll
    for (int dt = 0; dt < 2; ++dt)
#pragma unroll
        for (int i = 0; i < 16; ++i) o[dt][i] = 0.f;
#pragma unroll
    for (int kbr = 0; kbr < 5; ++kbr)
#pragma unroll
        for (int kk = 0; kk < 2; ++kk) {
            const bf16x8 pb = pack8(s[kbr], kk);
#pragma unroll
            for (int dt = 0; dt < 2; ++dt) {
                bf16x8 a; const int d = 32 * dt + r;
                if (SAMPLE) {
                    if (kbr < 4) { float f[8];
#pragma unroll
                        for (int j = 0; j < 8; ++j) { const int key = 32 * kbr + 16 * kk + 8 * (j >> 2) + 4 * g + (j & 3); f[j] = p.cv[((size_t)(b_s * 128 + key) * 4 + kvh) * 64 + d]; }
                        a = cvt8((f32x4){f[0], f[1], f[2], f[3]}, (f32x4){f[4], f[5], f[6], f[7]});
                    } else { u32x4 z = (u32x4){0u, 0u, 0u, 0u};
                        if (kk == 0 && g == 0) { const bf16_t* vp = Vb + (size_t)(TP + 4 * b_s) * 256 + kvh * 64 + d; z.x = (unsigned)vp[0] | ((unsigned)vp[256] << 16); z.y = (unsigned)vp[512] | ((unsigned)vp[768] << 16); }
                        a = __builtin_bit_cast(bf16x8, z); }
                } else {
                    const LAS bf16_t* vp = Vt + d * VT_STRIDE + 32 * (c + kbr) + 16 * kk + 4 * g;
                    const s16x4 lo = *(const LAS s16x4*)vp, hi = *(const LAS s16x4*)(vp + 8);
                    a = __builtin_shufflevector(lo, hi, 0, 1, 2, 3, 4, 5, 6, 7);
                }
                o[dt] = MFMA32(a, pb, o[dt]);
            }
        }
#pragma unroll
    for (int dt = 0; dt < 2; ++dt)
#pragma unroll
        for (int i4 = 0; i4 < 4; ++i4) {
            const int col = head * 64 + 32 * dt + 8 * i4 + 4 * g;
            const f32x4 at = (f32x4){o[dt][4 * i4], o[dt][4 * i4 + 1], o[dt][4 * i4 + 2], o[dt][4 * i4 + 3]} * inv;
            const size_t off = (size_t)tok * DM + col;
            const f32x4 sga = unpk4(*(const u32x2*)(SGA + off)), bg = unpk4(*(const u32x2*)(BG + off)), u0 = unpk4(*(const u32x2*)(U + off));
            f32x4 u1, u2;
            if (SAMPLE) {
                u1 = itok >= 1 ? unpk4(*(const u32x2*)(U + off - DM)) : *(const f32x4*)(p.sconv + (size_t)b_s * 4096 + DM + col);
                u2 = itok >= 2 ? unpk4(*(const u32x2*)(U + off - 2 * DM)) : *(const f32x4*)(p.sconv + (size_t)b_s * 4096 + (size_t)itok * DM + col);
            } else {
                u1 = tok >= 1 ? unpk4(*(const u32x2*)(U + off - DM)) : (f32x4){0.f, 0.f, 0.f, 0.f};
                u2 = tok >= 2 ? unpk4(*(const u32x2*)(U + off - 2 * DM)) : (f32x4){0.f, 0.f, 0.f, 0.f};
            }
            const f32x4 w0 = *(const f32x4*)(p.conv_w + col), w1 = *(const f32x4*)(p.conv_w + DM + col), w2 = *(const f32x4*)(p.conv_w + 2 * DM + col);
            const f32x4 conv = w0 * u2 + w1 * u1 + w2 * u0;
            *(u32x2*)(MIX + off) = pk4(sga * at + bg * conv);
        }
}

DI void p2_attention(const Params& p, LAS unsigned char* lds, int tid, int wid, int lane) {
    const bf16_t* Kb = (const bf16_t*)(p.ws + WS_K); const bf16_t* Vb = (const bf16_t*)(p.ws + WS_V);
    LAS bf16_t* Ks = (LAS bf16_t*)lds; LAS bf16_t* Vt = (LAS bf16_t*)(lds + VT_OFF);
    for (int item = blockIdx.x; item < 256; item += gridDim.x) {
        const int qb = item >> 2, kvh = item & 3;
        __syncthreads();
#pragma unroll
        for (int i = 0; i < 4; ++i) {
            const int e = tid + 512 * i, row = e >> 3, c8 = e & 7, tok = 128 * (qb - 1) + row;
            u32x4 kv = (u32x4){0u, 0u, 0u, 0u}, vv = (u32x4){0u, 0u, 0u, 0u};
            if (tok >= 0) { kv = *(const u32x4*)(Kb + (size_t)tok * 256 + kvh * 64 + 8 * c8); vv = *(const u32x4*)(Vb + (size_t)tok * 256 + kvh * 64 + 8 * c8); }
            *(LAS u32x4*)(Ks + row * KS_STRIDE + 8 * c8) = kv;
#pragma unroll
            for (int jj = 0; jj < 8; ++jj) Vt[(8 * c8 + jj) * VT_STRIDE + row] = (bf16_t)(vv[jj >> 1] >> (16 * (jj & 1)));
        }
        __syncthreads();
        for (int c = 0; c < 4; ++c) attn_chunk<false>(p, lds, qb, c, kvh, kvh * 8 + wid, 0, lane);
    }
    if (wid < 2)
        for (int it = blockIdx.x * 2 + wid; it < 512; it += gridDim.x * 2) attn_chunk<true>(p, lds, 0, 0, it & 3, 0, it >> 2, lane);
}

constexpr int LDS_BYTES = pg8::STAGE_BYTES + 16;

__global__ void __launch_bounds__(512, 2) fwd_megakernel(Params p) {
    extern __shared__ __attribute__((aligned(16))) unsigned char lds_raw[];
    LAS unsigned char* lds = (LAS unsigned char*)lds_raw;
    cg::grid_group grid = cg::this_grid();
    if (p.never) grid.sync();
    if (threadIdx.x < 4) ((LAS unsigned*)(lds + pg8::STAGE_BYTES))[threadIdx.x] = 0u;
    __syncthreads();
    const XcdBarrier xb = xcd_barrier_post((unsigned*)(p.ws + WS_BAR), (volatile LAS unsigned*)(lds + pg8::STAGE_BYTES));
    const int tid = threadIdx.x, wid = __builtin_amdgcn_readfirstlane(tid >> 6), lane = tid & 63;
    const int G = gridDim.x, bid = blockIdx.x;
    unsigned char* ws = p.ws;

    for (int rep = 0; rep < REP_P0; ++rep) p0_prologue(p, lds, wid, lane);
    for (int rep = 0; rep < REP_SYNC; ++rep) xcd_barrier(xb);
    xcd_barrier(xb);
    {
        pg8::Gemm g{(const bf16_t*)(ws + WS_XN), (const bf16_t*)(ws + WS_WIN), MT, DIN, DM}; pg8::StaticOrder S; S.init(MT, DIN, G, bid);
        Epi1 E{(bf16_t*)(ws + WS_Q), (bf16_t*)(ws + WS_K), (bf16_t*)(ws + WS_V), (bf16_t*)(ws + WS_U), (bf16_t*)(ws + WS_BG), (bf16_t*)(ws + WS_SGA),
               p.q_norm, p.k_norm, (const float*)(ws + WS_COS), (const float*)(ws + WS_SIN), p.out};
        for (int rep = 0; rep < REP_P1; ++rep) pg8::gemm_phase<Epi1>(lds, g, S, E);
    }
    xcd_barrier(xb);
    for (int rep = 0; rep < REP_P2; ++rep) p2_attention(p, lds, tid, wid, lane);
    xcd_barrier(xb);
    {
        pg8::Gemm g{(const bf16_t*)(ws + WS_MIX), (const bf16_t*)(ws + WS_WOUT), MT, DM, DM}; pg8::StaticOrder S; S.init(MT, DM, G, bid);
        Epi3 E{p.xp, p.xs, p.norm_ffn, p.out, (bf16_t*)(ws + WS_A2), (float*)(ws + WS_SSQ)};
        for (int rep = 0; rep < REP_P3; ++rep) pg8::gemm_phase<Epi3>(lds, g, S, E);
    }
    xcd_barrier(xb);
    {
        pg8::Gemm g{(const bf16_t*)(ws + WS_A2), (const bf16_t*)(ws + WS_WGU), MT, NGU, DM}; pg8::StaticOrder S; S.init(MT, NGU, G, bid);
        Epi4 E{(const float*)(ws + WS_SSQ), (bf16_t*)(ws + WS_HID)};
        for (int rep = 0; rep < REP_P4; ++rep) pg8::gemm_phase<Epi4>(lds, g, S, E);
    }
    xcd_barrier(xb);
    {
        pg8::Gemm g{(const bf16_t*)(ws + WS_HID), (const bf16_t*)(ws + WS_WDN), MT, DM, DFF}; pg8::StaticOrder S; S.init(MT, DM, G, bid);
        Epi5 E{p.out};
        pg8::gemm_phase<Epi5>(lds, g, S, E);
    }
}

extern "C" void kernel_launch(void* const* d_in, const int* in_sizes, int n_in, void* d_out, int out_size, void* d_ws, size_t ws_size, hipStream_t stream) {
    static int grid = 0;
    if (!grid) {
        int dev = 0, cus = 0, per_cu = 0;
        (void)hipGetDevice(&dev);
        (void)hipDeviceGetAttribute(&cus, hipDeviceAttributeMultiprocessorCount, dev);
        (void)hipFuncSetAttribute((const void*)fwd_megakernel, hipFuncAttributeMaxDynamicSharedMemorySize, LDS_BYTES);
        (void)hipOccupancyMaxActiveBlocksPerMultiprocessor(&per_cu, (const void*)fwd_megakernel, 512, LDS_BYTES);
        if (per_cu < 1) per_cu = 1;
        grid = cus * per_cu;
        if (ws_size < WS_END) fprintf(stderr, "kernel_launch: workspace too small (%zu < %zu)\n", ws_size, (size_t)WS_END);
    }
    Params p{};
    p.xp = (const float*)d_in[0]; p.xs = (const float*)d_in[1]; p.ck = (const float*)d_in[2]; p.cv = (const float*)d_in[3]; p.sconv = (const float*)d_in[4];
    p.norm_mix = (const float*)d_in[5]; p.w_in = (const float*)d_in[6]; p.q_norm = (const float*)d_in[7]; p.k_norm = (const float*)d_in[8]; p.sinks = (const float*)d_in[9];
    p.conv_w = (const float*)d_in[10]; p.w_out = (const float*)d_in[11]; p.norm_ffn = (const float*)d_in[12]; p.w_gu = (const float*)d_in[13]; p.w_dn = (const float*)d_in[14];
    p.out = (float*)d_out; p.ws = (unsigned char*)d_ws;
    p.never = 0;
    (void)hipMemsetAsync((char*)d_ws + WS_BAR, 0, 16384, stream);
    void* args[] = {&p};
    hipError_t e = hipLaunchCooperativeKernel((const void*)fwd_megakernel, dim3(grid), dim3(512), args, LDS_BYTES, stream);
    if (e != hipSuccess) fprintf(stderr, "cooperative launch failed: %s (grid %d)\n", hipGetErrorString(e), grid);
}
```

```cpp
#include <hip/hip_runtime.h>
#include <hip/hip_cooperative_groups.h>
#include <cstdio>
namespace cg = cooperative_groups;
#define REP_P0 1
#define REP_P1 1
#define REP_P2 1
#define REP_P3 1
#define REP_P4 1
#define REP_SYNC 0

#define LAS __attribute__((address_space(3)))
#define DI __device__ __forceinline__
typedef unsigned short bf16_t;
typedef short bf16x8 __attribute__((ext_vector_type(8)));
typedef short s16x4 __attribute__((ext_vector_type(4)));
typedef float f32x4 __attribute__((ext_vector_type(4)));
typedef float f32x16 __attribute__((ext_vector_type(16)));
typedef unsigned u32x4 __attribute__((ext_vector_type(4)));
typedef unsigned u32x2 __attribute__((ext_vector_type(2)));

constexpr int DM = 2048, TP = 8192, TS = 512, MT = TP + TS, DIN = 12800, DFF = 5632, NGU = 2 * DFF;
constexpr float EPS = 1e-6f;
constexpr int NPOS = 8196;
constexpr size_t O_YP = 0, O_YS = (size_t)TP * DM, O_PK = O_YS + (size_t)TS * DM, O_PV = O_PK + 32768, O_PC = O_PV + 32768,
                 O_SK = O_PC + 4096, O_SV = O_SK + 4194304, O_SC = O_SV + 4194304;
constexpr size_t WS_WIN = 0, WS_WOUT = WS_WIN + (size_t)DIN * DM * 2, WS_WGU = WS_WOUT + (size_t)DM * DM * 2, WS_WDN = WS_WGU + (size_t)NGU * DM * 2,
                 WS_XN = WS_WDN + (size_t)DM * DFF * 2, WS_Q = WS_XN + (size_t)MT * DM * 2, WS_K = WS_Q + (size_t)MT * DM * 2, WS_V = WS_K + (size_t)MT * 256 * 2,
                 WS_U = WS_V + (size_t)MT * 256 * 2, WS_BG = WS_U + (size_t)MT * DM * 2, WS_SGA = WS_BG + (size_t)MT * DM * 2, WS_COS = WS_SGA + (size_t)MT * DM * 2,
                 WS_SIN = WS_COS + (size_t)NPOS * 32 * 4, WS_SSQ = WS_SIN + (size_t)NPOS * 32 * 4, WS_BAR = WS_SSQ + (size_t)MT * 32 * 4, WS_END = WS_BAR + 16384;
constexpr size_t WS_MIX = WS_XN, WS_A2 = WS_Q, WS_HID = WS_U;
static_assert((size_t)MT * DFF * 2 <= 3 * (size_t)MT * DM * 2, "hidden fits in U|BG|SGA");

struct Params {
    const float *xp, *xs, *ck, *cv, *sconv, *norm_mix, *w_in, *q_norm, *k_norm, *sinks, *conv_w, *w_out, *norm_ffn, *w_gu, *w_dn;
    float* out; unsigned char* ws; long never;
};

typedef float f32x2 __attribute__((ext_vector_type(2)));
typedef __bf16 bf16x2v __attribute__((ext_vector_type(2)));
DI unsigned pk2(float lo, float hi) { const f32x2 f = {lo, hi}; return __builtin_bit_cast(unsigned, __builtin_convertvector(f, bf16x2v)); }
DI u32x2 pk4(f32x4 v) { u32x2 r; r.x = pk2(v[0], v[1]); r.y = pk2(v[2], v[3]); return r; }
DI float bf_lo(unsigned w) { return __uint_as_float(w << 16); }
DI float bf_hi(unsigned w) { return __uint_as_float(w & 0xffff0000u); }
DI f32x4 unpk4(u32x2 w) { return (f32x4){bf_lo(w.x), bf_hi(w.x), bf_lo(w.y), bf_hi(w.y)}; }
DI float sigmoidf_(float x) { return __builtin_amdgcn_rcpf(1.0f + __builtin_amdgcn_exp2f(-1.44269504089f * x)); }
DI float wave_sum(float v) {
#pragma unroll
    for (int o = 1; o < 64; o <<= 1) v += __shfl_xor(v, o);
    return v;
}


#define XB_TMO      128
#define XB_XCNT(j)  (256  + 64 * (j))
#define XB_XSUB(j)  (1280 + 64 * (j))
#define XB_XGEN(j)  (2304 + 64 * (j))
#define XB_TOP      3328
#define XB_TOPGEN   3392
#define XCD_BAR_WORDS 3456
#define XB_SPIN_CAP (1u << 20)
DI unsigned xb_ld(unsigned* p)              { return __hip_atomic_load(p, __ATOMIC_RELAXED, __HIP_MEMORY_SCOPE_AGENT); }
DI unsigned xb_add(unsigned* p, unsigned v) { return __hip_atomic_fetch_add(p, v, __ATOMIC_RELAXED, __HIP_MEMORY_SCOPE_AGENT); }
DI unsigned xb_xcc_id() { return (unsigned)__builtin_amdgcn_s_getreg((3 << 11) | 20) & 0xFu; }
#define XB_SPIN(cond, bar) do { unsigned _sp = 0; while (cond) { __builtin_amdgcn_s_sleep(1); \
    if ((++_sp & 255u) == 0u) { if (xb_ld(&(bar)[XB_TMO])) break; if (_sp > XB_SPIN_CAP) { atomicAdd(&(bar)[XB_TMO], 1u); break; } } } } while (0)
struct XcdBarrier { unsigned* bar; unsigned x; volatile LAS unsigned* st; };
DI XcdBarrier xcd_barrier_post(unsigned* bar, volatile LAS unsigned* st) {
    XcdBarrier b; b.bar = bar; b.x = xb_xcc_id(); b.st = st;
    if (threadIdx.x == 0) (void)xb_add(&bar[XB_XCNT(b.x)], 1u);
    return b;
}
DI void xcd_barrier_complete(unsigned* bar, unsigned x, unsigned& nloc, unsigned& nx) {
    const unsigned G = gridDim.x * gridDim.y * gridDim.z;
    unsigned sum, cnt, mine, sp = 0u;
    for (;;) {
        sum = 0u; cnt = 0u; mine = 0u;
#pragma unroll
        for (unsigned j = 0; j < 16; ++j) { const unsigned c = xb_ld(&bar[XB_XCNT(j)]); sum += c; cnt += (c > 0u) ? 1u : 0u; mine = (j == x) ? c : mine; }
        if (sum == G) break;
        __builtin_amdgcn_s_sleep(1);
        if ((++sp & 255u) == 0u) { if (xb_ld(&bar[XB_TMO])) break; if (sp > XB_SPIN_CAP) { atomicAdd(&bar[XB_TMO], 1u); break; } }
    }
    nloc = mine > 0u ? mine : 1u; nx = cnt > 0u ? cnt : 1u;
}
DI void xcd_barrier(const XcdBarrier& b) {
    asm volatile("s_waitcnt vmcnt(0)" ::: "memory");
    __syncthreads();
    if (threadIdx.x == 0) {
        unsigned* bar = b.bar;
        __builtin_amdgcn_s_waitcnt(0);
        unsigned nloc = b.st[0], nx = b.st[1];
        if (nloc == 0u) { xcd_barrier_complete(bar, b.x, nloc, nx); b.st[0] = nloc; b.st[1] = nx; }
        const unsigned old = xb_add(&bar[XB_XSUB(b.x)], 1u);
        const unsigned gen = old / nloc;
        if (old + 1u == (gen + 1u) * nloc) {
            __builtin_amdgcn_fence(__ATOMIC_RELEASE, "agent");
            asm volatile("s_waitcnt vmcnt(0)" ::: "memory");
            const unsigned og = xb_add(&bar[XB_TOP], 1u);
            const unsigned tg = og / nx;
            if (og + 1u == (tg + 1u) * nx) xb_add(&bar[XB_TOPGEN], 1u);
            else XB_SPIN(xb_ld(&bar[XB_TOPGEN]) == tg, bar);
            __builtin_amdgcn_fence(__ATOMIC_ACQUIRE, "agent");
            xb_add(&bar[XB_XGEN(b.x)], 1u);
            asm volatile("s_waitcnt vmcnt(0)" ::: "memory");
        } else {
            XB_SPIN(xb_ld(&bar[XB_XGEN(b.x)]) == gen, bar);
            __builtin_amdgcn_fence(__ATOMIC_ACQUIRE, "agent");
            asm volatile("s_waitcnt vmcnt(0)" ::: "memory");
        }
    }
    __syncthreads();
}

namespace pg8 {
constexpr int BM = 256, BK = 64, HALF = 128, HTB = HALF * BK * 2, STAGE_BYTES = 8 * HTB, NXCD = 8, WGM = 8;
DI int lds_byte(int r, int c) { const int st = (r >> 4) * 2 + (c >> 5), rr = r & 15, cc = c & 31, ob = rr * 64 + cc * 2; return st * 1024 + (ob ^ (((ob >> 9) & 1) << 5)); }
DI void stage_rc(int b, int& R, int& C) { const int st = b / 1024, sb = b % 1024, swz = sb ^ (((sb >> 9) & 1) << 5); R = (st >> 1) * 16 + swz / 64; C = (st & 1) * 32 + (swz % 64) / 2; }
struct Unit { int pm, pn; };
struct Gemm { const bf16_t* A; const bf16_t* Bt; int M, N, K; };
struct StaticOrder {
    int nM, nN, nwg, G, c;
    DI void init(int M, int N, int G_, int c_) { nM = M / BM; nN = N / BM; nwg = nM * nN; G = G_; c = c_; }
    DI bool next(int i, Unit& u) const {
        const long L = (long)i * G + c; if (L >= nwg) return false;
        int wgid = (int)L; { const int q = nwg / NXCD, r = nwg % NXCD, xcd = wgid % NXCD, off = wgid / NXCD; wgid = (xcd < r ? xcd * (q + 1) : r * (q + 1) + (xcd - r) * q) + off; }
        const int nig = WGM * nN, gid = wgid / nig, fm = gid * WGM, gsz = (nM - fm) < WGM ? (nM - fm) : WGM;
        u.pm = fm + ((wgid % nig) % gsz); u.pn = (wgid % nig) / gsz; return true;
    }
};

template <class Epi>
DI void gemm_phase(LAS unsigned char* lds, const Gemm g, const StaticOrder& S, const Epi& E) {
    const int tid = threadIdx.x, wid = __builtin_amdgcn_readfirstlane(tid >> 6), lane = tid & 63, wr = wid >> 2, wc = wid & 3, fr = lane & 15, fq = lane >> 4;
    const int K = g.K, nt = K / BK;
    unsigned voffA[2];
#pragma unroll
    for (int i = 0; i < 2; ++i) { int R, C; stage_rc(tid * 16 + i * 8192, R, C); voffA[i] = (unsigned)(R * K + C) * 2u; }
    const size_t kstep = (size_t)(BK * 2);
    const size_t hstep = (size_t)HALF * K * 2;
    const size_t tstep = 2 * hstep;
    const unsigned ldsw = (unsigned)wid * 1024u;
    const int aoff = lds_byte(wr * 64 + fr, fq * 8), boff = lds_byte(wc * 32 + fr, fq * 8);
#define PG8_SA(b, h) (((b) * 2 + (h)) * HTB)
#define PG8_SB(b, h) ((4 + (b) * 2 + (h)) * HTB)
#define PG8_STAGE(bufoff, gbase) do { _Pragma("unroll") for (int _i = 0; _i < 2; ++_i) \
        __builtin_amdgcn_global_load_lds((const unsigned*)((const char*)(gbase) + voffA[_i]), (LAS unsigned*)(lds + (bufoff) + ldsw + _i * 8192), 16, 0, 0); } while (0)
#define PG8_LDA(dst, b, h) do { _Pragma("unroll") for (int m = 0; m < 4; ++m) _Pragma("unroll") for (int k = 0; k < 2; ++k) dst[m][k] = *(const LAS bf16x8*)(lds + PG8_SA(b, h) + aoff + m * 2048 + k * 1024); } while (0)
#define PG8_LDB(dst, b, h) do { _Pragma("unroll") for (int n = 0; n < 2; ++n) _Pragma("unroll") for (int k = 0; k < 2; ++k) dst[n][k] = *(const LAS bf16x8*)(lds + PG8_SB(b, h) + boff + n * 2048 + k * 1024); } while (0)
#define PG8_MMA(ai, bj, At, Bt) do { __builtin_amdgcn_s_setprio(1); _Pragma("unroll") for (int m = 0; m < 4; ++m) _Pragma("unroll") for (int n = 0; n < 2; ++n) _Pragma("unroll") for (int k = 0; k < 2; ++k) \
        acc[ai][bj][m][n] = __builtin_amdgcn_mfma_f32_16x16x32_bf16(Bt[n][k], At[m][k], acc[ai][bj][m][n], 0, 0, 0); __builtin_amdgcn_s_setprio(0); } while (0)
#define PG8_WAIT_V(n) asm volatile("s_waitcnt vmcnt(" #n ")" ::: "memory")
#define PG8_WAIT_L(n) asm volatile("s_waitcnt lgkmcnt(" #n ")" ::: "memory")
#define PG8_BAR __builtin_amdgcn_s_barrier()
#define PG8_SCHED __builtin_amdgcn_sched_barrier(0)
    Unit cur, nxt; int ui = 0;
    if (!S.next(0, cur)) return;
    f32x4 acc[2][2][4][2];
#pragma unroll
    for (int a = 0; a < 2; ++a)
#pragma unroll
        for (int b = 0; b < 2; ++b)
#pragma unroll
            for (int m = 0; m < 4; ++m)
#pragma unroll
                for (int n = 0; n < 2; ++n) acc[a][b][m][n] = (f32x4){0.f, 0.f, 0.f, 0.f};
    bf16x8 At[4][2], B0[2][2], B1[2][2];
    const char* cA = (const char*)g.A + (size_t)cur.pm * tstep; const char* cB = (const char*)g.Bt + (size_t)cur.pn * tstep;
    PG8_STAGE(PG8_SB(0, 0), cB); PG8_STAGE(PG8_SA(0, 0), cA); PG8_STAGE(PG8_SB(0, 1), cB + hstep); PG8_STAGE(PG8_SA(0, 1), cA + hstep);
    if (wr == 1) PG8_BAR;
    PG8_WAIT_V(4); PG8_BAR;
    PG8_STAGE(PG8_SB(1, 0), cB + kstep); PG8_STAGE(PG8_SA(1, 0), cA + kstep); PG8_STAGE(PG8_SB(1, 1), cB + hstep + kstep);
    PG8_WAIT_V(6); PG8_BAR;
    for (;;) {
        const bool has_next = S.next(ui + 1, nxt);
        const char* nA = has_next ? (const char*)g.A + (size_t)nxt.pm * tstep : cA; const char* nB = has_next ? (const char*)g.Bt + (size_t)nxt.pn * tstep : cB;
        for (int t = 0; t < nt; t += 2) {
            const bool last = (t == nt - 2);
            const char* a1 = cA + (size_t)(t + 1) * kstep;
            const char* a2 = last ? nA : cA + (size_t)(t + 2) * kstep; const char* b2 = last ? nB : cB + (size_t)(t + 2) * kstep;
            const char* a3 = a2 + kstep; const char* b3 = b2 + kstep;
            PG8_LDB(B0, 0, 0); PG8_SCHED; PG8_LDA(At, 0, 0); PG8_STAGE(PG8_SA(1, 1), a1 + hstep);
            PG8_WAIT_L(8); PG8_BAR; PG8_WAIT_L(0); PG8_MMA(0, 0, At, B0); PG8_BAR; PG8_SCHED;
            PG8_LDB(B1, 0, 1); PG8_STAGE(PG8_SB(0, 0), b2);
            PG8_BAR; PG8_WAIT_L(0); PG8_MMA(0, 1, At, B1); PG8_BAR;
            PG8_LDA(At, 0, 1); PG8_STAGE(PG8_SA(0, 0), a2);
            PG8_BAR; PG8_WAIT_L(0); PG8_MMA(1, 0, At, B0); PG8_BAR; PG8_SCHED;
            PG8_STAGE(PG8_SB(0, 1), b2 + hstep);
            PG8_WAIT_V(6); PG8_BAR; PG8_MMA(1, 1, At, B1); PG8_BAR;
            PG8_LDB(B0, 1, 0); PG8_SCHED; PG8_LDA(At, 1, 0); PG8_STAGE(PG8_SA(0, 1), a2 + hstep);
            PG8_WAIT_L(8); PG8_BAR; PG8_WAIT_L(0); PG8_MMA(0, 0, At, B0); PG8_BAR; PG8_SCHED;
            PG8_LDB(B1, 1, 1); PG8_STAGE(PG8_SB(1, 0), b3);
            PG8_BAR; PG8_WAIT_L(0); PG8_MMA(0, 1, At, B1); PG8_BAR;
            PG8_LDA(At, 1, 1); PG8_STAGE(PG8_SA(1, 0), a3);
            PG8_BAR; PG8_WAIT_L(0); PG8_MMA(1, 0, At, B0); PG8_BAR; PG8_SCHED;
            PG8_STAGE(PG8_SB(1, 1), b3 + hstep);
            PG8_WAIT_V(6); PG8_BAR; PG8_MMA(1, 1, At, B1); PG8_BAR;
        }
        E(acc, cur, wr, wc, fr, fq);
        if (!has_next) break;
#pragma unroll
        for (int a = 0; a < 2; ++a)
#pragma unroll
            for (int b = 0; b < 2; ++b)
#pragma unroll
                for (int m = 0; m < 4; ++m)
#pragma unroll
                    for (int n = 0; n < 2; ++n) acc[a][b][m][n] = (f32x4){0.f, 0.f, 0.f, 0.f};
        cur = nxt; cA = nA; cB = nB; ++ui;
    }
    PG8_WAIT_V(0);
    if (wr == 0) PG8_BAR;
    PG8_BAR;
#undef PG8_SA
#undef PG8_SB
#undef PG8_STAGE
#undef PG8_LDA
#undef PG8_LDB
#undef PG8_MMA
#undef PG8_WAIT_V
#undef PG8_WAIT_L
#undef PG8_BAR
#undef PG8_SCHED
}
}

typedef f32x4 AccT[2][2][4][2];

DI int src_col_in(int R) {
    const int pn = R >> 8, c = R & 255, bj = c >> 7, wc = (c >> 5) & 3, r5 = c & 31;
    if (pn < 8) return (4 * pn + wc) * 64 + 32 * bj + r5;
    if (pn == 8) return 2048 + wc * 64 + 32 * bj + r5;
    if (pn == 9) return 2304 + c;
    if (pn < 26) return (bj ? 6656 : 2560) + 128 * (pn - 10) + (c & 127);
    if (pn < 42) return (bj ? 10752 : 4608) + 128 * (pn - 26) + (c & 127);
    return 8704 + 256 * (pn - 42) + c;
}
DI int src_col_gu(int R) { const int t = R >> 8, c = R & 255; return ((c >> 7) ? DFF : 0) + 128 * t + (c & 127); }

DI unsigned bperm(int src4, unsigned v) { return (unsigned)__builtin_amdgcn_ds_bpermute(src4, (int)v); }
DI u32x2 perm2(int src4, u32x2 v) { u32x2 r; r.x = bperm(src4, v.x); r.y = bperm(src4, v.y); return r; }
DI f32x4 perm4(int src4, f32x4 v) { f32x4 r; r[0] = __uint_as_float(bperm(src4, __float_as_uint(v[0]))); r[1] = __uint_as_float(bperm(src4, __float_as_uint(v[1])));
    r[2] = __uint_as_float(bperm(src4, __float_as_uint(v[2]))); r[3] = __uint_as_float(bperm(src4, __float_as_uint(v[3]))); return r; }

struct Epi1 {
    bf16_t *Q, *Kb, *Vb, *U, *BG, *SGA; const float *qg, *kg, *cosT, *sinT; float* out;
    DI void side_kv(float* pwin, float* swin, int row, int col, f32x4 v) const {
        if (row >= TP - 128 && row < TP) *(f32x4*)(pwin + (size_t)(row - (TP - 128)) * 256 + col) = v;
        if (row >= TP) { const int b = (row - TP) >> 2, i = (row - TP) & 3; *(f32x4*)(swin + (size_t)b * 32768 + (size_t)(124 + i) * 256 + col) = v; }
    }
    DI void operator()(const AccT& acc, const pg8::Unit& u, int wr, int wc, int fr, int fq) const {
        asm volatile("" : "+v"(fr), "+v"(fq));
        const int lane = fr + 16 * fq, tr = lane >> 2, tq = lane & 3, src4 = (tr + 16 * tq) * 4;
        const int pn = u.pn, row0 = u.pm * 256 + wr * 64 + fr, rowT0 = u.pm * 256 + wr * 64 + tr;
        const bool side = u.pm >= 31;
        if (pn < 9) {
            const float* g = pn < 8 ? qg : kg;
            f32x4 gv[2][2];
#pragma unroll
            for (int bj = 0; bj < 2; ++bj)
#pragma unroll
                for (int n = 0; n < 2; ++n) gv[bj][n] = *(const f32x4*)(g + 32 * bj + 16 * n + 4 * fq);
#pragma unroll
            for (int aim = 0; aim < 4; ++aim) {
                const int ai = aim >> 1, mh = (aim & 1) * 2;
                f32x4 cs[4][2], sn[4][2];
#pragma unroll
                for (int m = mh; m < mh + 2; ++m) {
                    const int row = row0 + 128 * ai + 16 * m;
                    const int pos = row < TP ? row : TP + ((row - TP) & 3);
#pragma unroll
                    for (int n = 0; n < 2; ++n) { cs[m][n] = *(const f32x4*)(cosT + (size_t)pos * 32 + 16 * n + 4 * fq); sn[m][n] = *(const f32x4*)(sinT + (size_t)pos * 32 + 16 * n + 4 * fq); }
                }
#pragma unroll
                for (int m = mh; m < mh + 2; ++m) {
                    const int rowT = rowT0 + 128 * ai + 16 * m;
                    float ssq = 0.f;
#pragma unroll
                    for (int bj = 0; bj < 2; ++bj)
#pragma unroll
                        for (int n = 0; n < 2; ++n) { const f32x4 x = acc[ai][bj][m][n]; ssq += (x[0] * x[0] + x[1] * x[1]) + (x[2] * x[2] + x[3] * x[3]); }
                    ssq += __shfl_xor(ssq, 16); ssq += __shfl_xor(ssq, 32);
                    const float rs = __builtin_amdgcn_rsqf(ssq * (1.0f / 64.0f) + EPS);
#pragma unroll
                    for (int n = 0; n < 2; ++n) {
                        const f32x4 y1 = acc[ai][0][m][n] * rs * gv[0][n], y2 = acc[ai][1][m][n] * rs * gv[1][n];
                        const f32x4 o1 = y1 * cs[m][n] - y2 * sn[m][n], o2 = y2 * cs[m][n] + y1 * sn[m][n];
                        const int d = 16 * n + 4 * tq;
                        const u32x2 w1 = perm2(src4, pk4(o1)), w2 = perm2(src4, pk4(o2));
                        if (pn < 8) {
                            bf16_t* qp = Q + (size_t)rowT * DM + (4 * pn + wc) * 64 + d;
                            *(u32x2*)qp = w1; *(u32x2*)(qp + 32) = w2;
                        } else {
                            bf16_t* kp = Kb + (size_t)rowT * 256 + wc * 64 + d;
                            *(u32x2*)kp = w1; *(u32x2*)(kp + 32) = w2;
                            if (side) { const f32x4 t1 = perm4(src4, o1), t2 = perm4(src4, o2);
                                side_kv(out + O_PK, out + O_SK, rowT, wc * 64 + d, t1); side_kv(out + O_PK, out + O_SK, rowT, wc * 64 + d + 32, t2); }
                        }
                    }
                }
            }
        } else if (pn == 9) {
#pragma unroll
            for (int ai = 0; ai < 2; ++ai)
#pragma unroll
                for (int m = 0; m < 4; ++m) {
                    const int rowT = rowT0 + 128 * ai + 16 * m;
#pragma unroll
                    for (int bj = 0; bj < 2; ++bj)
#pragma unroll
                        for (int n = 0; n < 2; ++n) { const int col = 128 * bj + 32 * wc + 16 * n + 4 * tq; const f32x4 v = acc[ai][bj][m][n];
                            *(u32x2*)(Vb + (size_t)rowT * 256 + col) = perm2(src4, pk4(v));
                            if (side) side_kv(out + O_PV, out + O_SV, rowT, col, perm4(src4, v)); }
                }
        } else if (pn < 26) {
            const int t = pn - 10;
#pragma unroll
            for (int ai = 0; ai < 2; ++ai)
#pragma unroll
                for (int m = 0; m < 4; ++m) {
                    const int rowT = rowT0 + 128 * ai + 16 * m;
#pragma unroll
                    for (int n = 0; n < 2; ++n) { const int col = 128 * t + 32 * wc + 16 * n + 4 * tq; const f32x4 v = acc[ai][0][m][n] * acc[ai][1][m][n];
                        *(u32x2*)(U + (size_t)rowT * DM + col) = perm2(src4, pk4(v));
                        if (side) { const f32x4 vt = perm4(src4, v);
                            if (rowT >= TP - 2 && rowT < TP) *(f32x4*)(out + O_PC + (size_t)(rowT - (TP - 2)) * DM + col) = vt;
                            if (rowT >= TP && ((rowT - TP) & 3) >= 2) { const int b = (rowT - TP) >> 2, i = (rowT - TP) & 3; *(f32x4*)(out + O_SC + (size_t)b * 4096 + (size_t)(i - 2) * DM + col) = vt; } } }
                }
        } else if (pn < 42) {
            const int t = pn - 26;
#pragma unroll
            for (int ai = 0; ai < 2; ++ai)
#pragma unroll
                for (int m = 0; m < 4; ++m) {
                    const int rowT = rowT0 + 128 * ai + 16 * m;
#pragma unroll
                    for (int n = 0; n < 2; ++n) { const int col = 128 * t + 32 * wc + 16 * n + 4 * tq; const f32x4 b = acc[ai][0][m][n], gc = acc[ai][1][m][n];
                        f32x4 v; v[0] = b[0] * sigmoidf_(gc[0]); v[1] = b[1] * sigmoidf_(gc[1]); v[2] = b[2] * sigmoidf_(gc[2]); v[3] = b[3] * sigmoidf_(gc[3]);
                        *(u32x2*)(BG + (size_t)rowT * DM + col) = perm2(src4, pk4(v)); }
                }
        } else {
#pragma unroll
            for (int ai = 0; ai < 2; ++ai)
#pragma unroll
                for (int m = 0; m < 4; ++m) {
                    const int rowT = rowT0 + 128 * ai + 16 * m;
#pragma unroll
                    for (int bj = 0; bj < 2; ++bj)
#pragma unroll
                        for (int n = 0; n < 2; ++n) { const int col = 256 * (pn - 42) + 128 * bj + 32 * wc + 16 * n + 4 * tq; const f32x4 a = acc[ai][bj][m][n];
                            f32x4 v; v[0] = sigmoidf_(a[0]); v[1] = sigmoidf_(a[1]); v[2] = sigmoidf_(a[2]); v[3] = sigmoidf_(a[3]);
                            *(u32x2*)(SGA + (size_t)rowT * DM + col) = perm2(src4, pk4(v)); }
                }
        }
    }
};

struct Epi3 {
    const float *xp, *xs, *gffn; float* Y; bf16_t* A2; float* SSQ;
    DI void operator()(const AccT& acc, const pg8::Unit& u, int wr, int wc, int fr, int fq) const {
        asm volatile("" : "+v"(fr), "+v"(fq));
        const int lane = fr + 16 * fq, tr = lane >> 2, tq = lane & 3, src4 = (tr + 16 * tq) * 4;
        const int rowT0 = u.pm * 256 + wr * 64 + tr, colT0 = u.pn * 256 + wc * 32 + 4 * tq;
        const float* xb = u.pm < 32 ? xp : xs - (size_t)TP * DM;
        f32x4 gv[2][2];
#pragma unroll
        for (int bj = 0; bj < 2; ++bj)
#pragma unroll
            for (int n = 0; n < 2; ++n) gv[bj][n] = *(const f32x4*)(gffn + colT0 + 128 * bj + 16 * n);
#pragma unroll
        for (int aim = 0; aim < 4; ++aim) {
            const int ai = aim >> 1, mh = (aim & 1) * 2;
            f32x4 xv[4][2][2];
#pragma unroll
            for (int m = mh; m < mh + 2; ++m)
#pragma unroll
                for (int bj = 0; bj < 2; ++bj)
#pragma unroll
                    for (int n = 0; n < 2; ++n) xv[m][bj][n] = *(const f32x4*)(xb + (size_t)(rowT0 + 128 * ai + 16 * m) * DM + colT0 + 128 * bj + 16 * n);
#pragma unroll
            for (int m = mh; m < mh + 2; ++m) {
                const int rowT = rowT0 + 128 * ai + 16 * m; float ssq = 0.f;
#pragma unroll
                for (int bj = 0; bj < 2; ++bj)
#pragma unroll
                    for (int n = 0; n < 2; ++n) { const size_t off = (size_t)rowT * DM + colT0 + 128 * bj + 16 * n;
                        const f32x4 y = xv[m][bj][n] + perm4(src4, acc[ai][bj][m][n]);
                        ssq += (y[0] * y[0] + y[1] * y[1]) + (y[2] * y[2] + y[3] * y[3]);
                        *(f32x4*)(Y + off) = y; *(u32x2*)(A2 + off) = pk4(y * gv[bj][n]); }
                ssq += __shfl_xor(ssq, 1); ssq += __shfl_xor(ssq, 2);
                if (tq == 0) SSQ[(size_t)rowT * 32 + u.pn * 4 + wc] = ssq;
            }
        }
    }
};

struct Epi4 {
    const float* SSQ; bf16_t* HID;
    DI void operator()(const AccT& acc, const pg8::Unit& u, int wr, int wc, int fr, int fq) const {
        asm volatile("" : "+v"(fr), "+v"(fq));
        const int lane = fr + 16 * fq, tr = lane >> 2, tq = lane & 3, src4 = (tr + 16 * tq) * 4;
        const int row0 = u.pm * 256 + wr * 64 + fr, rowT0 = u.pm * 256 + wr * 64 + tr, colT0 = u.pn * 128 + wc * 32 + 4 * tq;
#pragma unroll
        for (int ai = 0; ai < 2; ++ai) {
            f32x4 sp[4][2];
#pragma unroll
            for (int m = 0; m < 4; ++m) { const f32x4* q = (const f32x4*)(SSQ + (size_t)(row0 + 128 * ai + 16 * m) * 32 + 8 * fq); sp[m][0] = q[0]; sp[m][1] = q[1]; }
#pragma unroll
            for (int m = 0; m < 4; ++m) {
                const int rowT = rowT0 + 128 * ai + 16 * m;
                const f32x4 s4 = sp[m][0] + sp[m][1];
                float ss = (s4[0] + s4[1]) + (s4[2] + s4[3]);
                ss += __shfl_xor(ss, 16); ss += __shfl_xor(ss, 32);
                const float rstd = __builtin_amdgcn_rsqf(ss * (1.0f / DM) + EPS);
#pragma unroll
                for (int n = 0; n < 2; ++n) { const f32x4 g = acc[ai][0][m][n] * rstd, up = acc[ai][1][m][n] * rstd;
                    f32x4 h; h[0] = g[0] * sigmoidf_(g[0]) * up[0]; h[1] = g[1] * sigmoidf_(g[1]) * up[1]; h[2] = g[2] * sigmoidf_(g[2]) * up[2]; h[3] = g[3] * sigmoidf_(g[3]) * up[3];
                    *(u32x2*)(HID + (size_t)rowT * DFF + colT0 + 16 * n) = perm2(src4, pk4(h)); }
            }
        }
    }
};

struct Epi5 {
    float* Y;
    DI void operator()(const AccT& acc, const pg8::Unit& u, int wr, int wc, int fr, int fq) const {
        asm volatile("" : "+v"(fr), "+v"(fq));
        const int lane = fr + 16 * fq, tr = lane >> 2, tq = lane & 3, src4 = (tr + 16 * tq) * 4;
        const int rowT0 = u.pm * 256 + wr * 64 + tr, colT0 = u.pn * 256 + wc * 32 + 4 * tq;
#pragma unroll
        for (int aim = 0; aim < 4; ++aim) {
            const int ai = aim >> 1, mh = (aim & 1) * 2;
            f32x4 yv[4][2][2];
#pragma unroll
            for (int m = mh; m < mh + 2; ++m)
#pragma unroll
                for (int bj = 0; bj < 2; ++bj)
#pragma unroll
                    for (int n = 0; n < 2; ++n) yv[m][bj][n] = *(const f32x4*)(Y + (size_t)(rowT0 + 128 * ai + 16 * m) * DM + colT0 + 128 * bj + 16 * n);
#pragma unroll
            for (int m = mh; m < mh + 2; ++m)
#pragma unroll
                for (int bj = 0; bj < 2; ++bj)
#pragma unroll
                    for (int n = 0; n < 2; ++n) *(f32x4*)(Y + (size_t)(rowT0 + 128 * ai + 16 * m) * DM + colT0 + 128 * bj + 16 * n) = yv[m][bj][n] + perm4(src4, acc[ai][bj][m][n]);
        }
    }
};

DI void p0_transpose_item(const float* W, int K, int N, bf16_t* WT, int src_n0, int dst_n0, int k0, LAS float* scr, int lane) {
#pragma unroll 8
    for (int i = 0; i < 32; ++i) { const int kk = 2 * i + (lane >> 5); scr[kk * 33 + (lane & 31)] = W[(size_t)(k0 + kk) * N + src_n0 + (lane & 31)]; }
    asm volatile("s_waitcnt lgkmcnt(0)" ::: "memory");
    const int c = lane & 7;
#pragma unroll
    for (int j = 0; j < 4; ++j) { const int n = (lane >> 3) + 8 * j; const LAS float* s = scr + (8 * c) * 33 + n;
        u32x4 o; o.x = pk2(s[0 * 33], s[1 * 33]); o.y = pk2(s[2 * 33], s[3 * 33]); o.z = pk2(s[4 * 33], s[5 * 33]); o.w = pk2(s[6 * 33], s[7 * 33]);
        *(u32x4*)(WT + (size_t)(dst_n0 + n) * K + k0 + 8 * c) = o; }
    asm volatile("s_waitcnt lgkmcnt(0)" ::: "memory");
}

DI void p0_prologue(const Params& p, LAS unsigned char* lds, int wid, int lane) {
    LAS float* scr = (LAS float*)(lds + wid * 8704);
    const int gw = blockIdx.x * 8 + wid, NGW = gridDim.x * 8;
    bf16_t* WinT = (bf16_t*)(p.ws + WS_WIN); bf16_t* WoutT = (bf16_t*)(p.ws + WS_WOUT); bf16_t* WguT = (bf16_t*)(p.ws + WS_WGU); bf16_t* WdnT = (bf16_t*)(p.ws + WS_WDN);
    constexpr int I_IN = (DM / 64) * (DIN / 32), I_OUT = (DM / 64) * (DM / 32), I_GU = (DM / 64) * (NGU / 32), I_DN = (DFF / 64) * (DM / 32);
    constexpr int NITEMS = I_IN + I_OUT + I_GU + I_DN;
    for (int it = gw; it < NITEMS; it += NGW) {
        int r = it;
        if (r < I_IN) { const int nblk = DIN / 32, kb = r / nblk, nb = r % nblk; p0_transpose_item(p.w_in, DM, DIN, WinT, src_col_in(32 * nb), 32 * nb, 64 * kb, scr, lane); continue; } r -= I_IN;
        if (r < I_OUT) { const int nblk = DM / 32, kb = r / nblk, nb = r % nblk; p0_transpose_item(p.w_out, DM, DM, WoutT, 32 * nb, 32 * nb, 64 * kb, scr, lane); continue; } r -= I_OUT;
        if (r < I_GU) { const int nblk = NGU / 32, kb = r / nblk, nb = r % nblk; p0_transpose_item(p.w_gu, DM, NGU, WguT, src_col_gu(32 * nb), 32 * nb, 64 * kb, scr, lane); continue; } r -= I_GU;
        { const int nblk = DM / 32, kb = r / nblk, nb = r % nblk; p0_transpose_item(p.w_dn, DFF, DM, WdnT, 32 * nb, 32 * nb, 64 * kb, scr, lane); }
    }
    bf16_t* XN = (bf16_t*)(p.ws + WS_XN);
    for (int m = gw; m < MT; m += NGW) {
        const float* xrow = m < TP ? p.xp + (size_t)m * DM : p.xs + (size_t)(m - TP) * DM;
        const f32x4* xr = (const f32x4*)xrow + lane; f32x4 v[8]; float s = 0.f;
#pragma unroll
        for (int j = 0; j < 8; ++j) { v[j] = xr[64 * j]; s += (v[j][0] * v[j][0] + v[j][1] * v[j][1]) + (v[j][2] * v[j][2] + v[j][3] * v[j][3]); }
        const float rstd = 1.0f / sqrtf(wave_sum(s) * (1.0f / DM) + EPS);
        u32x2* o8 = (u32x2*)(XN + (size_t)m * DM) + lane;
#pragma unroll
        for (int j = 0; j < 8; ++j) { const f32x4 gv = ((const f32x4*)p.norm_mix)[64 * j + lane]; o8[64 * j] = pk4(v[j] * rstd * gv); }
    }
    float* cosT = (float*)(p.ws + WS_COS); float* sinT = (float*)(p.ws + WS_SIN);
    const int gt = blockIdx.x * 512 + threadIdx.x, GT = gridDim.x * 512;
    for (int idx = gt; idx < NPOS * 32; idx += GT) {
        const int pos = idx >> 5, i = idx & 31;
        const float inv = __builtin_amdgcn_exp2f(-(float)i * (13.287712379549449f / 32.0f));
        const float ang = (float)pos * inv;
        const double rev = (double)ang * 0.15915494309189535; const float fr = (float)(rev - __builtin_floor(rev));
        cosT[idx] = __builtin_amdgcn_cosf(fr); sinT[idx] = __builtin_amdgcn_sinf(fr);
    }
    for (int idx = gt; idx < 128 * 7936; idx += GT) {
        const int b = idx / 7936, e = idx - b * 7936;
        ((f32x4*)(p.out + O_SK + (size_t)b * 32768))[e] = ((const f32x4*)(p.ck + (size_t)b * 32768 + 1024))[e];
        ((f32x4*)(p.out + O_SV + (size_t)b * 32768))[e] = ((const f32x4*)(p.cv + (size_t)b * 32768 + 1024))[e];
    }
}

#define MFMA32(a, b, c) __builtin_amdgcn_mfma_f32_32x32x16_bf16((a), (b), (c), 0, 0, 0)
DI int crow(int reg, int h) { return (reg & 3) + 8 * (reg >> 2) + 4 * h; }
DI bf16x8 pack8(const f32x16& x, int s) {
    u32x4 p; p.x = pk2(x[8 * s], x[8 * s + 1]); p.y = pk2(x[8 * s + 2], x[8 * s + 3]); p.z = pk2(x[8 * s + 4], x[8 * s + 5]); p.w = pk2(x[8 * s + 6], x[8 * s + 7]);
    return __builtin_bit_cast(bf16x8, p);
}
DI bf16x8 cvt8(f32x4 a, f32x4 b) { u32x4 p; p.x = pk2(a[0], a[1]); p.y = pk2(a[2], a[3]); p.z = pk2(b[0], b[1]); p.w = pk2(b[2], b[3]); return __builtin_bit_cast(bf16x8, p); }

constexpr int KS_STRIDE = 72, VT_STRIDE = 260, VT_OFF = 256 * KS_STRIDE * 2;

template <bool SAMPLE>
DI void attn_chunk(const Params& p, LAS unsigned char* lds, int qb, int c, int kvh, int head_w, int b_s, int lane) {
    const bf16_t* Q = (const bf16_t*)(p.ws + WS_Q); const bf16_t* Kb = (const bf16_t*)(p.ws + WS_K); const bf16_t* Vb = (const bf16_t*)(p.ws + WS_V);
    const bf16_t* U = (const bf16_t*)(p.ws + WS_U); const bf16_t* BG = (const bf16_t*)(p.ws + WS_BG); const bf16_t* SGA = (const bf16_t*)(p.ws + WS_SGA);
    bf16_t* MIX = (bf16_t*)(p.ws + WS_MIX);
    const int r = lane & 31, g = lane >> 5;
    int tok, head, itok = 0;
    if (SAMPLE) { itok = r >> 3; head = kvh * 8 + (r & 7); tok = TP + 4 * b_s + itok; }
    else { head = head_w; tok = 128 * qb + 32 * c + r; }
    const LAS bf16_t* Ks = (const LAS bf16_t*)lds; const LAS bf16_t* Vt = (const LAS bf16_t*)(lds + VT_OFF);
    bf16x8 qf[4];
#pragma unroll
    for (int ks = 0; ks < 4; ++ks) qf[ks] = *(const bf16x8*)(Q + (size_t)tok * DM + head * 64 + 16 * ks + 8 * g);
    f32x16 s[5];
#pragma unroll
    for (int kbr = 0; kbr < 5; ++kbr) {
#pragma unroll
        for (int i = 0; i < 16; ++i) s[kbr][i] = 0.f;
#pragma unroll
        for (int ks = 0; ks < 4; ++ks) {
            bf16x8 a;
            if (SAMPLE) {
                if (kbr < 4) { const float* kp = p.ck + ((size_t)(b_s * 128 + 32 * kbr + r) * 4 + kvh) * 64 + 16 * ks + 8 * g; a = cvt8(*(const f32x4*)kp, *(const f32x4*)(kp + 4)); }
                else { u32x4 z = (u32x4){0u, 0u, 0u, 0u}; if (r < 4) z = *(const u32x4*)(Kb + (size_t)(TP + 4 * b_s + r) * 256 + kvh * 64 + 16 * ks + 8 * g); a = __builtin_bit_cast(bf16x8, z); }
            } else a = *(const LAS bf16x8*)(Ks + (32 * (c + kbr) + r) * KS_STRIDE + 16 * ks + 8 * g);
            s[kbr] = MFMA32(a, qf[ks], s[kbr]);
        }
    }
    const float sc = 0.125f * 1.44269504089f;
    const float sink2 = p.sinks[head] * 1.44269504089f;
    float mraw = -1e30f;
#pragma unroll
    for (int kbr = 0; kbr < 5; ++kbr)
#pragma unroll
        for (int i = 0; i < 16; ++i) {
            const int kr = crow(i, g); bool valid;
            if (SAMPLE) valid = kbr < 4 ? (32 * kbr + kr > itok) : (kr <= itok);
            else { valid = kbr == 0 ? (kr > r) : (kbr == 4 ? (kr <= r) : true); if (qb == 0 && c + kbr < 4) valid = false; }
            const float t = valid ? s[kbr][i] : -1e30f; s[kbr][i] = t; mraw = fmaxf(mraw, t);
        }
    mraw = fmaxf(mraw, __shfl_xor(mraw, 32));
    const float mx = fmaxf(mraw * sc, sink2);
    float sum = 0.f;
#pragma unroll
    for (int kbr = 0; kbr < 5; ++kbr)
#pragma unroll
        for (int i = 0; i < 16; ++i) { const float e = __builtin_amdgcn_exp2f(__builtin_fmaf(s[kbr][i], sc, -mx)); s[kbr][i] = e; sum += e; }
    sum += __shfl_xor(sum, 32);
    const float inv = 1.0f / (sum + __builtin_amdgcn_exp2f(sink2 - mx));
    f32x16 o[2];
#pragma unroll
    for (int dt = 0; dt < 2; ++dt)
#pragma unroll
        for (int i = 0; i < 16; ++i) o[dt][i] = 0.f;
#pragma unroll
    for (int kbr = 0; kbr < 5; ++kbr)
#pragma unroll
        for (int kk = 0; kk < 2; ++kk) {
            const bf16x8 pb = pack8(s[kbr], kk);
#pragma unroll
            for (int dt = 0; dt < 2; ++dt) {
                bf16x8 a; const int d = 32 * dt + r;
                if (SAMPLE) {
                    if (kbr < 4) { float f[8];
#pragma unroll
                        for (int j = 0; j < 8; ++j) { const int key = 32 * kbr + 16 * kk + 8 * (j >> 2) + 4 * g + (j & 3); f[j] = p.cv[((size_t)(b_s * 128 + key) * 4 + kvh) * 64 + d]; }
                        a = cvt8((f32x4){f[0], f[1], f[2], f[3]}, (f32x4){f[4], f[5], f[6], f[7]});
                    } else { u32x4 z = (u32x4){0u, 0u, 0u, 0u};
                        if (kk == 0 && g == 0) { const bf16_t* vp = Vb + (size_t)(TP + 4 * b_s) * 256 + kvh * 64 + d; z.x = (unsigned)vp[0] | ((unsigned)vp[256] << 16); z.y = (unsigned)vp[512] | ((unsigned)vp[768] << 16); }
                        a = __builtin_bit_cast(bf16x8, z); }
                } else {
                    const LAS bf16_t* vp = Vt + d * VT_STRIDE + 32 * (c + kbr) + 16 * kk + 4 * g;
                    const s16x4 lo = *(const LAS s16x4*)vp, hi = *(const LAS s16x4*)(vp + 8);
                    a = __builtin_shufflevector(lo, hi, 0, 1, 2, 3, 4, 5, 6, 7);
                }
                o[dt] = MFMA32(a, pb, o[dt]);
            }
        }
    if (!SAMPLE) {
#pragma unroll
        for (int dt = 0; dt < 2; ++dt)
#pragma unroll
            for (int i4 = 0; i4 < 4; ++i4) {
                const int col = head * 64 + 32 * dt + 8 * i4 + 4 * g;
                const f32x4 at = (f32x4){o[dt][4 * i4], o[dt][4 * i4 + 1], o[dt][4 * i4 + 2], o[dt][4 * i4 + 3]} * inv;
                *(u32x2*)(MIX + (size_t)tok * DM + col) = pk4(at);
            }
        return;
    }
#pragma unroll
    for (int dt = 0; dt < 2; ++dt) {
        u32x2 lsga[4], lbg[4], lu0[4]; f32x4 lu1[4], lu2[4], w0[4], w1[4], w2[4];
#pragma unroll
        for (int i4 = 0; i4 < 4; ++i4) {
            const int col = head * 64 + 32 * dt + 8 * i4 + 4 * g; const size_t off = (size_t)tok * DM + col;
            lsga[i4] = *(const u32x2*)(SGA + off); lbg[i4] = *(const u32x2*)(BG + off); lu0[i4] = *(const u32x2*)(U + off);
            lu1[i4] = itok >= 1 ? unpk4(*(const u32x2*)(U + off - DM)) : *(const f32x4*)(p.sconv + (size_t)b_s * 4096 + DM + col);
            lu2[i4] = itok >= 2 ? unpk4(*(const u32x2*)(U + off - 2 * DM)) : *(const f32x4*)(p.sconv + (size_t)b_s * 4096 + (size_t)itok * DM + col);
            w0[i4] = *(const f32x4*)(p.conv_w + col); w1[i4] = *(const f32x4*)(p.conv_w + DM + col); w2[i4] = *(const f32x4*)(p.conv_w + 2 * DM + col);
        }
#pragma unroll
        for (int i4 = 0; i4 < 4; ++i4) {
            const int col = head * 64 + 32 * dt + 8 * i4 + 4 * g; const size_t off = (size_t)tok * DM + col;
            const f32x4 at = (f32x4){o[dt][4 * i4], o[dt][4 * i4 + 1], o[dt][4 * i4 + 2], o[dt][4 * i4 + 3]} * inv;
            const f32x4 conv = w0[i4] * lu2[i4] + w1[i4] * lu1[i4] + w2[i4] * unpk4(lu0[i4]);
            *(u32x2*)(MIX + off) = pk4(unpk4(lsga[i4]) * at + unpk4(lbg[i4]) * conv);
        }
    }
}

DI void unpk8(u32x4 w, f32x4& lo, f32x4& hi) { lo = (f32x4){bf_lo(w.x), bf_hi(w.x), bf_lo(w.y), bf_hi(w.y)}; hi = (f32x4){bf_lo(w.z), bf_hi(w.z), bf_lo(w.w), bf_hi(w.w)}; }

constexpr int P2_CNT_OFF = 120000;
DI void p2_attention(const Params& p, LAS unsigned char* lds, int tid, int wid, int lane) {
    const bf16_t* Kb = (const bf16_t*)(p.ws + WS_K); const bf16_t* Vb = (const bf16_t*)(p.ws + WS_V);
    const bf16_t* U = (const bf16_t*)(p.ws + WS_U); const bf16_t* BG = (const bf16_t*)(p.ws + WS_BG); const bf16_t* SGA = (const bf16_t*)(p.ws + WS_SGA);
    bf16_t* MIX = (bf16_t*)(p.ws + WS_MIX);
    LAS bf16_t* Ks = (LAS bf16_t*)lds; LAS bf16_t* Vt = (LAS bf16_t*)(lds + VT_OFF);
    LAS unsigned* cnt = (LAS unsigned*)(lds + P2_CNT_OFF);
    int samp_next = blockIdx.x * 2;
    for (int item = blockIdx.x; item < 256; item += gridDim.x) {
        const int qb = item >> 2, kvh = item & 3;
        __syncthreads();
#pragma unroll
        for (int i = 0; i < 4; ++i) {
            const int e = tid + 512 * i, row = e >> 3, c8 = e & 7, tok = 128 * (qb - 1) + row;
            u32x4 kv = (u32x4){0u, 0u, 0u, 0u}, vv = (u32x4){0u, 0u, 0u, 0u};
            if (tok >= 0) { kv = *(const u32x4*)(Kb + (size_t)tok * 256 + kvh * 64 + 8 * c8); vv = *(const u32x4*)(Vb + (size_t)tok * 256 + kvh * 64 + 8 * c8); }
            *(LAS u32x4*)(Ks + row * KS_STRIDE + 8 * c8) = kv;
#pragma unroll
            for (int jj = 0; jj < 8; ++jj) Vt[(8 * c8 + jj) * VT_STRIDE + row] = (bf16_t)(vv[jj >> 1] >> (16 * (jj & 1)));
        }
        if (tid == 0) *cnt = 0u;
        __syncthreads();
        const int ns = (samp_next < 512) ? ((samp_next + 1 < 512) ? 2 : 1) : 0;
        for (;;) {
            unsigned t = 0; if (lane == 0) t = __hip_atomic_fetch_add(cnt, 1u, __ATOMIC_RELAXED, __HIP_MEMORY_SCOPE_WORKGROUP);
            t = __builtin_amdgcn_readfirstlane(t);
            if ((int)t >= ns + 32) break;
            if ((int)t < ns) { const int it = samp_next + (int)t; attn_chunk<true>(p, lds, 0, 0, it & 3, 0, it >> 2, lane); }
            else { const int pc = (int)t - ns; attn_chunk<false>(p, lds, qb, pc & 3, kvh, kvh * 8 + (pc >> 2), 0, lane); }
        }
        samp_next += gridDim.x * 2;
        asm volatile("s_waitcnt vmcnt(0)" ::: "memory");
        __syncthreads();
        __builtin_amdgcn_fence(__ATOMIC_ACQUIRE, "agent");
        {
            const int c8 = tid & 63, rbase = tid >> 6, col = kvh * 512 + 8 * c8;
            f32x4 w[3][2];
#pragma unroll
            for (int k = 0; k < 3; ++k) { w[k][0] = *(const f32x4*)(p.conv_w + k * DM + col); w[k][1] = *(const f32x4*)(p.conv_w + k * DM + col + 4); }
#pragma unroll
            for (int ib = 0; ib < 4; ++ib) {
                u32x4 la[4], ls[4], lb[4], l0[4], l1[4], l2[4];
#pragma unroll
                for (int ii = 0; ii < 4; ++ii) {
                    const int tok = 128 * qb + rbase + 8 * (4 * ib + ii); const size_t off = (size_t)tok * DM + col;
                    la[ii] = *(const u32x4*)(MIX + off); ls[ii] = *(const u32x4*)(SGA + off); lb[ii] = *(const u32x4*)(BG + off); l0[ii] = *(const u32x4*)(U + off);
                    l1[ii] = (u32x4){0u, 0u, 0u, 0u}; l2[ii] = (u32x4){0u, 0u, 0u, 0u};
                    if (tok >= 1) l1[ii] = *(const u32x4*)(U + off - DM);
                    if (tok >= 2) l2[ii] = *(const u32x4*)(U + off - 2 * DM);
                }
#pragma unroll
                for (int ii = 0; ii < 4; ++ii) {
                    const int tok = 128 * qb + rbase + 8 * (4 * ib + ii); const size_t off = (size_t)tok * DM + col;
                    f32x4 a0, a1, s0, s1, b0, b1, x0, x1, y0, y1, z0, z1;
                    unpk8(la[ii], a0, a1); unpk8(ls[ii], s0, s1); unpk8(lb[ii], b0, b1); unpk8(l0[ii], x0, x1); unpk8(l1[ii], y0, y1); unpk8(l2[ii], z0, z1);
                    const f32x4 m0 = s0 * a0 + b0 * (w[0][0] * z0 + w[1][0] * y0 + w[2][0] * x0);
                    const f32x4 m1 = s1 * a1 + b1 * (w[0][1] * z1 + w[1][1] * y1 + w[2][1] * x1);
                    u32x4 o; o.x = pk2(m0[0], m0[1]); o.y = pk2(m0[2], m0[3]); o.z = pk2(m1[0], m1[1]); o.w = pk2(m1[2], m1[3]);
                    *(u32x4*)(MIX + off) = o;
                }
            }
        }
    }
    for (int it = samp_next + (wid & 1); it < 512 && wid < 2; it += gridDim.x * 2) attn_chunk<true>(p, lds, 0, 0, it & 3, 0, it >> 2, lane);
}

constexpr int LDS_BYTES = pg8::STAGE_BYTES + 16;

__global__ void __launch_bounds__(512, 2) fwd_megakernel(Params p) {
    extern __shared__ __attribute__((aligned(16))) unsigned char lds_raw[];
    LAS unsigned char* lds = (LAS unsigned char*)lds_raw;
    cg::grid_group grid = cg::this_grid();
    if (p.never) grid.sync();
    if (threadIdx.x < 4) ((LAS unsigned*)(lds + pg8::STAGE_BYTES))[threadIdx.x] = 0u;
    __syncthreads();
    const XcdBarrier xb = xcd_barrier_post((unsigned*)(p.ws + WS_BAR), (volatile LAS unsigned*)(lds + pg8::STAGE_BYTES));
    const int tid = threadIdx.x, wid = __builtin_amdgcn_readfirstlane(tid >> 6), lane = tid & 63;
    const int G = gridDim.x, bid = blockIdx.x;
    unsigned char* ws = p.ws;

    for (int rep = 0; rep < REP_P0; ++rep) p0_prologue(p, lds, wid, lane);
    for (int rep = 0; rep < REP_SYNC; ++rep) xcd_barrier(xb);
    xcd_barrier(xb);
    {
        pg8::Gemm g{(const bf16_t*)(ws + WS_XN), (const bf16_t*)(ws + WS_WIN), MT, DIN, DM}; pg8::StaticOrder S; S.init(MT, DIN, G, bid);
        Epi1 E{(bf16_t*)(ws + WS_Q), (bf16_t*)(ws + WS_K), (bf16_t*)(ws + WS_V), (bf16_t*)(ws + WS_U), (bf16_t*)(ws + WS_BG), (bf16_t*)(ws + WS_SGA),
               p.q_norm, p.k_norm, (const float*)(ws + WS_COS), (const float*)(ws + WS_SIN), p.out};
        for (int rep = 0; rep < REP_P1; ++rep) pg8::gemm_phase<Epi1>(lds, g, S, E);
    }
    xcd_barrier(xb);
    for (int rep = 0; rep < REP_P2; ++rep) p2_attention(p, lds, tid, wid, lane);
    xcd_barrier(xb);
    {
        pg8::Gemm g{(const bf16_t*)(ws + WS_MIX), (const bf16_t*)(ws + WS_WOUT), MT, DM, DM}; pg8::StaticOrder S; S.init(MT, DM, G, bid);
        Epi3 E{p.xp, p.xs, p.norm_ffn, p.out, (bf16_t*)(ws + WS_A2), (float*)(ws + WS_SSQ)};
        for (int rep = 0; rep < REP_P3; ++rep) pg8::gemm_phase<Epi3>(lds, g, S, E);
    }
    xcd_barrier(xb);
    {
        pg8::Gemm g{(const bf16_t*)(ws + WS_A2), (const bf16_t*)(ws + WS_WGU), MT, NGU, DM}; pg8::StaticOrder S; S.init(MT, NGU, G, bid);
        Epi4 E{(const float*)(ws + WS_SSQ), (bf16_t*)(ws + WS_HID)};
        for (int rep = 0; rep < REP_P4; ++rep) pg8::gemm_phase<Epi4>(lds, g, S, E);
    }
    xcd_barrier(xb);
    {
        pg8::Gemm g{(const bf16_t*)(ws + WS_HID), (const bf16_t*)(ws + WS_WDN), MT, DM, DFF}; pg8::StaticOrder S; S.init(MT, DM, G, bid);
        Epi5 E{p.out};
        pg8::gemm_phase<Epi5>(lds, g, S, E);
    }
}

extern "C" void kernel_launch(void* const* d_in, const int* in_sizes, int n_in, void* d_out, int out_size, void* d_ws, size_t ws_size, hipStream_t stream) {
    static int grid = 0;
    if (!grid) {
        int dev = 0, cus = 0, per_cu = 0;
        (void)hipGetDevice(&dev);
        (void)hipDeviceGetAttribute(&cus, hipDeviceAttributeMultiprocessorCount, dev);
        (void)hipFuncSetAttribute((const void*)fwd_megakernel, hipFuncAttributeMaxDynamicSharedMemorySize, LDS_BYTES);
        (void)hipOccupancyMaxActiveBlocksPerMultiprocessor(&per_cu, (const void*)fwd_megakernel, 512, LDS_BYTES);
        if (per_cu < 1) per_cu = 1;
        grid = cus * per_cu;
        if (ws_size < WS_END) fprintf(stderr, "kernel_launch: workspace too small (%zu < %zu)\n", ws_size, (size_t)WS_END);
    }
    Params p{};
    p.xp = (const float*)d_in[0]; p.xs = (const float*)d_in[1]; p.ck = (const float*)d_in[2]; p.cv = (const float*)d_in[3]; p.sconv = (const float*)d_in[4];
    p.norm_mix = (const float*)d_in[5]; p.w_in = (const float*)d_in[6]; p.q_norm = (const float*)d_in[7]; p.k_norm = (const float*)d_in[8]; p.sinks = (const float*)d_in[9];
    p.conv_w = (const float*)d_in[10]; p.w_out = (const float*)d_in[11]; p.norm_ffn = (const float*)d_in[12]; p.w_gu = (const float*)d_in[13]; p.w_dn = (const float*)d_in[14];
    p.out = (float*)d_out; p.ws = (unsigned char*)d_ws;
    p.never = 0;
    (void)hipMemsetAsync((char*)d_ws + WS_BAR, 0, 16384, stream);
    void* args[] = {&p};
    hipError_t e = hipLaunchCooperativeKernel((const void*)fwd_megakernel, dim3(grid), dim3(512), args, LDS_BYTES, stream);
    if (e != hipSuccess) fprintf(stderr, "cooperative launch failed: %s (grid %d)\n", hipGetErrorString(e), grid);
}
```

```cpp
#include <hip/hip_runtime.h>
#include <hip/hip_cooperative_groups.h>
#include <cstdio>
namespace cg = cooperative_groups;
#define REP_P0 1
#define REP_P1 1
#define REP_P2 1
#define REP_P3 1
#define REP_P4 1
#define REP_SYNC 0

#define LAS __attribute__((address_space(3)))
#define DI __device__ __forceinline__
typedef unsigned short bf16_t;
typedef short bf16x8 __attribute__((ext_vector_type(8)));
typedef short s16x4 __attribute__((ext_vector_type(4)));
typedef float f32x4 __attribute__((ext_vector_type(4)));
typedef float f32x16 __attribute__((ext_vector_type(16)));
typedef unsigned u32x4 __attribute__((ext_vector_type(4)));
typedef unsigned u32x2 __attribute__((ext_vector_type(2)));

constexpr int DM = 2048, TP = 8192, TS = 512, MT = TP + TS, DIN = 12800, DFF = 5632, NGU = 2 * DFF;
constexpr float EPS = 1e-6f;
constexpr int NPOS = 8196;
constexpr size_t O_YP = 0, O_YS = (size_t)TP * DM, O_PK = O_YS + (size_t)TS * DM, O_PV = O_PK + 32768, O_PC = O_PV + 32768,
                 O_SK = O_PC + 4096, O_SV = O_SK + 4194304, O_SC = O_SV + 4194304;
constexpr size_t WS_WIN = 0, WS_WOUT = WS_WIN + (size_t)DIN * DM * 2, WS_WGU = WS_WOUT + (size_t)DM * DM * 2, WS_WDN = WS_WGU + (size_t)NGU * DM * 2,
                 WS_XN = WS_WDN + (size_t)DM * DFF * 2, WS_Q = WS_XN + (size_t)MT * DM * 2, WS_K = WS_Q + (size_t)MT * DM * 2, WS_V = WS_K + (size_t)MT * 256 * 2,
                 WS_U = WS_V + (size_t)MT * 256 * 2, WS_BG = WS_U + (size_t)MT * DM * 2, WS_SGA = WS_BG + (size_t)MT * DM * 2, WS_COS = WS_SGA + (size_t)MT * DM * 2,
                 WS_SIN = WS_COS + (size_t)NPOS * 32 * 4, WS_SSQ = WS_SIN + (size_t)NPOS * 32 * 4, WS_BAR = WS_SSQ + (size_t)MT * 32 * 4, WS_END = WS_BAR + 16384;
constexpr size_t WS_MIX = WS_XN, WS_A2 = WS_Q, WS_HID = WS_U;
static_assert((size_t)MT * DFF * 2 <= 3 * (size_t)MT * DM * 2, "hidden fits in U|BG|SGA");

struct Params {
    const float *xp, *xs, *ck, *cv, *sconv, *norm_mix, *w_in, *q_norm, *k_norm, *sinks, *conv_w, *w_out, *norm_ffn, *w_gu, *w_dn;
    float* out; unsigned char* ws; long never;
};

typedef float f32x2 __attribute__((ext_vector_type(2)));
typedef __bf16 bf16x2v __attribute__((ext_vector_type(2)));
DI unsigned pk2(float lo, float hi) { const f32x2 f = {lo, hi}; return __builtin_bit_cast(unsigned, __builtin_convertvector(f, bf16x2v)); }
DI u32x2 pk4(f32x4 v) { u32x2 r; r.x = pk2(v[0], v[1]); r.y = pk2(v[2], v[3]); return r; }
DI float bf_lo(unsigned w) { return __uint_as_float(w << 16); }
DI float bf_hi(unsigned w) { return __uint_as_float(w & 0xffff0000u); }
DI f32x4 unpk4(u32x2 w) { return (f32x4){bf_lo(w.x), bf_hi(w.x), bf_lo(w.y), bf_hi(w.y)}; }
DI float sigmoidf_(float x) { return __builtin_amdgcn_rcpf(1.0f + __builtin_amdgcn_exp2f(-1.44269504089f * x)); }
DI float wave_sum(float v) {
#pragma unroll
    for (int o = 1; o < 64; o <<= 1) v += __shfl_xor(v, o);
    return v;
}


#define XB_TMO      128
#define XB_XCNT(j)  (256  + 64 * (j))
#define XB_XSUB(j)  (1280 + 64 * (j))
#define XB_XGEN(j)  (2304 + 64 * (j))
#define XB_TOP      3328
#define XB_TOPGEN   3392
#define XCD_BAR_WORDS 3456
#define XB_SPIN_CAP (1u << 20)
DI unsigned xb_ld(unsigned* p)              { return __hip_atomic_load(p, __ATOMIC_RELAXED, __HIP_MEMORY_SCOPE_AGENT); }
DI unsigned xb_add(unsigned* p, unsigned v) { return __hip_atomic_fetch_add(p, v, __ATOMIC_RELAXED, __HIP_MEMORY_SCOPE_AGENT); }
DI unsigned xb_xcc_id() { return (unsigned)__builtin_amdgcn_s_getreg((3 << 11) | 20) & 0xFu; }
#define XB_SPIN(cond, bar) do { unsigned _sp = 0; while (cond) { __builtin_amdgcn_s_sleep(1); \
    if ((++_sp & 255u) == 0u) { if (xb_ld(&(bar)[XB_TMO])) break; if (_sp > XB_SPIN_CAP) { atomicAdd(&(bar)[XB_TMO], 1u); break; } } } } while (0)
struct XcdBarrier { unsigned* bar; unsigned x; volatile LAS unsigned* st; };
DI XcdBarrier xcd_barrier_post(unsigned* bar, volatile LAS unsigned* st) {
    XcdBarrier b; b.bar = bar; b.x = xb_xcc_id(); b.st = st;
    if (threadIdx.x == 0) (void)xb_add(&bar[XB_XCNT(b.x)], 1u);
    return b;
}
DI void xcd_barrier_complete(unsigned* bar, unsigned x, unsigned& nloc, unsigned& nx) {
    const unsigned G = gridDim.x * gridDim.y * gridDim.z;
    unsigned sum, cnt, mine, sp = 0u;
    for (;;) {
        sum = 0u; cnt = 0u; mine = 0u;
#pragma unroll
        for (unsigned j = 0; j < 16; ++j) { const unsigned c = xb_ld(&bar[XB_XCNT(j)]); sum += c; cnt += (c > 0u) ? 1u : 0u; mine = (j == x) ? c : mine; }
        if (sum == G) break;
        __builtin_amdgcn_s_sleep(1);
        if ((++sp & 255u) == 0u) { if (xb_ld(&bar[XB_TMO])) break; if (sp > XB_SPIN_CAP) { atomicAdd(&bar[XB_TMO], 1u); break; } }
    }
    nloc = mine > 0u ? mine : 1u; nx = cnt > 0u ? cnt : 1u;
}
DI void xcd_barrier(const XcdBarrier& b) {
    asm volatile("s_waitcnt vmcnt(0)" ::: "memory");
    __syncthreads();
    if (threadIdx.x == 0) {
        unsigned* bar = b.bar;
        __builtin_amdgcn_s_waitcnt(0);
        unsigned nloc = b.st[0], nx = b.st[1];
        if (nloc == 0u) { xcd_barrier_complete(bar, b.x, nloc, nx); b.st[0] = nloc; b.st[1] = nx; }
        const unsigned old = xb_add(&bar[XB_XSUB(b.x)], 1u);
        const unsigned gen = old / nloc;
        if (old + 1u == (gen + 1u) * nloc) {
            __builtin_amdgcn_fence(__ATOMIC_RELEASE, "agent");
            asm volatile("s_waitcnt vmcnt(0)" ::: "memory");
            const unsigned og = xb_add(&bar[XB_TOP], 1u);
            const unsigned tg = og / nx;
            if (og + 1u == (tg + 1u) * nx) xb_add(&bar[XB_TOPGEN], 1u);
            else XB_SPIN(xb_ld(&bar[XB_TOPGEN]) == tg, bar);
            __builtin_amdgcn_fence(__ATOMIC_ACQUIRE, "agent");
            xb_add(&bar[XB_XGEN(b.x)], 1u);
            asm volatile("s_waitcnt vmcnt(0)" ::: "memory");
        } else {
            XB_SPIN(xb_ld(&bar[XB_XGEN(b.x)]) == gen, bar);
            __builtin_amdgcn_fence(__ATOMIC_ACQUIRE, "agent");
            asm volatile("s_waitcnt vmcnt(0)" ::: "memory");
        }
    }
    __syncthreads();
}

namespace pg8 {
constexpr int BM = 256, BK = 64, HALF = 128, HTB = HALF * BK * 2, STAGE_BYTES = 8 * HTB, NXCD = 8, WGM = 8;
DI int lds_byte(int r, int c) { const int st = (r >> 4) * 2 + (c >> 5), rr = r & 15, cc = c & 31, ob = rr * 64 + cc * 2; return st * 1024 + (ob ^ (((ob >> 9) & 1) << 5)); }
DI void stage_rc(int b, int& R, int& C) { const int st = b / 1024, sb = b % 1024, swz = sb ^ (((sb >> 9) & 1) << 5); R = (st >> 1) * 16 + swz / 64; C = (st & 1) * 32 + (swz % 64) / 2; }
struct Unit { int pm, pn; };
struct Gemm { const bf16_t* A; const bf16_t* Bt; int M, N, K; };
struct StaticOrder {
    int nM, nN, nwg, G, c;
    DI void init(int M, int N, int G_, int c_) { nM = M / BM; nN = N / BM; nwg = nM * nN; G = G_; c = c_; }
    DI bool next(int i, Unit& u) const {
        const long L = (long)i * G + c; if (L >= nwg) return false;
        int wgid = (int)L; { const int q = nwg / NXCD, r = nwg % NXCD, xcd = wgid % NXCD, off = wgid / NXCD; wgid = (xcd < r ? xcd * (q + 1) : r * (q + 1) + (xcd - r) * q) + off; }
        const int nig = WGM * nN, gid = wgid / nig, fm = gid * WGM, gsz = (nM - fm) < WGM ? (nM - fm) : WGM;
        u.pm = fm + ((wgid % nig) % gsz); u.pn = (wgid % nig) / gsz; return true;
    }
};

template <class Epi>
DI void gemm_phase(LAS unsigned char* lds, const Gemm g, const StaticOrder& S, const Epi& E) {
    const int tid = threadIdx.x, wid = __builtin_amdgcn_readfirstlane(tid >> 6), lane = tid & 63, wr = wid >> 2, wc = wid & 3, fr = lane & 15, fq = lane >> 4;
    const int K = g.K, nt = K / BK;
    unsigned voffA[2];
#pragma unroll
    for (int i = 0; i < 2; ++i) { int R, C; stage_rc(tid * 16 + i * 8192, R, C); voffA[i] = (unsigned)(R * K + C) * 2u; }
    const size_t kstep = (size_t)(BK * 2);
    const size_t hstep = (size_t)HALF * K * 2;
    const size_t tstep = 2 * hstep;
    const unsigned ldsw = (unsigned)wid * 1024u;
    const int aoff = lds_byte(wr * 64 + fr, fq * 8), boff = lds_byte(wc * 32 + fr, fq * 8);
#define PG8_SA(b, h) (((b) * 2 + (h)) * HTB)
#define PG8_SB(b, h) ((4 + (b) * 2 + (h)) * HTB)
#define PG8_STAGE(bufoff, gbase) do { _Pragma("unroll") for (int _i = 0; _i < 2; ++_i) \
        __builtin_amdgcn_global_load_lds((const unsigned*)((const char*)(gbase) + voffA[_i]), (LAS unsigned*)(lds + (bufoff) + ldsw + _i * 8192), 16, 0, 0); } while (0)
#define PG8_LDA(dst, b, h) do { _Pragma("unroll") for (int m = 0; m < 4; ++m) _Pragma("unroll") for (int k = 0; k < 2; ++k) dst[m][k] = *(const LAS bf16x8*)(lds + PG8_SA(b, h) + aoff + m * 2048 + k * 1024); } while (0)
#define PG8_LDB(dst, b, h) do { _Pragma("unroll") for (int n = 0; n < 2; ++n) _Pragma("unroll") for (int k = 0; k < 2; ++k) dst[n][k] = *(const LAS bf16x8*)(lds + PG8_SB(b, h) + boff + n * 2048 + k * 1024); } while (0)
#define PG8_MMA(ai, bj, At, Bt) do { __builtin_amdgcn_s_setprio(1); _Pragma("unroll") for (int m = 0; m < 4; ++m) _Pragma("unroll") for (int n = 0; n < 2; ++n) _Pragma("unroll") for (int k = 0; k < 2; ++k) \
        acc[ai][bj][m][n] = __builtin_amdgcn_mfma_f32_16x16x32_bf16(Bt[n][k], At[m][k], acc[ai][bj][m][n], 0, 0, 0); __builtin_amdgcn_s_setprio(0); } while (0)
#define PG8_WAIT_V(n) asm volatile("s_waitcnt vmcnt(" #n ")" ::: "memory")
#define PG8_WAIT_L(n) asm volatile("s_waitcnt lgkmcnt(" #n ")" ::: "memory")
#define PG8_BAR __builtin_amdgcn_s_barrier()
#define PG8_SCHED __builtin_amdgcn_sched_barrier(0)
    Unit cur, nxt; int ui = 0;
    if (!S.next(0, cur)) return;
    f32x4 acc[2][2][4][2];
#pragma unroll
    for (int a = 0; a < 2; ++a)
#pragma unroll
        for (int b = 0; b < 2; ++b)
#pragma unroll
            for (int m = 0; m < 4; ++m)
#pragma unroll
                for (int n = 0; n < 2; ++n) acc[a][b][m][n] = (f32x4){0.f, 0.f, 0.f, 0.f};
    bf16x8 At[4][2], B0[2][2], B1[2][2];
    const char* cA = (const char*)g.A + (size_t)cur.pm * tstep; const char* cB = (const char*)g.Bt + (size_t)cur.pn * tstep;
    PG8_STAGE(PG8_SB(0, 0), cB); PG8_STAGE(PG8_SA(0, 0), cA); PG8_STAGE(PG8_SB(0, 1), cB + hstep); PG8_STAGE(PG8_SA(0, 1), cA + hstep);
    if (wr == 1) PG8_BAR;
    PG8_WAIT_V(4); PG8_BAR;
    PG8_STAGE(PG8_SB(1, 0), cB + kstep); PG8_STAGE(PG8_SA(1, 0), cA + kstep); PG8_STAGE(PG8_SB(1, 1), cB + hstep + kstep);
    PG8_WAIT_V(6); PG8_BAR;
    for (;;) {
        const bool has_next = S.next(ui + 1, nxt);
        const char* nA = has_next ? (const char*)g.A + (size_t)nxt.pm * tstep : cA; const char* nB = has_next ? (const char*)g.Bt + (size_t)nxt.pn * tstep : cB;
        for (int t = 0; t < nt; t += 2) {
            const bool last = (t == nt - 2);
            const char* a1 = cA + (size_t)(t + 1) * kstep;
            const char* a2 = last ? nA : cA + (size_t)(t + 2) * kstep; const char* b2 = last ? nB : cB + (size_t)(t + 2) * kstep;
            const char* a3 = a2 + kstep; const char* b3 = b2 + kstep;
            PG8_LDB(B0, 0, 0); PG8_SCHED; PG8_LDA(At, 0, 0); PG8_STAGE(PG8_SA(1, 1), a1 + hstep);
            PG8_WAIT_L(8); PG8_BAR; PG8_WAIT_L(0); PG8_MMA(0, 0, At, B0); PG8_BAR; PG8_SCHED;
            PG8_LDB(B1, 0, 1); PG8_STAGE(PG8_SB(0, 0), b2);
            PG8_BAR; PG8_WAIT_L(0); PG8_MMA(0, 1, At, B1); PG8_BAR;
            PG8_LDA(At, 0, 1); PG8_STAGE(PG8_SA(0, 0), a2);
            PG8_BAR; PG8_WAIT_L(0); PG8_MMA(1, 0, At, B0); PG8_BAR; PG8_SCHED;
            PG8_STAGE(PG8_SB(0, 1), b2 + hstep);
            PG8_WAIT_V(6); PG8_BAR; PG8_MMA(1, 1, At, B1); PG8_BAR;
            PG8_LDB(B0, 1, 0); PG8_SCHED; PG8_LDA(At, 1, 0); PG8_STAGE(PG8_SA(0, 1), a2 + hstep);
            PG8_WAIT_L(8); PG8_BAR; PG8_WAIT_L(0); PG8_MMA(0, 0, At, B0); PG8_BAR; PG8_SCHED;
            PG8_LDB(B1, 1, 1); PG8_STAGE(PG8_SB(1, 0), b3);
            PG8_BAR; PG8_WAIT_L(0); PG8_MMA(0, 1, At, B1); PG8_BAR;
            PG8_LDA(At, 1, 1); PG8_STAGE(PG8_SA(1, 0), a3);
            PG8_BAR; PG8_WAIT_L(0); PG8_MMA(1, 0, At, B0); PG8_BAR; PG8_SCHED;
            PG8_STAGE(PG8_SB(1, 1), b3 + hstep);
            PG8_WAIT_V(6); PG8_BAR; PG8_MMA(1, 1, At, B1); PG8_BAR;
        }
        E(acc, cur, wr, wc, fr, fq);
        if (!has_next) break;
#pragma unroll
        for (int a = 0; a < 2; ++a)
#pragma unroll
            for (int b = 0; b < 2; ++b)
#pragma unroll
                for (int m = 0; m < 4; ++m)
#pragma unroll
                    for (int n = 0; n < 2; ++n) acc[a][b][m][n] = (f32x4){0.f, 0.f, 0.f, 0.f};
        cur = nxt; cA = nA; cB = nB; ++ui;
    }
    PG8_WAIT_V(0);
    if (wr == 0) PG8_BAR;
    PG8_BAR;
#undef PG8_SA
#undef PG8_SB
#undef PG8_STAGE
#undef PG8_LDA
#undef PG8_LDB
#undef PG8_MMA
#undef PG8_WAIT_V
#undef PG8_WAIT_L
#undef PG8_BAR
#undef PG8_SCHED
}
}

typedef f32x4 AccT[2][2][4][2];

DI int src_col_in(int R) {
    const int pn = R >> 8, c = R & 255, bj = c >> 7, wc = (c >> 5) & 3, r5 = c & 31;
    if (pn < 8) return (4 * pn + wc) * 64 + 32 * bj + r5;
    if (pn == 8) return 2048 + wc * 64 + 32 * bj + r5;
    if (pn == 9) return 2304 + c;
    if (pn < 26) return (bj ? 6656 : 2560) + 128 * (pn - 10) + (c & 127);
    if (pn < 42) return (bj ? 10752 : 4608) + 128 * (pn - 26) + (c & 127);
    return 8704 + 256 * (pn - 42) + c;
}
DI int src_col_gu(int R) { const int t = R >> 8, c = R & 255; return ((c >> 7) ? DFF : 0) + 128 * t + (c & 127); }

DI unsigned bperm(int src4, unsigned v) { return (unsigned)__builtin_amdgcn_ds_bpermute(src4, (int)v); }
DI u32x2 perm2(int src4, u32x2 v) { u32x2 r; r.x = bperm(src4, v.x); r.y = bperm(src4, v.y); return r; }
DI f32x4 perm4(int src4, f32x4 v) { f32x4 r; r[0] = __uint_as_float(bperm(src4, __float_as_uint(v[0]))); r[1] = __uint_as_float(bperm(src4, __float_as_uint(v[1])));
    r[2] = __uint_as_float(bperm(src4, __float_as_uint(v[2]))); r[3] = __uint_as_float(bperm(src4, __float_as_uint(v[3]))); return r; }

struct Epi1 {
    bf16_t *Q, *Kb, *Vb, *U, *BG, *SGA; const float *qg, *kg, *cosT, *sinT; float* out;
    DI void side_kv(float* pwin, float* swin, int row, int col, f32x4 v) const {
        if (row >= TP - 128 && row < TP) *(f32x4*)(pwin + (size_t)(row - (TP - 128)) * 256 + col) = v;
        if (row >= TP) { const int b = (row - TP) >> 2, i = (row - TP) & 3; *(f32x4*)(swin + (size_t)b * 32768 + (size_t)(124 + i) * 256 + col) = v; }
    }
    DI void operator()(const AccT& acc, const pg8::Unit& u, int wr, int wc, int fr, int fq) const {
        asm volatile("" : "+v"(fr), "+v"(fq));
        const int lane = fr + 16 * fq, tr = lane >> 2, tq = lane & 3, src4 = (tr + 16 * tq) * 4;
        const int pn = u.pn, row0 = u.pm * 256 + wr * 64 + fr, rowT0 = u.pm * 256 + wr * 64 + tr;
        const bool side = u.pm >= 31;
        if (pn < 9) {
            const float* g = pn < 8 ? qg : kg;
            f32x4 gv[2][2];
#pragma unroll
            for (int bj = 0; bj < 2; ++bj)
#pragma unroll
                for (int n = 0; n < 2; ++n) gv[bj][n] = *(const f32x4*)(g + 32 * bj + 16 * n + 4 * fq);
#pragma unroll
            for (int aim = 0; aim < 4; ++aim) {
                const int ai = aim >> 1, mh = (aim & 1) * 2;
                f32x4 cs[4][2], sn[4][2];
#pragma unroll
                for (int m = mh; m < mh + 2; ++m) {
                    const int row = row0 + 128 * ai + 16 * m;
                    const int pos = row < TP ? row : TP + ((row - TP) & 3);
#pragma unroll
                    for (int n = 0; n < 2; ++n) { cs[m][n] = *(const f32x4*)(cosT + (size_t)pos * 32 + 16 * n + 4 * fq); sn[m][n] = *(const f32x4*)(sinT + (size_t)pos * 32 + 16 * n + 4 * fq); }
                }
#pragma unroll
                for (int m = mh; m < mh + 2; ++m) {
                    const int rowT = rowT0 + 128 * ai + 16 * m;
                    float ssq = 0.f;
#pragma unroll
                    for (int bj = 0; bj < 2; ++bj)
#pragma unroll
                        for (int n = 0; n < 2; ++n) { const f32x4 x = acc[ai][bj][m][n]; ssq += (x[0] * x[0] + x[1] * x[1]) + (x[2] * x[2] + x[3] * x[3]); }
                    ssq += __shfl_xor(ssq, 16); ssq += __shfl_xor(ssq, 32);
                    const float rs = __builtin_amdgcn_rsqf(ssq * (1.0f / 64.0f) + EPS);
#pragma unroll
                    for (int n = 0; n < 2; ++n) {
                        const f32x4 y1 = acc[ai][0][m][n] * rs * gv[0][n], y2 = acc[ai][1][m][n] * rs * gv[1][n];
                        const f32x4 o1 = y1 * cs[m][n] - y2 * sn[m][n], o2 = y2 * cs[m][n] + y1 * sn[m][n];
                        const int d = 16 * n + 4 * tq;
                        const u32x2 w1 = perm2(src4, pk4(o1)), w2 = perm2(src4, pk4(o2));
                        if (pn < 8) {
                            bf16_t* qp = Q + (size_t)rowT * DM + (4 * pn + wc) * 64 + d;
                            *(u32x2*)qp = w1; *(u32x2*)(qp + 32) = w2;
                        } else {
                            bf16_t* kp = Kb + (size_t)rowT * 256 + wc * 64 + d;
                            *(u32x2*)kp = w1; *(u32x2*)(kp + 32) = w2;
                            if (side) { const f32x4 t1 = perm4(src4, o1), t2 = perm4(src4, o2);
                                side_kv(out + O_PK, out + O_SK, rowT, wc * 64 + d, t1); side_kv(out + O_PK, out + O_SK, rowT, wc * 64 + d + 32, t2); }
                        }
                    }
                }
            }
        } else if (pn == 9) {
#pragma unroll
            for (int ai = 0; ai < 2; ++ai)
#pragma unroll
                for (int m = 0; m < 4; ++m) {
                    const int rowT = rowT0 + 128 * ai + 16 * m;
#pragma unroll
                    for (int bj = 0; bj < 2; ++bj)
#pragma unroll
                        for (int n = 0; n < 2; ++n) { const int col = 128 * bj + 32 * wc + 16 * n + 4 * tq; const f32x4 v = acc[ai][bj][m][n];
                            *(u32x2*)(Vb + (size_t)rowT * 256 + col) = perm2(src4, pk4(v));
                            if (side) side_kv(out + O_PV, out + O_SV, rowT, col, perm4(src4, v)); }
                }
        } else if (pn < 26) {
            const int t = pn - 10;
#pragma unroll
            for (int ai = 0; ai < 2; ++ai)
#pragma unroll
                for (int m = 0; m < 4; ++m) {
                    const int rowT = rowT0 + 128 * ai + 16 * m;
#pragma unroll
                    for (int n = 0; n < 2; ++n) { const int col = 128 * t + 32 * wc + 16 * n + 4 * tq; const f32x4 v = acc[ai][0][m][n] * acc[ai][1][m][n];
                        *(u32x2*)(U + (size_t)rowT * DM + col) = perm2(src4, pk4(v));
                        if (side) { const f32x4 vt = perm4(src4, v);
                            if (rowT >= TP - 2 && rowT < TP) *(f32x4*)(out + O_PC + (size_t)(rowT - (TP - 2)) * DM + col) = vt;
                            if (rowT >= TP && ((rowT - TP) & 3) >= 2) { const int b = (rowT - TP) >> 2, i = (rowT - TP) & 3; *(f32x4*)(out + O_SC + (size_t)b * 4096 + (size_t)(i - 2) * DM + col) = vt; } } }
                }
        } else if (pn < 42) {
            const int t = pn - 26;
#pragma unroll
            for (int ai = 0; ai < 2; ++ai)
#pragma unroll
                for (int m = 0; m < 4; ++m) {
                    const int rowT = rowT0 + 128 * ai + 16 * m;
#pragma unroll
                    for (int n = 0; n < 2; ++n) { const int col = 128 * t + 32 * wc + 16 * n + 4 * tq; const f32x4 b = acc[ai][0][m][n], gc = acc[ai][1][m][n];
                        f32x4 v; v[0] = b[0] * sigmoidf_(gc[0]); v[1] = b[1] * sigmoidf_(gc[1]); v[2] = b[2] * sigmoidf_(gc[2]); v[3] = b[3] * sigmoidf_(gc[3]);
                        *(u32x2*)(BG + (size_t)rowT * DM + col) = perm2(src4, pk4(v)); }
                }
        } else {
#pragma unroll
            for (int ai = 0; ai < 2; ++ai)
#pragma unroll
                for (int m = 0; m < 4; ++m) {
                    const int rowT = rowT0 + 128 * ai + 16 * m;
#pragma unroll
                    for (int bj = 0; bj < 2; ++bj)
#pragma unroll
                        for (int n = 0; n < 2; ++n) { const int col = 256 * (pn - 42) + 128 * bj + 32 * wc + 16 * n + 4 * tq; const f32x4 a = acc[ai][bj][m][n];
                            f32x4 v; v[0] = sigmoidf_(a[0]); v[1] = sigmoidf_(a[1]); v[2] = sigmoidf_(a[2]); v[3] = sigmoidf_(a[3]);
                            *(u32x2*)(SGA + (size_t)rowT * DM + col) = perm2(src4, pk4(v)); }
                }
        }
    }
};

struct Epi3 {
    const float *xp, *xs, *gffn; float* Y; bf16_t* A2; float* SSQ;
    DI void operator()(const AccT& acc, const pg8::Unit& u, int wr, int wc, int fr, int fq) const {
        asm volatile("" : "+v"(fr), "+v"(fq));
        const int lane = fr + 16 * fq, tr = lane >> 2, tq = lane & 3, src4 = (tr + 16 * tq) * 4;
        const int rowT0 = u.pm * 256 + wr * 64 + tr, colT0 = u.pn * 256 + wc * 32 + 4 * tq;
        const float* xb = u.pm < 32 ? xp : xs - (size_t)TP * DM;
        f32x4 gv[2][2];
#pragma unroll
        for (int bj = 0; bj < 2; ++bj)
#pragma unroll
            for (int n = 0; n < 2; ++n) gv[bj][n] = *(const f32x4*)(gffn + colT0 + 128 * bj + 16 * n);
#pragma unroll
        for (int aim = 0; aim < 4; ++aim) {
            const int ai = aim >> 1, mh = (aim & 1) * 2;
            f32x4 xv[4][2][2];
#pragma unroll
            for (int m = mh; m < mh + 2; ++m)
#pragma unroll
                for (int bj = 0; bj < 2; ++bj)
#pragma unroll
                    for (int n = 0; n < 2; ++n) xv[m][bj][n] = *(const f32x4*)(xb + (size_t)(rowT0 + 128 * ai + 16 * m) * DM + colT0 + 128 * bj + 16 * n);
#pragma unroll
            for (int m = mh; m < mh + 2; ++m) {
                const int rowT = rowT0 + 128 * ai + 16 * m; float ssq = 0.f;
#pragma unroll
                for (int bj = 0; bj < 2; ++bj)
#pragma unroll
                    for (int n = 0; n < 2; ++n) { const size_t off = (size_t)rowT * DM + colT0 + 128 * bj + 16 * n;
                        const f32x4 y = xv[m][bj][n] + perm4(src4, acc[ai][bj][m][n]);
                        ssq += (y[0] * y[0] + y[1] * y[1]) + (y[2] * y[2] + y[3] * y[3]);
                        *(f32x4*)(Y + off) = y; *(u32x2*)(A2 + off) = pk4(y * gv[bj][n]); }
                ssq += __shfl_xor(ssq, 1); ssq += __shfl_xor(ssq, 2);
                if (tq == 0) SSQ[(size_t)rowT * 32 + u.pn * 4 + wc] = ssq;
            }
        }
    }
};

struct Epi4 {
    const float* SSQ; bf16_t* HID;
    DI void operator()(const AccT& acc, const pg8::Unit& u, int wr, int wc, int fr, int fq) const {
        asm volatile("" : "+v"(fr), "+v"(fq));
        const int lane = fr + 16 * fq, tr = lane >> 2, tq = lane & 3, src4 = (tr + 16 * tq) * 4;
        const int row0 = u.pm * 256 + wr * 64 + fr, rowT0 = u.pm * 256 + wr * 64 + tr, colT0 = u.pn * 128 + wc * 32 + 4 * tq;
#pragma unroll
        for (int ai = 0; ai < 2; ++ai) {
            f32x4 sp[4][2];
#pragma unroll
            for (int m = 0; m < 4; ++m) { const f32x4* q = (const f32x4*)(SSQ + (size_t)(row0 + 128 * ai + 16 * m) * 32 + 8 * fq); sp[m][0] = q[0]; sp[m][1] = q[1]; }
#pragma unroll
            for (int m = 0; m < 4; ++m) {
                const int rowT = rowT0 + 128 * ai + 16 * m;
                const f32x4 s4 = sp[m][0] + sp[m][1];
                float ss = (s4[0] + s4[1]) + (s4[2] + s4[3]);
                ss += __shfl_xor(ss, 16); ss += __shfl_xor(ss, 32);
                const float rstd = __builtin_amdgcn_rsqf(ss * (1.0f / DM) + EPS);
#pragma unroll
                for (int n = 0; n < 2; ++n) { const f32x4 g = acc[ai][0][m][n] * rstd, up = acc[ai][1][m][n] * rstd;
                    f32x4 h; h[0] = g[0] * sigmoidf_(g[0]) * up[0]; h[1] = g[1] * sigmoidf_(g[1]) * up[1]; h[2] = g[2] * sigmoidf_(g[2]) * up[2]; h[3] = g[3] * sigmoidf_(g[3]) * up[3];
                    *(u32x2*)(HID + (size_t)rowT * DFF + colT0 + 16 * n) = perm2(src4, pk4(h)); }
            }
        }
    }
};

struct Epi5 {
    float* Y;
    DI void operator()(const AccT& acc, const pg8::Unit& u, int wr, int wc, int fr, int fq) const {
        asm volatile("" : "+v"(fr), "+v"(fq));
        const int lane = fr + 16 * fq, tr = lane >> 2, tq = lane & 3, src4 = (tr + 16 * tq) * 4;
        const int rowT0 = u.pm * 256 + wr * 64 + tr, colT0 = u.pn * 256 + wc * 32 + 4 * tq;
#pragma unroll
        for (int aim = 0; aim < 4; ++aim) {
            const int ai = aim >> 1, mh = (aim & 1) * 2;
            f32x4 yv[4][2][2];
#pragma unroll
            for (int m = mh; m < mh + 2; ++m)
#pragma unroll
                for (int bj = 0; bj < 2; ++bj)
#pragma unroll
                    for (int n = 0; n < 2; ++n) yv[m][bj][n] = *(const f32x4*)(Y + (size_t)(rowT0 + 128 * ai + 16 * m) * DM + colT0 + 128 * bj + 16 * n);
#pragma unroll
            for (int m = mh; m < mh + 2; ++m)
#pragma unroll
                for (int bj = 0; bj < 2; ++bj)
#pragma unroll
                    for (int n = 0; n < 2; ++n) *(f32x4*)(Y + (size_t)(rowT0 + 128 * ai + 16 * m) * DM + colT0 + 128 * bj + 16 * n) = yv[m][bj][n] + perm4(src4, acc[ai][bj][m][n]);
        }
    }
};

DI void p0_transpose_item(const float* W, int K, int N, bf16_t* WT, int src_n0, int dst_n0, int k0, LAS float* scr, int lane) {
#pragma unroll 8
    for (int i = 0; i < 32; ++i) { const int kk = 2 * i + (lane >> 5); scr[kk * 33 + (lane & 31)] = W[(size_t)(k0 + kk) * N + src_n0 + (lane & 31)]; }
    asm volatile("s_waitcnt lgkmcnt(0)" ::: "memory");
    const int c = lane & 7;
#pragma unroll
    for (int j = 0; j < 4; ++j) { const int n = (lane >> 3) + 8 * j; const LAS float* s = scr + (8 * c) * 33 + n;
        u32x4 o; o.x = pk2(s[0 * 33], s[1 * 33]); o.y = pk2(s[2 * 33], s[3 * 33]); o.z = pk2(s[4 * 33], s[5 * 33]); o.w = pk2(s[6 * 33], s[7 * 33]);
        *(u32x4*)(WT + (size_t)(dst_n0 + n) * K + k0 + 8 * c) = o; }
    asm volatile("s_waitcnt lgkmcnt(0)" ::: "memory");
}

DI void p0_rest(const Params& p, LAS unsigned char* lds, int wid, int lane, int worker, int nworkers) {
    LAS float* scr = (LAS float*)(lds + wid * 8704);
    const int gw = worker * 8 + wid, NGW = nworkers * 8;
    bf16_t* WoutT = (bf16_t*)(p.ws + WS_WOUT); bf16_t* WguT = (bf16_t*)(p.ws + WS_WGU); bf16_t* WdnT = (bf16_t*)(p.ws + WS_WDN);
    constexpr int I_OUT = (DM / 64) * (DM / 32), I_GU = (DM / 64) * (NGU / 32), I_DN = (DFF / 64) * (DM / 32);
    for (int it = gw; it < I_OUT + I_GU + I_DN; it += NGW) {
        int r = it;
        if (r < I_OUT) { const int nblk = DM / 32, kb = r / nblk, nb = r % nblk; p0_transpose_item(p.w_out, DM, DM, WoutT, 32 * nb, 32 * nb, 64 * kb, scr, lane); continue; } r -= I_OUT;
        if (r < I_GU) { const int nblk = NGU / 32, kb = r / nblk, nb = r % nblk; p0_transpose_item(p.w_gu, DM, NGU, WguT, src_col_gu(32 * nb), 32 * nb, 64 * kb, scr, lane); continue; } r -= I_GU;
        { const int nblk = DM / 32, kb = r / nblk, nb = r % nblk; p0_transpose_item(p.w_dn, DFF, DM, WdnT, 32 * nb, 32 * nb, 64 * kb, scr, lane); }
    }
}

DI void p0_prologue(const Params& p, LAS unsigned char* lds, int wid, int lane) {
    LAS float* scr = (LAS float*)(lds + wid * 8704);
    const int gw = blockIdx.x * 8 + wid, NGW = gridDim.x * 8;
    bf16_t* WinT = (bf16_t*)(p.ws + WS_WIN);
    constexpr int I_IN = (DM / 64) * (DIN / 32);
    for (int it = gw; it < I_IN; it += NGW) { const int nblk = DIN / 32, kb = it / nblk, nb = it % nblk; p0_transpose_item(p.w_in, DM, DIN, WinT, src_col_in(32 * nb), 32 * nb, 64 * kb, scr, lane); }
    bf16_t* XN = (bf16_t*)(p.ws + WS_XN);
    for (int m = gw; m < MT; m += NGW) {
        const float* xrow = m < TP ? p.xp + (size_t)m * DM : p.xs + (size_t)(m - TP) * DM;
        const f32x4* xr = (const f32x4*)xrow + lane; f32x4 v[8]; float s = 0.f;
#pragma unroll
        for (int j = 0; j < 8; ++j) { v[j] = xr[64 * j]; s += (v[j][0] * v[j][0] + v[j][1] * v[j][1]) + (v[j][2] * v[j][2] + v[j][3] * v[j][3]); }
        const float rstd = 1.0f / sqrtf(wave_sum(s) * (1.0f / DM) + EPS);
        u32x2* o8 = (u32x2*)(XN + (size_t)m * DM) + lane;
#pragma unroll
        for (int j = 0; j < 8; ++j) { const f32x4 gv = ((const f32x4*)p.norm_mix)[64 * j + lane]; o8[64 * j] = pk4(v[j] * rstd * gv); }
    }
    float* cosT = (float*)(p.ws + WS_COS); float* sinT = (float*)(p.ws + WS_SIN);
    const int gt = blockIdx.x * 512 + threadIdx.x, GT = gridDim.x * 512;
    for (int idx = gt; idx < NPOS * 32; idx += GT) {
        const int pos = idx >> 5, i = idx & 31;
        const float inv = __builtin_amdgcn_exp2f(-(float)i * (13.287712379549449f / 32.0f));
        const float ang = (float)pos * inv;
        const double rev = (double)ang * 0.15915494309189535; const float fr = (float)(rev - __builtin_floor(rev));
        cosT[idx] = __builtin_amdgcn_cosf(fr); sinT[idx] = __builtin_amdgcn_sinf(fr);
    }
}

DI void cache_copy(const Params& p, int worker, int nworkers) {
    const int gt = worker * 512 + threadIdx.x, GT = nworkers * 512;
    for (int idx = gt; idx < 128 * 7936; idx += GT) {
        const int b = idx / 7936, e = idx - b * 7936;
        ((f32x4*)(p.out + O_SK + (size_t)b * 32768))[e] = ((const f32x4*)(p.ck + (size_t)b * 32768 + 1024))[e];
        ((f32x4*)(p.out + O_SV + (size_t)b * 32768))[e] = ((const f32x4*)(p.cv + (size_t)b * 32768 + 1024))[e];
    }
}

#define MFMA32(a, b, c) __builtin_amdgcn_mfma_f32_32x32x16_bf16((a), (b), (c), 0, 0, 0)
DI int crow(int reg, int h) { return (reg & 3) + 8 * (reg >> 2) + 4 * h; }
DI bf16x8 pack8(const f32x16& x, int s) {
    u32x4 p; p.x = pk2(x[8 * s], x[8 * s + 1]); p.y = pk2(x[8 * s + 2], x[8 * s + 3]); p.z = pk2(x[8 * s + 4], x[8 * s + 5]); p.w = pk2(x[8 * s + 6], x[8 * s + 7]);
    return __builtin_bit_cast(bf16x8, p);
}
DI bf16x8 cvt8(f32x4 a, f32x4 b) { u32x4 p; p.x = pk2(a[0], a[1]); p.y = pk2(a[2], a[3]); p.z = pk2(b[0], b[1]); p.w = pk2(b[2], b[3]); return __builtin_bit_cast(bf16x8, p); }

constexpr int KS_STRIDE = 72, VT_STRIDE = 260, VT_OFF = 256 * KS_STRIDE * 2;

template <bool SAMPLE>
DI void attn_chunk(const Params& p, LAS unsigned char* lds, int qb, int c, int kvh, int head_w, int b_s, int lane) {
    const bf16_t* Q = (const bf16_t*)(p.ws + WS_Q); const bf16_t* Kb = (const bf16_t*)(p.ws + WS_K); const bf16_t* Vb = (const bf16_t*)(p.ws + WS_V);
    const bf16_t* U = (const bf16_t*)(p.ws + WS_U); const bf16_t* BG = (const bf16_t*)(p.ws + WS_BG); const bf16_t* SGA = (const bf16_t*)(p.ws + WS_SGA);
    bf16_t* MIX = (bf16_t*)(p.ws + WS_MIX);
    const int r = lane & 31, g = lane >> 5;
    int tok, head, itok = 0;
    if (SAMPLE) { itok = r >> 3; head = kvh * 8 + (r & 7); tok = TP + 4 * b_s + itok; }
    else { head = head_w; tok = 128 * qb + 32 * c + r; }
    const LAS bf16_t* Ks = (const LAS bf16_t*)lds; const LAS bf16_t* Vt = (const LAS bf16_t*)(lds + VT_OFF);
    bf16x8 qf[4];
#pragma unroll
    for (int ks = 0; ks < 4; ++ks) qf[ks] = *(const bf16x8*)(Q + (size_t)tok * DM + head * 64 + 16 * ks + 8 * g);
    f32x16 s[5];
#pragma unroll
    for (int kbr = 0; kbr < 5; ++kbr) {
#pragma unroll
        for (int i = 0; i < 16; ++i) s[kbr][i] = 0.f;
#pragma unroll
        for (int ks = 0; ks < 4; ++ks) {
            bf16x8 a;
            if (SAMPLE) {
                if (kbr < 4) { const float* kp = p.ck + ((size_t)(b_s * 128 + 32 * kbr + r) * 4 + kvh) * 64 + 16 * ks + 8 * g; a = cvt8(*(const f32x4*)kp, *(const f32x4*)(kp + 4)); }
                else { u32x4 z = (u32x4){0u, 0u, 0u, 0u}; if (r < 4) z = *(const u32x4*)(Kb + (size_t)(TP + 4 * b_s + r) * 256 + kvh * 64 + 16 * ks + 8 * g); a = __builtin_bit_cast(bf16x8, z); }
            } else a = *(const LAS bf16x8*)(Ks + (32 * (c + kbr) + r) * KS_STRIDE + 16 * ks + 8 * g);
            s[kbr] = MFMA32(a, qf[ks], s[kbr]);
        }
    }
    const float sc = 0.125f * 1.44269504089f;
    const float sink2 = p.sinks[head] * 1.44269504089f;
    float mraw = -1e30f;
#pragma unroll
    for (int kbr = 0; kbr < 5; ++kbr)
#pragma unroll
        for (int i = 0; i < 16; ++i) {
            const int kr = crow(i, g); bool valid;
            if (SAMPLE) valid = kbr < 4 ? (32 * kbr + kr > itok) : (kr <= itok);
            else { valid = kbr == 0 ? (kr > r) : (kbr == 4 ? (kr <= r) : true); if (qb == 0 && c + kbr < 4) valid = false; }
            const float t = valid ? s[kbr][i] : -1e30f; s[kbr][i] = t; mraw = fmaxf(mraw, t);
        }
    mraw = fmaxf(mraw, __shfl_xor(mraw, 32));
    const float mx = fmaxf(mraw * sc, sink2);
    float sum = 0.f;
#pragma unroll
    for (int kbr = 0; kbr < 5; ++kbr)
#pragma unroll
        for (int i = 0; i < 16; ++i) { const float e = __builtin_amdgcn_exp2f(__builtin_fmaf(s[kbr][i], sc, -mx)); s[kbr][i] = e; sum += e; }
    sum += __shfl_xor(sum, 32);
    const float inv = 1.0f / (sum + __builtin_amdgcn_exp2f(sink2 - mx));
    f32x16 o[2];
#pragma unroll
    for (int dt = 0; dt < 2; ++dt)
#pragma unroll
        for (int i = 0; i < 16; ++i) o[dt][i] = 0.f;
#pragma unroll
    for (int kbr = 0; kbr < 5; ++kbr)
#pragma unroll
        for (int kk = 0; kk < 2; ++kk) {
            const bf16x8 pb = pack8(s[kbr], kk);
#pragma unroll
            for (int dt = 0; dt < 2; ++dt) {
                bf16x8 a; const int d = 32 * dt + r;
                if (SAMPLE) {
                    if (kbr < 4) { float f[8];
#pragma unroll
                        for (int j = 0; j < 8; ++j) { const int key = 32 * kbr + 16 * kk + 8 * (j >> 2) + 4 * g + (j & 3); f[j] = p.cv[((size_t)(b_s * 128 + key) * 4 + kvh) * 64 + d]; }
                        a = cvt8((f32x4){f[0], f[1], f[2], f[3]}, (f32x4){f[4], f[5], f[6], f[7]});
                    } else { u32x4 z = (u32x4){0u, 0u, 0u, 0u};
                        if (kk == 0 && g == 0) { const bf16_t* vp = Vb + (size_t)(TP + 4 * b_s) * 256 + kvh * 64 + d; z.x = (unsigned)vp[0] | ((unsigned)vp[256] << 16); z.y = (unsigned)vp[512] | ((unsigned)vp[768] << 16); }
                        a = __builtin_bit_cast(bf16x8, z); }
                } else {
                    const LAS bf16_t* vp = Vt + d * VT_STRIDE + 32 * (c + kbr) + 16 * kk + 4 * g;
                    const s16x4 lo = *(const LAS s16x4*)vp, hi = *(const LAS s16x4*)(vp + 8);
                    a = __builtin_shufflevector(lo, hi, 0, 1, 2, 3, 4, 5, 6, 7);
                }
                o[dt] = MFMA32(a, pb, o[dt]);
            }
        }
    if (!SAMPLE) {
#pragma unroll
        for (int dt = 0; dt < 2; ++dt)
#pragma unroll
            for (int i4 = 0; i4 < 4; ++i4) {
                const int col = head * 64 + 32 * dt + 8 * i4 + 4 * g;
                const f32x4 at = (f32x4){o[dt][4 * i4], o[dt][4 * i4 + 1], o[dt][4 * i4 + 2], o[dt][4 * i4 + 3]} * inv;
                *(u32x2*)(MIX + (size_t)tok * DM + col) = pk4(at);
            }
        return;
    }
#pragma unroll
    for (int dt = 0; dt < 2; ++dt) {
        u32x2 lsga[4], lbg[4], lu0[4]; f32x4 lu1[4], lu2[4], w0[4], w1[4], w2[4];
#pragma unroll
        for (int i4 = 0; i4 < 4; ++i4) {
            const int col = head * 64 + 32 * dt + 8 * i4 + 4 * g; const size_t off = (size_t)tok * DM + col;
            lsga[i4] = *(const u32x2*)(SGA + off); lbg[i4] = *(const u32x2*)(BG + off); lu0[i4] = *(const u32x2*)(U + off);
            lu1[i4] = itok >= 1 ? unpk4(*(const u32x2*)(U + off - DM)) : *(const f32x4*)(p.sconv + (size_t)b_s * 4096 + DM + col);
            lu2[i4] = itok >= 2 ? unpk4(*(const u32x2*)(U + off - 2 * DM)) : *(const f32x4*)(p.sconv + (size_t)b_s * 4096 + (size_t)itok * DM + col);
            w0[i4] = *(const f32x4*)(p.conv_w + col); w1[i4] = *(const f32x4*)(p.conv_w + DM + col); w2[i4] = *(const f32x4*)(p.conv_w + 2 * DM + col);
        }
#pragma unroll
        for (int i4 = 0; i4 < 4; ++i4) {
            const int col = head * 64 + 32 * dt + 8 * i4 + 4 * g; const size_t off = (size_t)tok * DM + col;
            const f32x4 at = (f32x4){o[dt][4 * i4], o[dt][4 * i4 + 1], o[dt][4 * i4 + 2], o[dt][4 * i4 + 3]} * inv;
            const f32x4 conv = w0[i4] * lu2[i4] + w1[i4] * lu1[i4] + w2[i4] * unpk4(lu0[i4]);
            *(u32x2*)(MIX + off) = pk4(unpk4(lsga[i4]) * at + unpk4(lbg[i4]) * conv);
        }
    }
}

DI void unpk8(u32x4 w, f32x4& lo, f32x4& hi) { lo = (f32x4){bf_lo(w.x), bf_hi(w.x), bf_lo(w.y), bf_hi(w.y)}; hi = (f32x4){bf_lo(w.z), bf_hi(w.z), bf_lo(w.w), bf_hi(w.w)}; }

constexpr int P2_CNT_OFF = 120000;
DI void p2_attention(const Params& p, LAS unsigned char* lds, int tid, int wid, int lane) {
    const bf16_t* Kb = (const bf16_t*)(p.ws + WS_K); const bf16_t* Vb = (const bf16_t*)(p.ws + WS_V);
    const bf16_t* U = (const bf16_t*)(p.ws + WS_U); const bf16_t* BG = (const bf16_t*)(p.ws + WS_BG); const bf16_t* SGA = (const bf16_t*)(p.ws + WS_SGA);
    bf16_t* MIX = (bf16_t*)(p.ws + WS_MIX);
    LAS bf16_t* Ks = (LAS bf16_t*)lds; LAS bf16_t* Vt = (LAS bf16_t*)(lds + VT_OFF);
    LAS unsigned* cnt = (LAS unsigned*)(lds + P2_CNT_OFF);
    int samp_next = blockIdx.x * 2;
    for (int item = blockIdx.x; item < 256; item += gridDim.x) {
        const int qb = item >> 2, kvh = item & 3;
        __syncthreads();
#pragma unroll
        for (int i = 0; i < 4; ++i) {
            const int e = tid + 512 * i, row = e >> 3, c8 = e & 7, tok = 128 * (qb - 1) + row;
            u32x4 kv = (u32x4){0u, 0u, 0u, 0u}, vv = (u32x4){0u, 0u, 0u, 0u};
            if (tok >= 0) { kv = *(const u32x4*)(Kb + (size_t)tok * 256 + kvh * 64 + 8 * c8); vv = *(const u32x4*)(Vb + (size_t)tok * 256 + kvh * 64 + 8 * c8); }
            *(LAS u32x4*)(Ks + row * KS_STRIDE + 8 * c8) = kv;
#pragma unroll
            for (int jj = 0; jj < 8; ++jj) Vt[(8 * c8 + jj) * VT_STRIDE + row] = (bf16_t)(vv[jj >> 1] >> (16 * (jj & 1)));
        }
        if (tid == 0) *cnt = 0u;
        __syncthreads();
        const int ns = (samp_next < 512) ? ((samp_next + 1 < 512) ? 2 : 1) : 0;
        for (;;) {
            unsigned t = 0; if (lane == 0) t = __hip_atomic_fetch_add(cnt, 1u, __ATOMIC_RELAXED, __HIP_MEMORY_SCOPE_WORKGROUP);
            t = __builtin_amdgcn_readfirstlane(t);
            if ((int)t >= ns + 32) break;
            if ((int)t < ns) { const int it = samp_next + (int)t; attn_chunk<true>(p, lds, 0, 0, it & 3, 0, it >> 2, lane); }
            else { const int pc = (int)t - ns; attn_chunk<false>(p, lds, qb, pc & 3, kvh, kvh * 8 + (pc >> 2), 0, lane); }
        }
        samp_next += gridDim.x * 2;
        asm volatile("s_waitcnt vmcnt(0)" ::: "memory");
        __syncthreads();
        __builtin_amdgcn_fence(__ATOMIC_ACQUIRE, "agent");
        {
            const int c8 = tid & 63, rbase = tid >> 6, col = kvh * 512 + 8 * c8;
            f32x4 w[3][2];
#pragma unroll
            for (int k = 0; k < 3; ++k) { w[k][0] = *(const f32x4*)(p.conv_w + k * DM + col); w[k][1] = *(const f32x4*)(p.conv_w + k * DM + col + 4); }
#pragma unroll
            for (int ib = 0; ib < 4; ++ib) {
                u32x4 la[4], ls[4], lb[4], l0[4], l1[4], l2[4];
#pragma unroll
                for (int ii = 0; ii < 4; ++ii) {
                    const int tok = 128 * qb + rbase + 8 * (4 * ib + ii); const size_t off = (size_t)tok * DM + col;
                    la[ii] = *(const u32x4*)(MIX + off); ls[ii] = *(const u32x4*)(SGA + off); lb[ii] = *(const u32x4*)(BG + off); l0[ii] = *(const u32x4*)(U + off);
                    l1[ii] = (u32x4){0u, 0u, 0u, 0u}; l2[ii] = (u32x4){0u, 0u, 0u, 0u};
                    if (tok >= 1) l1[ii] = *(const u32x4*)(U + off - DM);
                    if (tok >= 2) l2[ii] = *(const u32x4*)(U + off - 2 * DM);
                }
#pragma unroll
                for (int ii = 0; ii < 4; ++ii) {
                    const int tok = 128 * qb + rbase + 8 * (4 * ib + ii); const size_t off = (size_t)tok * DM + col;
                    f32x4 a0, a1, s0, s1, b0, b1, x0, x1, y0, y1, z0, z1;
                    unpk8(la[ii], a0, a1); unpk8(ls[ii], s0, s1); unpk8(lb[ii], b0, b1); unpk8(l0[ii], x0, x1); unpk8(l1[ii], y0, y1); unpk8(l2[ii], z0, z1);
                    const f32x4 m0 = s0 * a0 + b0 * (w[0][0] * z0 + w[1][0] * y0 + w[2][0] * x0);
                    const f32x4 m1 = s1 * a1 + b1 * (w[0][1] * z1 + w[1][1] * y1 + w[2][1] * x1);
                    u32x4 o; o.x = pk2(m0[0], m0[1]); o.y = pk2(m0[2], m0[3]); o.z = pk2(m1[0], m1[1]); o.w = pk2(m1[2], m1[3]);
                    *(u32x4*)(MIX + off) = o;
                }
            }
        }
    }
    for (int it = samp_next + (wid & 1); it < 512 && wid < 2; it += gridDim.x * 2) attn_chunk<true>(p, lds, 0, 0, it & 3, 0, it >> 2, lane);
}

constexpr int LDS_BYTES = pg8::STAGE_BYTES + 16;

__global__ void __launch_bounds__(512, 2) fwd_megakernel(Params p) {
    extern __shared__ __attribute__((aligned(16))) unsigned char lds_raw[];
    LAS unsigned char* lds = (LAS unsigned char*)lds_raw;
    cg::grid_group grid = cg::this_grid();
    if (p.never) grid.sync();
    if (threadIdx.x < 4) ((LAS unsigned*)(lds + pg8::STAGE_BYTES))[threadIdx.x] = 0u;
    __syncthreads();
    const XcdBarrier xb = xcd_barrier_post((unsigned*)(p.ws + WS_BAR), (volatile LAS unsigned*)(lds + pg8::STAGE_BYTES));
    const int tid = threadIdx.x, wid = __builtin_amdgcn_readfirstlane(tid >> 6), lane = tid & 63;
    const int G = gridDim.x, bid = blockIdx.x;
    unsigned char* ws = p.ws;

    for (int rep = 0; rep < REP_P0; ++rep) p0_prologue(p, lds, wid, lane);
    for (int rep = 0; rep < REP_SYNC; ++rep) xcd_barrier(xb);
    xcd_barrier(xb);
    {
        pg8::Gemm g{(const bf16_t*)(ws + WS_XN), (const bf16_t*)(ws + WS_WIN), MT, DIN, DM}; pg8::StaticOrder S; S.init(MT, DIN, G, bid);
        Epi1 E{(bf16_t*)(ws + WS_Q), (bf16_t*)(ws + WS_K), (bf16_t*)(ws + WS_V), (bf16_t*)(ws + WS_U), (bf16_t*)(ws + WS_BG), (bf16_t*)(ws + WS_SGA),
               p.q_norm, p.k_norm, (const float*)(ws + WS_COS), (const float*)(ws + WS_SIN), p.out};
        for (int rep = 0; rep < REP_P1; ++rep) pg8::gemm_phase<Epi1>(lds, g, S, E);
        {
            const int nfull = ((MT / 256) * (DIN / 256)) % G;
            if (nfull == 0) p0_rest(p, lds, wid, lane, bid, G);
            else if (bid >= nfull) p0_rest(p, lds, wid, lane, bid - nfull, G - nfull);
        }
    }
    xcd_barrier(xb);
    for (int rep = 0; rep < REP_P2; ++rep) p2_attention(p, lds, tid, wid, lane);
    xcd_barrier(xb);
    {
        pg8::Gemm g{(const bf16_t*)(ws + WS_MIX), (const bf16_t*)(ws + WS_WOUT), MT, DM, DM}; pg8::StaticOrder S; S.init(MT, DM, G, bid);
        Epi3 E{p.xp, p.xs, p.norm_ffn, p.out, (bf16_t*)(ws + WS_A2), (float*)(ws + WS_SSQ)};
        for (int rep = 0; rep < REP_P3; ++rep) pg8::gemm_phase<Epi3>(lds, g, S, E);
        {   const int nfull = ((MT / 256) * (DM / 256)) % G;
            if (nfull == 0) cache_copy(p, bid, G); else if (bid >= nfull) cache_copy(p, bid - nfull, G - nfull);
        }
    }
    xcd_barrier(xb);
    {
        pg8::Gemm g{(const bf16_t*)(ws + WS_A2), (const bf16_t*)(ws + WS_WGU), MT, NGU, DM}; pg8::StaticOrder S; S.init(MT, NGU, G, bid);
        Epi4 E{(const float*)(ws + WS_SSQ), (bf16_t*)(ws + WS_HID)};
        for (int rep = 0; rep < REP_P4; ++rep) pg8::gemm_phase<Epi4>(lds, g, S, E);
    }
    xcd_barrier(xb);
    {
        pg8::Gemm g{(const bf16_t*)(ws + WS_HID), (const bf16_t*)(ws + WS_WDN), MT, DM, DFF}; pg8::StaticOrder S; S.init(MT, DM, G, bid);
        Epi5 E{p.out};
        pg8::gemm_phase<Epi5>(lds, g, S, E);
    }
}

extern "C" void kernel_launch(void* const* d_in, const int* in_sizes, int n_in, void* d_out, int out_size, void* d_ws, size_t ws_size, hipStream_t stream) {
    static int grid = 0;
    if (!grid) {
        int dev = 0, cus = 0, per_cu = 0;
        (void)hipGetDevice(&dev);
        (void)hipDeviceGetAttribute(&cus, hipDeviceAttributeMultiprocessorCount, dev);
        (void)hipFuncSetAttribute((const void*)fwd_megakernel, hipFuncAttributeMaxDynamicSharedMemorySize, LDS_BYTES);
        (void)hipOccupancyMaxActiveBlocksPerMultiprocessor(&per_cu, (const void*)fwd_megakernel, 512, LDS_BYTES);
        if (per_cu < 1) per_cu = 1;
        grid = cus * per_cu;
        if (ws_size < WS_END) fprintf(stderr, "kernel_launch: workspace too small (%zu < %zu)\n", ws_size, (size_t)WS_END);
    }
    Params p{};
    p.xp = (const float*)d_in[0]; p.xs = (const float*)d_in[1]; p.ck = (const float*)d_in[2]; p.cv = (const float*)d_in[3]; p.sconv = (const float*)d_in[4];
    p.norm_mix = (const float*)d_in[5]; p.w_in = (const float*)d_in[6]; p.q_norm = (const float*)d_in[7]; p.k_norm = (const float*)d_in[8]; p.sinks = (const float*)d_in[9];
    p.conv_w = (const float*)d_in[10]; p.w_out = (const float*)d_in[11]; p.norm_ffn = (const float*)d_in[12]; p.w_gu = (const float*)d_in[13]; p.w_dn = (const float*)d_in[14];
    p.out = (float*)d_out; p.ws = (unsigned char*)d_ws;
    p.never = 0;
    (void)hipMemsetAsync((char*)d_ws + WS_BAR, 0, 16384, stream);
    void* args[] = {&p};
    hipError_t e = hipLaunchCooperativeKernel((const void*)fwd_megakernel, dim3(grid), dim3(512), args, LDS_BYTES, stream);
    if (e != hipSuccess) fprintf(stderr, "cooperative launch failed: %s (grid %d)\n", hipGetErrorString(e), grid);
}
```

```cpp
#include <hip/hip_runtime.h>
#include <hip/hip_cooperative_groups.h>
#include <cstdio>
namespace cg = cooperative_groups;
#define REP_P0 1
#define REP_P1 1
#define REP_P2 1
#define REP_P3 1
#define REP_P4 1
#define REP_SYNC 0

#define LAS __attribute__((address_space(3)))
#define DI __device__ __forceinline__
typedef unsigned short bf16_t;
typedef short bf16x8 __attribute__((ext_vector_type(8)));
typedef short s16x4 __attribute__((ext_vector_type(4)));
typedef float f32x4 __attribute__((ext_vector_type(4)));
typedef float f32x16 __attribute__((ext_vector_type(16)));
typedef unsigned u32x4 __attribute__((ext_vector_type(4)));
typedef unsigned u32x2 __attribute__((ext_vector_type(2)));

constexpr int DM = 2048, TP = 8192, TS = 512, MT = TP + TS, DIN = 12800, DFF = 5632, NGU = 2 * DFF;
constexpr float EPS = 1e-6f;
constexpr int NPOS = 8196;
constexpr size_t O_YP = 0, O_YS = (size_t)TP * DM, O_PK = O_YS + (size_t)TS * DM, O_PV = O_PK + 32768, O_PC = O_PV + 32768,
                 O_SK = O_PC + 4096, O_SV = O_SK + 4194304, O_SC = O_SV + 4194304;
constexpr size_t WS_WIN = 0, WS_WOUT = WS_WIN + (size_t)DIN * DM * 2, WS_WGU = WS_WOUT + (size_t)DM * DM * 2, WS_WDN = WS_WGU + (size_t)NGU * DM * 2,
                 WS_XN = WS_WDN + (size_t)DM * DFF * 2, WS_Q = WS_XN + (size_t)MT * DM * 2, WS_K = WS_Q + (size_t)MT * DM * 2, WS_V = WS_K + (size_t)MT * 256 * 2,
                 WS_U = WS_V + (size_t)MT * 256 * 2, WS_BG = WS_U + (size_t)MT * DM * 2, WS_SGA = WS_BG + (size_t)MT * DM * 2, WS_COS = WS_SGA + (size_t)MT * DM * 2,
                 WS_SIN = WS_COS + (size_t)NPOS * 32 * 4, WS_SSQ = WS_SIN + (size_t)NPOS * 32 * 4, WS_BAR = WS_SSQ + (size_t)MT * 32 * 4, WS_PB = WS_BAR + 16384, WS_END = WS_PB + (size_t)4 * TS * DM * 4;
constexpr size_t WS_MIX = WS_XN, WS_A2 = WS_Q, WS_HID = WS_U;
static_assert((size_t)MT * DFF * 2 <= 3 * (size_t)MT * DM * 2, "hidden fits in U|BG|SGA");

struct Params {
    const float *xp, *xs, *ck, *cv, *sconv, *norm_mix, *w_in, *q_norm, *k_norm, *sinks, *conv_w, *w_out, *norm_ffn, *w_gu, *w_dn;
    float* out; unsigned char* ws; long never;
};

typedef float f32x2 __attribute__((ext_vector_type(2)));
typedef __bf16 bf16x2v __attribute__((ext_vector_type(2)));
DI unsigned pk2(float lo, float hi) { const f32x2 f = {lo, hi}; return __builtin_bit_cast(unsigned, __builtin_convertvector(f, bf16x2v)); }
DI u32x2 pk4(f32x4 v) { u32x2 r; r.x = pk2(v[0], v[1]); r.y = pk2(v[2], v[3]); return r; }
DI float bf_lo(unsigned w) { return __uint_as_float(w << 16); }
DI float bf_hi(unsigned w) { return __uint_as_float(w & 0xffff0000u); }
DI f32x4 unpk4(u32x2 w) { return (f32x4){bf_lo(w.x), bf_hi(w.x), bf_lo(w.y), bf_hi(w.y)}; }
DI float sigmoidf_(float x) { return __builtin_amdgcn_rcpf(1.0f + __builtin_amdgcn_exp2f(-1.44269504089f * x)); }
DI float wave_sum(float v) {
#pragma unroll
    for (int o = 1; o < 64; o <<= 1) v += __shfl_xor(v, o);
    return v;
}


#define XB_TMO      128
#define XB_XCNT(j)  (256  + 64 * (j))
#define XB_XSUB(j)  (1280 + 64 * (j))
#define XB_XGEN(j)  (2304 + 64 * (j))
#define XB_TOP      3328
#define XB_TOPGEN   3392
#define XCD_BAR_WORDS 3456
#define XB_SPIN_CAP (1u << 20)
DI unsigned xb_ld(unsigned* p)              { return __hip_atomic_load(p, __ATOMIC_RELAXED, __HIP_MEMORY_SCOPE_AGENT); }
DI unsigned xb_add(unsigned* p, unsigned v) { return __hip_atomic_fetch_add(p, v, __ATOMIC_RELAXED, __HIP_MEMORY_SCOPE_AGENT); }
DI unsigned xb_xcc_id() { return (unsigned)__builtin_amdgcn_s_getreg((3 << 11) | 20) & 0xFu; }
#define XB_SPIN(cond, bar) do { unsigned _sp = 0; while (cond) { __builtin_amdgcn_s_sleep(1); \
    if ((++_sp & 255u) == 0u) { if (xb_ld(&(bar)[XB_TMO])) break; if (_sp > XB_SPIN_CAP) { atomicAdd(&(bar)[XB_TMO], 1u); break; } } } } while (0)
struct XcdBarrier { unsigned* bar; unsigned x; volatile LAS unsigned* st; };
DI XcdBarrier xcd_barrier_post(unsigned* bar, volatile LAS unsigned* st) {
    XcdBarrier b; b.bar = bar; b.x = xb_xcc_id(); b.st = st;
    if (threadIdx.x == 0) (void)xb_add(&bar[XB_XCNT(b.x)], 1u);
    return b;
}
DI void xcd_barrier_complete(unsigned* bar, unsigned x, unsigned& nloc, unsigned& nx) {
    const unsigned G = gridDim.x * gridDim.y * gridDim.z;
    unsigned sum, cnt, mine, sp = 0u;
    for (;;) {
        sum = 0u; cnt = 0u; mine = 0u;
#pragma unroll
        for (unsigned j = 0; j < 16; ++j) { const unsigned c = xb_ld(&bar[XB_XCNT(j)]); sum += c; cnt += (c > 0u) ? 1u : 0u; mine = (j == x) ? c : mine; }
        if (sum == G) break;
        __builtin_amdgcn_s_sleep(1);
        if ((++sp & 255u) == 0u) { if (xb_ld(&bar[XB_TMO])) break; if (sp > XB_SPIN_CAP) { atomicAdd(&bar[XB_TMO], 1u); break; } }
    }
    nloc = mine > 0u ? mine : 1u; nx = cnt > 0u ? cnt : 1u;
}
DI void xcd_barrier(const XcdBarrier& b) {
    asm volatile("s_waitcnt vmcnt(0)" ::: "memory");
    __syncthreads();
    if (threadIdx.x == 0) {
        unsigned* bar = b.bar;
        __builtin_amdgcn_s_waitcnt(0);
        unsigned nloc = b.st[0], nx = b.st[1];
        if (nloc == 0u) { xcd_barrier_complete(bar, b.x, nloc, nx); b.st[0] = nloc; b.st[1] = nx; }
        const unsigned old = xb_add(&bar[XB_XSUB(b.x)], 1u);
        const unsigned gen = old / nloc;
        if (old + 1u == (gen + 1u) * nloc) {
            __builtin_amdgcn_fence(__ATOMIC_RELEASE, "agent");
            asm volatile("s_waitcnt vmcnt(0)" ::: "memory");
            const unsigned og = xb_add(&bar[XB_TOP], 1u);
            const unsigned tg = og / nx;
            if (og + 1u == (tg + 1u) * nx) xb_add(&bar[XB_TOPGEN], 1u);
            else XB_SPIN(xb_ld(&bar[XB_TOPGEN]) == tg, bar);
            __builtin_amdgcn_fence(__ATOMIC_ACQUIRE, "agent");
            xb_add(&bar[XB_XGEN(b.x)], 1u);
            asm volatile("s_waitcnt vmcnt(0)" ::: "memory");
        } else {
            XB_SPIN(xb_ld(&bar[XB_XGEN(b.x)]) == gen, bar);
            __builtin_amdgcn_fence(__ATOMIC_ACQUIRE, "agent");
            asm volatile("s_waitcnt vmcnt(0)" ::: "memory");
        }
    }
    __syncthreads();
}

namespace pg8 {
constexpr int BM = 256, BK = 64, HALF = 128, HTB = HALF * BK * 2, STAGE_BYTES = 8 * HTB, NXCD = 8, WGM = 8;
DI int lds_byte(int r, int c) { const int st = (r >> 4) * 2 + (c >> 5), rr = r & 15, cc = c & 31, ob = rr * 64 + cc * 2; return st * 1024 + (ob ^ (((ob >> 9) & 1) << 5)); }
DI void stage_rc(int b, int& R, int& C) { const int st = b / 1024, sb = b % 1024, swz = sb ^ (((sb >> 9) & 1) << 5); R = (st >> 1) * 16 + swz / 64; C = (st & 1) * 32 + (swz % 64) / 2; }
struct Unit { int pm, pn, k0, nt, split; };
struct Gemm { const bf16_t* A; const bf16_t* Bt; int M, N, K; };
struct StaticOrder {
    int nM, nN, nwg, G, c, ntk;
    DI void init(int M, int N, int G_, int c_, int ntk_ = 32) { nM = M / BM; nN = N / BM; nwg = nM * nN; G = G_; c = c_; ntk = ntk_; }
    DI void map(int L, Unit& u) const {
        int wgid = L; { const int q = nwg / NXCD, r = nwg % NXCD, xcd = wgid % NXCD, off = wgid / NXCD; wgid = (xcd < r ? xcd * (q + 1) : r * (q + 1) + (xcd - r) * q) + off; }
        const int nig = WGM * nN, gid = wgid / nig, fm = gid * WGM, gsz = (nM - fm) < WGM ? (nM - fm) : WGM;
        u.pm = fm + ((wgid % nig) % gsz); u.pn = (wgid % nig) / gsz; u.k0 = 0; u.nt = ntk; u.split = -1;
    }
    DI bool next(int i, Unit& u) const { const long L = (long)i * G + c; if (L >= nwg) return false; map((int)L, u); return true; }
};
struct SplitOrder {
    StaticOrder base;
    DI void init(int N, int G_, int c_, int ntk_) { base.init(TP, N, G_, c_, ntk_); }
    DI int total() const { return base.nwg + 16 * 4; }
    DI bool next(int i, Unit& u) const {
        const int L = i * base.G + base.c;
        if (L >= base.nwg + 64) return false;
        const bool sp = L >= base.nwg;
        Unit a; base.map(sp ? 0 : L, a);
        const int j = L - base.nwg, tile = j >> 2, s4 = j & 3, q = base.ntk >> 2;
        u.pm = sp ? (TP / BM + (tile >> 3)) : a.pm; u.pn = sp ? (tile & 7) : a.pn; u.nt = sp ? q : a.nt; u.k0 = sp ? s4 * q : 0; u.split = sp ? s4 : -1;
        return true;
    }
};

template <class Epi, class Sched>
DI void gemm_phase(LAS unsigned char* lds, const Gemm g, const Sched& S, const Epi& E) {
    const int tid = threadIdx.x, wid = __builtin_amdgcn_readfirstlane(tid >> 6), lane = tid & 63, wr = wid >> 2, wc = wid & 3, fr = lane & 15, fq = lane >> 4;
    const int K = g.K;
    unsigned voffA[2];
#pragma unroll
    for (int i = 0; i < 2; ++i) { int R, C; stage_rc(tid * 16 + i * 8192, R, C); voffA[i] = (unsigned)(R * K + C) * 2u; }
    const size_t kstep = (size_t)(BK * 2);
    const size_t hstep = (size_t)HALF * K * 2;
    const size_t tstep = 2 * hstep;
    const unsigned ldsw = (unsigned)wid * 1024u;
    const int aoff = lds_byte(wr * 64 + fr, fq * 8), boff = lds_byte(wc * 32 + fr, fq * 8);
#define PG8_SA(b, h) (((b) * 2 + (h)) * HTB)
#define PG8_SB(b, h) ((4 + (b) * 2 + (h)) * HTB)
#define PG8_STAGE(bufoff, gbase) do { _Pragma("unroll") for (int _i = 0; _i < 2; ++_i) \
        __builtin_amdgcn_global_load_lds((const unsigned*)((const char*)(gbase) + voffA[_i]), (LAS unsigned*)(lds + (bufoff) + ldsw + _i * 8192), 16, 0, 0); } while (0)
#define PG8_LDA(dst, b, h) do { _Pragma("unroll") for (int m = 0; m < 4; ++m) _Pragma("unroll") for (int k = 0; k < 2; ++k) dst[m][k] = *(const LAS bf16x8*)(lds + PG8_SA(b, h) + aoff + m * 2048 + k * 1024); } while (0)
#define PG8_LDB(dst, b, h) do { _Pragma("unroll") for (int n = 0; n < 2; ++n) _Pragma("unroll") for (int k = 0; k < 2; ++k) dst[n][k] = *(const LAS bf16x8*)(lds + PG8_SB(b, h) + boff + n * 2048 + k * 1024); } while (0)
#define PG8_MMA(ai, bj, At, Bt) do { __builtin_amdgcn_s_setprio(1); _Pragma("unroll") for (int m = 0; m < 4; ++m) _Pragma("unroll") for (int n = 0; n < 2; ++n) _Pragma("unroll") for (int k = 0; k < 2; ++k) \
        acc[ai][bj][m][n] = __builtin_amdgcn_mfma_f32_16x16x32_bf16(Bt[n][k], At[m][k], acc[ai][bj][m][n], 0, 0, 0); __builtin_amdgcn_s_setprio(0); } while (0)
#define PG8_WAIT_V(n) asm volatile("s_waitcnt vmcnt(" #n ")" ::: "memory")
#define PG8_WAIT_L(n) asm volatile("s_waitcnt lgkmcnt(" #n ")" ::: "memory")
#define PG8_BAR __builtin_amdgcn_s_barrier()
#define PG8_SCHED __builtin_amdgcn_sched_barrier(0)
    Unit cur, nxt; int ui = 0;
    if (!S.next(0, cur)) return;
    f32x4 acc[2][2][4][2];
#pragma unroll
    for (int a = 0; a < 2; ++a)
#pragma unroll
        for (int b = 0; b < 2; ++b)
#pragma unroll
            for (int m = 0; m < 4; ++m)
#pragma unroll
                for (int n = 0; n < 2; ++n) acc[a][b][m][n] = (f32x4){0.f, 0.f, 0.f, 0.f};
    bf16x8 At[4][2], B0[2][2], B1[2][2];
    const char* cA = (const char*)g.A + (size_t)cur.pm * tstep + (size_t)cur.k0 * kstep; const char* cB = (const char*)g.Bt + (size_t)cur.pn * tstep + (size_t)cur.k0 * kstep;
    PG8_STAGE(PG8_SB(0, 0), cB); PG8_STAGE(PG8_SA(0, 0), cA); PG8_STAGE(PG8_SB(0, 1), cB + hstep); PG8_STAGE(PG8_SA(0, 1), cA + hstep);
    if (wr == 1) PG8_BAR;
    PG8_WAIT_V(4); PG8_BAR;
    PG8_STAGE(PG8_SB(1, 0), cB + kstep); PG8_STAGE(PG8_SA(1, 0), cA + kstep); PG8_STAGE(PG8_SB(1, 1), cB + hstep + kstep);
    PG8_WAIT_V(6); PG8_BAR;
    for (;;) {
        const bool has_next = S.next(ui + 1, nxt);
        const char* nA = has_next ? (const char*)g.A + (size_t)nxt.pm * tstep + (size_t)nxt.k0 * kstep : cA; const char* nB = has_next ? (const char*)g.Bt + (size_t)nxt.pn * tstep + (size_t)nxt.k0 * kstep : cB;
        const int nt = cur.nt;
        for (int t = 0; t < nt; t += 2) {
            const bool last = (t == nt - 2);
            const char* a1 = cA + (size_t)(t + 1) * kstep;
            const char* a2 = last ? nA : cA + (size_t)(t + 2) * kstep; const char* b2 = last ? nB : cB + (size_t)(t + 2) * kstep;
            const char* a3 = a2 + kstep; const char* b3 = b2 + kstep;
            PG8_LDB(B0, 0, 0); PG8_SCHED; PG8_LDA(At, 0, 0); PG8_STAGE(PG8_SA(1, 1), a1 + hstep);
            PG8_WAIT_L(8); PG8_BAR; PG8_WAIT_L(0); PG8_MMA(0, 0, At, B0); PG8_BAR; PG8_SCHED;
            PG8_LDB(B1, 0, 1); PG8_STAGE(PG8_SB(0, 0), b2);
            PG8_BAR; PG8_WAIT_L(0); PG8_MMA(0, 1, At, B1); PG8_BAR;
            PG8_LDA(At, 0, 1); PG8_STAGE(PG8_SA(0, 0), a2);
            PG8_BAR; PG8_WAIT_L(0); PG8_MMA(1, 0, At, B0); PG8_BAR; PG8_SCHED;
            PG8_STAGE(PG8_SB(0, 1), b2 + hstep);
            PG8_WAIT_V(6); PG8_BAR; PG8_MMA(1, 1, At, B1); PG8_BAR;
            PG8_LDB(B0, 1, 0); PG8_SCHED; PG8_LDA(At, 1, 0); PG8_STAGE(PG8_SA(0, 1), a2 + hstep);
            PG8_WAIT_L(8); PG8_BAR; PG8_WAIT_L(0); PG8_MMA(0, 0, At, B0); PG8_BAR; PG8_SCHED;
            PG8_LDB(B1, 1, 1); PG8_STAGE(PG8_SB(1, 0), b3);
            PG8_BAR; PG8_WAIT_L(0); PG8_MMA(0, 1, At, B1); PG8_BAR;
            PG8_LDA(At, 1, 1); PG8_STAGE(PG8_SA(1, 0), a3);
            PG8_BAR; PG8_WAIT_L(0); PG8_MMA(1, 0, At, B0); PG8_BAR; PG8_SCHED;
            PG8_STAGE(PG8_SB(1, 1), b3 + hstep);
            PG8_WAIT_V(6); PG8_BAR; PG8_MMA(1, 1, At, B1); PG8_BAR;
        }
        E(acc, cur, wr, wc, fr, fq);
        if (!has_next) break;
#pragma unroll
        for (int a = 0; a < 2; ++a)
#pragma unroll
            for (int b = 0; b < 2; ++b)
#pragma unroll
                for (int m = 0; m < 4; ++m)
#pragma unroll
                    for (int n = 0; n < 2; ++n) acc[a][b][m][n] = (f32x4){0.f, 0.f, 0.f, 0.f};
        cur = nxt; cA = nA; cB = nB; ++ui;
    }
    PG8_WAIT_V(0);
    if (wr == 0) PG8_BAR;
    PG8_BAR;
#undef PG8_SA
#undef PG8_SB
#undef PG8_STAGE
#undef PG8_LDA
#undef PG8_LDB
#undef PG8_MMA
#undef PG8_WAIT_V
#undef PG8_WAIT_L
#undef PG8_BAR
#undef PG8_SCHED
}
}

typedef f32x4 AccT[2][2][4][2];

DI int src_col_in(int R) {
    const int pn = R >> 8, c = R & 255, bj = c >> 7, wc = (c >> 5) & 3, r5 = c & 31;
    if (pn < 8) return (4 * pn + wc) * 64 + 32 * bj + r5;
    if (pn == 8) return 2048 + wc * 64 + 32 * bj + r5;
    if (pn == 9) return 2304 + c;
    if (pn < 26) return (bj ? 6656 : 2560) + 128 * (pn - 10) + (c & 127);
    if (pn < 42) return (bj ? 10752 : 4608) + 128 * (pn - 26) + (c & 127);
    return 8704 + 256 * (pn - 42) + c;
}
DI int src_col_gu(int R) { const int t = R >> 8, c = R & 255; return ((c >> 7) ? DFF : 0) + 128 * t + (c & 127); }

DI unsigned bperm(int src4, unsigned v) { return (unsigned)__builtin_amdgcn_ds_bpermute(src4, (int)v); }
DI u32x2 perm2(int src4, u32x2 v) { u32x2 r; r.x = bperm(src4, v.x); r.y = bperm(src4, v.y); return r; }
DI f32x4 perm4(int src4, f32x4 v) { f32x4 r; r[0] = __uint_as_float(bperm(src4, __float_as_uint(v[0]))); r[1] = __uint_as_float(bperm(src4, __float_as_uint(v[1])));
    r[2] = __uint_as_float(bperm(src4, __float_as_uint(v[2]))); r[3] = __uint_as_float(bperm(src4, __float_as_uint(v[3]))); return r; }

struct Epi1 {
    bf16_t *Q, *Kb, *Vb, *U, *BG, *SGA; const float *qg, *kg, *cosT, *sinT; float* out;
    DI void side_kv(float* pwin, float* swin, int row, int col, f32x4 v) const {
        if (row >= TP - 128 && row < TP) *(f32x4*)(pwin + (size_t)(row - (TP - 128)) * 256 + col) = v;
        if (row >= TP) { const int b = (row - TP) >> 2, i = (row - TP) & 3; *(f32x4*)(swin + (size_t)b * 32768 + (size_t)(124 + i) * 256 + col) = v; }
    }
    DI void operator()(const AccT& acc, const pg8::Unit& u, int wr, int wc, int fr, int fq) const {
        asm volatile("" : "+v"(fr), "+v"(fq));
        const int lane = fr + 16 * fq, tr = lane >> 2, tq = lane & 3, src4 = (tr + 16 * tq) * 4;
        const int pn = u.pn, row0 = u.pm * 256 + wr * 64 + fr, rowT0 = u.pm * 256 + wr * 64 + tr;
        const bool side = u.pm >= 31;
        if (pn < 9) {
            const float* g = pn < 8 ? qg : kg;
            f32x4 gv[2][2];
#pragma unroll
            for (int bj = 0; bj < 2; ++bj)
#pragma unroll
                for (int n = 0; n < 2; ++n) gv[bj][n] = *(const f32x4*)(g + 32 * bj + 16 * n + 4 * fq);
#pragma unroll
            for (int aim = 0; aim < 4; ++aim) {
                const int ai = aim >> 1, mh = (aim & 1) * 2;
                f32x4 cs[4][2], sn[4][2];
#pragma unroll
                for (int m = mh; m < mh + 2; ++m) {
                    const int row = row0 + 128 * ai + 16 * m;
                    const int pos = row < TP ? row : TP + ((row - TP) & 3);
#pragma unroll
                    for (int n = 0; n < 2; ++n) { cs[m][n] = *(const f32x4*)(cosT + (size_t)pos * 32 + 16 * n + 4 * fq); sn[m][n] = *(const f32x4*)(sinT + (size_t)pos * 32 + 16 * n + 4 * fq); }
                }
#pragma unroll
                for (int m = mh; m < mh + 2; ++m) {
                    const int rowT = rowT0 + 128 * ai + 16 * m;
                    float ssq = 0.f;
#pragma unroll
                    for (int bj = 0; bj < 2; ++bj)
#pragma unroll
                        for (int n = 0; n < 2; ++n) { const f32x4 x = acc[ai][bj][m][n]; ssq += (x[0] * x[0] + x[1] * x[1]) + (x[2] * x[2] + x[3] * x[3]); }
                    ssq += __shfl_xor(ssq, 16); ssq += __shfl_xor(ssq, 32);
                    const float rs = __builtin_amdgcn_rsqf(ssq * (1.0f / 64.0f) + EPS);
#pragma unroll
                    for (int n = 0; n < 2; ++n) {
                        const f32x4 y1 = acc[ai][0][m][n] * rs * gv[0][n], y2 = acc[ai][1][m][n] * rs * gv[1][n];
                        const f32x4 o1 = y1 * cs[m][n] - y2 * sn[m][n], o2 = y2 * cs[m][n] + y1 * sn[m][n];
                        const int d = 16 * n + 4 * tq;
                        const u32x2 w1 = perm2(src4, pk4(o1)), w2 = perm2(src4, pk4(o2));
                        if (pn < 8) {
                            bf16_t* qp = Q + (size_t)rowT * DM + (4 * pn + wc) * 64 + d;
                            *(u32x2*)qp = w1; *(u32x2*)(qp + 32) = w2;
                        } else {
                            bf16_t* kp = Kb + (size_t)rowT * 256 + wc * 64 + d;
                            *(u32x2*)kp = w1; *(u32x2*)(kp + 32) = w2;
                            if (side) { const f32x4 t1 = perm4(src4, o1), t2 = perm4(src4, o2);
                                side_kv(out + O_PK, out + O_SK, rowT, wc * 64 + d, t1); side_kv(out + O_PK, out + O_SK, rowT, wc * 64 + d + 32, t2); }
                        }
                    }
                }
            }
        } else if (pn == 9) {
#pragma unroll
            for (int ai = 0; ai < 2; ++ai)
#pragma unroll
                for (int m = 0; m < 4; ++m) {
                    const int rowT = rowT0 + 128 * ai + 16 * m;
#pragma unroll
                    for (int bj = 0; bj < 2; ++bj)
#pragma unroll
                        for (int n = 0; n < 2; ++n) { const int col = 128 * bj + 32 * wc + 16 * n + 4 * tq; const f32x4 v = acc[ai][bj][m][n];
                            *(u32x2*)(Vb + (size_t)rowT * 256 + col) = perm2(src4, pk4(v));
                            if (side) side_kv(out + O_PV, out + O_SV, rowT, col, perm4(src4, v)); }
                }
        } else if (pn < 26) {
            const int t = pn - 10;
#pragma unroll
            for (int ai = 0; ai < 2; ++ai)
#pragma unroll
                for (int m = 0; m < 4; ++m) {
                    const int rowT = rowT0 + 128 * ai + 16 * m;
#pragma unroll
                    for (int n = 0; n < 2; ++n) { const int col = 128 * t + 32 * wc + 16 * n + 4 * tq; const f32x4 v = acc[ai][0][m][n] * acc[ai][1][m][n];
                        *(u32x2*)(U + (size_t)rowT * DM + col) = perm2(src4, pk4(v));
                        if (side) { const f32x4 vt = perm4(src4, v);
                            if (rowT >= TP - 2 && rowT < TP) *(f32x4*)(out + O_PC + (size_t)(rowT - (TP - 2)) * DM + col) = vt;
                            if (rowT >= TP && ((rowT - TP) & 3) >= 2) { const int b = (rowT - TP) >> 2, i = (rowT - TP) & 3; *(f32x4*)(out + O_SC + (size_t)b * 4096 + (size_t)(i - 2) * DM + col) = vt; } } }
                }
        } else if (pn < 42) {
            const int t = pn - 26;
#pragma unroll
            for (int ai = 0; ai < 2; ++ai)
#pragma unroll
                for (int m = 0; m < 4; ++m) {
                    const int rowT = rowT0 + 128 * ai + 16 * m;
#pragma unroll
                    for (int n = 0; n < 2; ++n) { const int col = 128 * t + 32 * wc + 16 * n + 4 * tq; const f32x4 b = acc[ai][0][m][n], gc = acc[ai][1][m][n];
                        f32x4 v; v[0] = b[0] * sigmoidf_(gc[0]); v[1] = b[1] * sigmoidf_(gc[1]); v[2] = b[2] * sigmoidf_(gc[2]); v[3] = b[3] * sigmoidf_(gc[3]);
                        *(u32x2*)(BG + (size_t)rowT * DM + col) = perm2(src4, pk4(v)); }
                }
        } else {
#pragma unroll
            for (int ai = 0; ai < 2; ++ai)
#pragma unroll
                for (int m = 0; m < 4; ++m) {
                    const int rowT = rowT0 + 128 * ai + 16 * m;
#pragma unroll
                    for (int bj = 0; bj < 2; ++bj)
#pragma unroll
                        for (int n = 0; n < 2; ++n) { const int col = 256 * (pn - 42) + 128 * bj + 32 * wc + 16 * n + 4 * tq; const f32x4 a = acc[ai][bj][m][n];
                            f32x4 v; v[0] = sigmoidf_(a[0]); v[1] = sigmoidf_(a[1]); v[2] = sigmoidf_(a[2]); v[3] = sigmoidf_(a[3]);
                            *(u32x2*)(SGA + (size_t)rowT * DM + col) = perm2(src4, pk4(v)); }
                }
        }
    }
};

DI void store_partial(float* PB, const AccT& acc, const pg8::Unit& u, int wr, int wc, int tr, int tq, int src4) {
    float* pb = PB + ((size_t)u.split * TS + (size_t)(u.pm * 256 - TP) + wr * 64 + tr) * DM + u.pn * 256 + wc * 32 + 4 * tq;
#pragma unroll
    for (int ai = 0; ai < 2; ++ai)
#pragma unroll
        for (int m = 0; m < 4; ++m)
#pragma unroll
            for (int bj = 0; bj < 2; ++bj)
#pragma unroll
                for (int n = 0; n < 2; ++n) *(f32x4*)(pb + (size_t)(128 * ai + 16 * m) * DM + 128 * bj + 16 * n) = perm4(src4, acc[ai][bj][m][n]);
}

struct Epi3 {
    const float *xp, *xs, *gffn; float* Y; bf16_t* A2; float* SSQ; float* PB;
    DI void operator()(const AccT& acc, const pg8::Unit& u, int wr, int wc, int fr, int fq) const {
        asm volatile("" : "+v"(fr), "+v"(fq));
        const int lane = fr + 16 * fq, tr = lane >> 2, tq = lane & 3, src4 = (tr + 16 * tq) * 4;
        if (u.split >= 0) { store_partial(PB, acc, u, wr, wc, tr, tq, src4); return; }
        const int rowT0 = u.pm * 256 + wr * 64 + tr, colT0 = u.pn * 256 + wc * 32 + 4 * tq;
        const float* xb = u.pm < 32 ? xp : xs - (size_t)TP * DM;
        f32x4 gv[2][2];
#pragma unroll
        for (int bj = 0; bj < 2; ++bj)
#pragma unroll
            for (int n = 0; n < 2; ++n) gv[bj][n] = *(const f32x4*)(gffn + colT0 + 128 * bj + 16 * n);
#pragma unroll
        for (int aim = 0; aim < 4; ++aim) {
            const int ai = aim >> 1, mh = (aim & 1) * 2;
            f32x4 xv[4][2][2];
#pragma unroll
            for (int m = mh; m < mh + 2; ++m)
#pragma unroll
                for (int bj = 0; bj < 2; ++bj)
#pragma unroll
                    for (int n = 0; n < 2; ++n) xv[m][bj][n] = *(const f32x4*)(xb + (size_t)(rowT0 + 128 * ai + 16 * m) * DM + colT0 + 128 * bj + 16 * n);
#pragma unroll
            for (int m = mh; m < mh + 2; ++m) {
                const int rowT = rowT0 + 128 * ai + 16 * m; float ssq = 0.f;
#pragma unroll
                for (int bj = 0; bj < 2; ++bj)
#pragma unroll
                    for (int n = 0; n < 2; ++n) { const size_t off = (size_t)rowT * DM + colT0 + 128 * bj + 16 * n;
                        const f32x4 y = xv[m][bj][n] + perm4(src4, acc[ai][bj][m][n]);
                        ssq += (y[0] * y[0] + y[1] * y[1]) + (y[2] * y[2] + y[3] * y[3]);
                        *(f32x4*)(Y + off) = y; *(u32x2*)(A2 + off) = pk4(y * gv[bj][n]); }
                ssq += __shfl_xor(ssq, 1); ssq += __shfl_xor(ssq, 2);
                if (tq == 0) SSQ[(size_t)rowT * 32 + u.pn * 4 + wc] = ssq;
            }
        }
    }
};

struct Epi4 {
    const float* SSQ; bf16_t* HID;
    DI void operator()(const AccT& acc, const pg8::Unit& u, int wr, int wc, int fr, int fq) const {
        asm volatile("" : "+v"(fr), "+v"(fq));
        const int lane = fr + 16 * fq, tr = lane >> 2, tq = lane & 3, src4 = (tr + 16 * tq) * 4;
        const int row0 = u.pm * 256 + wr * 64 + fr, rowT0 = u.pm * 256 + wr * 64 + tr, colT0 = u.pn * 128 + wc * 32 + 4 * tq;
#pragma unroll
        for (int ai = 0; ai < 2; ++ai) {
            f32x4 sp[4][2];
#pragma unroll
            for (int m = 0; m < 4; ++m) { const f32x4* q = (const f32x4*)(SSQ + (size_t)(row0 + 128 * ai + 16 * m) * 32 + 8 * fq); sp[m][0] = q[0]; sp[m][1] = q[1]; }
#pragma unroll
            for (int m = 0; m < 4; ++m) {
                const int rowT = rowT0 + 128 * ai + 16 * m;
                const f32x4 s4 = sp[m][0] + sp[m][1];
                float ss = (s4[0] + s4[1]) + (s4[2] + s4[3]);
                ss += __shfl_xor(ss, 16); ss += __shfl_xor(ss, 32);
                const float rstd = __builtin_amdgcn_rsqf(ss * (1.0f / DM) + EPS);
#pragma unroll
                for (int n = 0; n < 2; ++n) { const f32x4 g = acc[ai][0][m][n] * rstd, up = acc[ai][1][m][n] * rstd;
                    f32x4 h; h[0] = g[0] * sigmoidf_(g[0]) * up[0]; h[1] = g[1] * sigmoidf_(g[1]) * up[1]; h[2] = g[2] * sigmoidf_(g[2]) * up[2]; h[3] = g[3] * sigmoidf_(g[3]) * up[3];
                    *(u32x2*)(HID + (size_t)rowT * DFF + colT0 + 16 * n) = perm2(src4, pk4(h)); }
            }
        }
    }
};

struct Epi5 {
    float* Y; float* PB;
    DI void operator()(const AccT& acc, const pg8::Unit& u, int wr, int wc, int fr, int fq) const {
        asm volatile("" : "+v"(fr), "+v"(fq));
        const int lane = fr + 16 * fq, tr = lane >> 2, tq = lane & 3, src4 = (tr + 16 * tq) * 4;
        if (u.split >= 0) { store_partial(PB, acc, u, wr, wc, tr, tq, src4); return; }
        const int rowT0 = u.pm * 256 + wr * 64 + tr, colT0 = u.pn * 256 + wc * 32 + 4 * tq;
#pragma unroll
        for (int aim = 0; aim < 4; ++aim) {
            const int ai = aim >> 1, mh = (aim & 1) * 2;
            f32x4 yv[4][2][2];
#pragma unroll
            for (int m = mh; m < mh + 2; ++m)
#pragma unroll
                for (int bj = 0; bj < 2; ++bj)
#pragma unroll
                    for (int n = 0; n < 2; ++n) yv[m][bj][n] = *(const f32x4*)(Y + (size_t)(rowT0 + 128 * ai + 16 * m) * DM + colT0 + 128 * bj + 16 * n);
#pragma unroll
            for (int m = mh; m < mh + 2; ++m)
#pragma unroll
                for (int bj = 0; bj < 2; ++bj)
#pragma unroll
                    for (int n = 0; n < 2; ++n) *(f32x4*)(Y + (size_t)(rowT0 + 128 * ai + 16 * m) * DM + colT0 + 128 * bj + 16 * n) = yv[m][bj][n] + perm4(src4, acc[ai][bj][m][n]);
        }
    }
};

DI void p0_transpose_item(const float* W, int K, int N, bf16_t* WT, int src_n0, int dst_n0, int k0, LAS float* scr, int lane) {
#pragma unroll 8
    for (int i = 0; i < 32; ++i) { const int kk = 2 * i + (lane >> 5); scr[kk * 33 + (lane & 31)] = W[(size_t)(k0 + kk) * N + src_n0 + (lane & 31)]; }
    asm volatile("s_waitcnt lgkmcnt(0)" ::: "memory");
    const int c = lane & 7;
#pragma unroll
    for (int j = 0; j < 4; ++j) { const int n = (lane >> 3) + 8 * j; const LAS float* s = scr + (8 * c) * 33 + n;
        u32x4 o; o.x = pk2(s[0 * 33], s[1 * 33]); o.y = pk2(s[2 * 33], s[3 * 33]); o.z = pk2(s[4 * 33], s[5 * 33]); o.w = pk2(s[6 * 33], s[7 * 33]);
        *(u32x4*)(WT + (size_t)(dst_n0 + n) * K + k0 + 8 * c) = o; }
    asm volatile("s_waitcnt lgkmcnt(0)" ::: "memory");
}

DI void p0_rest(const Params& p, LAS unsigned char* lds, int wid, int lane, int worker, int nworkers) {
    LAS float* scr = (LAS float*)(lds + wid * 8704);
    const int gw = worker * 8 + wid, NGW = nworkers * 8;
    bf16_t* WoutT = (bf16_t*)(p.ws + WS_WOUT); bf16_t* WguT = (bf16_t*)(p.ws + WS_WGU); bf16_t* WdnT = (bf16_t*)(p.ws + WS_WDN);
    constexpr int I_OUT = (DM / 64) * (DM / 32), I_GU = (DM / 64) * (NGU / 32), I_DN = (DFF / 64) * (DM / 32);
    for (int it = gw; it < I_OUT + I_GU + I_DN; it += NGW) {
        int r = it;
        if (r < I_OUT) { const int nblk = DM / 32, kb = r / nblk, nb = r % nblk; p0_transpose_item(p.w_out, DM, DM, WoutT, 32 * nb, 32 * nb, 64 * kb, scr, lane); continue; } r -= I_OUT;
        if (r < I_GU) { const int nblk = NGU / 32, kb = r / nblk, nb = r % nblk; p0_transpose_item(p.w_gu, DM, NGU, WguT, src_col_gu(32 * nb), 32 * nb, 64 * kb, scr, lane); continue; } r -= I_GU;
        { const int nblk = DM / 32, kb = r / nblk, nb = r % nblk; p0_transpose_item(p.w_dn, DFF, DM, WdnT, 32 * nb, 32 * nb, 64 * kb, scr, lane); }
    }
}

DI void p0_prologue(const Params& p, LAS unsigned char* lds, int wid, int lane) {
    LAS float* scr = (LAS float*)(lds + wid * 8704);
    const int gw = blockIdx.x * 8 + wid, NGW = gridDim.x * 8;
    bf16_t* WinT = (bf16_t*)(p.ws + WS_WIN);
    constexpr int I_IN = (DM / 64) * (DIN / 32);
    for (int it = gw; it < I_IN; it += NGW) { const int nblk = DIN / 32, kb = it / nblk, nb = it % nblk; p0_transpose_item(p.w_in, DM, DIN, WinT, src_col_in(32 * nb), 32 * nb, 64 * kb, scr, lane); }
    bf16_t* XN = (bf16_t*)(p.ws + WS_XN);
    for (int m = gw; m < MT; m += NGW) {
        const float* xrow = m < TP ? p.xp + (size_t)m * DM : p.xs + (size_t)(m - TP) * DM;
        const f32x4* xr = (const f32x4*)xrow + lane; f32x4 v[8]; float s = 0.f;
#pragma unroll
        for (int j = 0; j < 8; ++j) { v[j] = xr[64 * j]; s += (v[j][0] * v[j][0] + v[j][1] * v[j][1]) + (v[j][2] * v[j][2] + v[j][3] * v[j][3]); }
        const float rstd = 1.0f / sqrtf(wave_sum(s) * (1.0f / DM) + EPS);
        u32x2* o8 = (u32x2*)(XN + (size_t)m * DM) + lane;
#pragma unroll
        for (int j = 0; j < 8; ++j) { const f32x4 gv = ((const f32x4*)p.norm_mix)[64 * j + lane]; o8[64 * j] = pk4(v[j] * rstd * gv); }
    }
    float* cosT = (float*)(p.ws + WS_COS); float* sinT = (float*)(p.ws + WS_SIN);
    const int gt = blockIdx.x * 512 + threadIdx.x, GT = gridDim.x * 512;
    for (int idx = gt; idx < NPOS * 32; idx += GT) {
        const int pos = idx >> 5, i = idx & 31;
        const float inv = __builtin_amdgcn_exp2f(-(float)i * (13.287712379549449f / 32.0f));
        const float ang = (float)pos * inv;
        const double rev = (double)ang * 0.15915494309189535; const float fr = (float)(rev - __builtin_floor(rev));
        cosT[idx] = __builtin_amdgcn_cosf(fr); sinT[idx] = __builtin_amdgcn_sinf(fr);
    }
}

DI void cache_copy(const Params& p, int worker, int nworkers) {
    const int gt = worker * 512 + threadIdx.x, GT = nworkers * 512;
    for (int idx = gt; idx < 128 * 7936; idx += GT) {
        const int b = idx / 7936, e = idx - b * 7936;
        ((f32x4*)(p.out + O_SK + (size_t)b * 32768))[e] = ((const f32x4*)(p.ck + (size_t)b * 32768 + 1024))[e];
        ((f32x4*)(p.out + O_SV + (size_t)b * 32768))[e] = ((const f32x4*)(p.cv + (size_t)b * 32768 + 1024))[e];
    }
}

#define MFMA32(a, b, c) __builtin_amdgcn_mfma_f32_32x32x16_bf16((a), (b), (c), 0, 0, 0)
DI int crow(int reg, int h) { return (reg & 3) + 8 * (reg >> 2) + 4 * h; }
DI bf16x8 pack8(const f32x16& x, int s) {
    u32x4 p; p.x = pk2(x[8 * s], x[8 * s + 1]); p.y = pk2(x[8 * s + 2], x[8 * s + 3]); p.z = pk2(x[8 * s + 4], x[8 * s + 5]); p.w = pk2(x[8 * s + 6], x[8 * s + 7]);
    return __builtin_bit_cast(bf16x8, p);
}
DI bf16x8 cvt8(f32x4 a, f32x4 b) { u32x4 p; p.x = pk2(a[0], a[1]); p.y = pk2(a[2], a[3]); p.z = pk2(b[0], b[1]); p.w = pk2(b[2], b[3]); return __builtin_bit_cast(bf16x8, p); }

constexpr int KS_STRIDE = 72, VT_STRIDE = 260, VT_OFF = 256 * KS_STRIDE * 2;

template <bool SAMPLE>
DI void attn_chunk(const Params& p, LAS unsigned char* lds, int qb, int c, int kvh, int head_w, int b_s, int lane) {
    const bf16_t* Q = (const bf16_t*)(p.ws + WS_Q); const bf16_t* Kb = (const bf16_t*)(p.ws + WS_K); const bf16_t* Vb = (const bf16_t*)(p.ws + WS_V);
    const bf16_t* U = (const bf16_t*)(p.ws + WS_U); const bf16_t* BG = (const bf16_t*)(p.ws + WS_BG); const bf16_t* SGA = (const bf16_t*)(p.ws + WS_SGA);
    bf16_t* MIX = (bf16_t*)(p.ws + WS_MIX);
    const int r = lane & 31, g = lane >> 5;
    int tok, head, itok = 0;
    if (SAMPLE) { itok = r >> 3; head = kvh * 8 + (r & 7); tok = TP + 4 * b_s + itok; }
    else { head = head_w; tok = 128 * qb + 32 * c + r; }
    const LAS bf16_t* Ks = (const LAS bf16_t*)lds; const LAS bf16_t* Vt = (const LAS bf16_t*)(lds + VT_OFF);
    bf16x8 qf[4];
#pragma unroll
    for (int ks = 0; ks < 4; ++ks) qf[ks] = *(const bf16x8*)(Q + (size_t)tok * DM + head * 64 + 16 * ks + 8 * g);
    f32x16 s[5];
#pragma unroll
    for (int kbr = 0; kbr < 5; ++kbr) {
#pragma unroll
        for (int i = 0; i < 16; ++i) s[kbr][i] = 0.f;
#pragma unroll
        for (int ks = 0; ks < 4; ++ks) {
            bf16x8 a;
            if (SAMPLE) {
                if (kbr < 4) { const float* kp = p.ck + ((size_t)(b_s * 128 + 32 * kbr + r) * 4 + kvh) * 64 + 16 * ks + 8 * g; a = cvt8(*(const f32x4*)kp, *(const f32x4*)(kp + 4)); }
                else { u32x4 z = (u32x4){0u, 0u, 0u, 0u}; if (r < 4) z = *(const u32x4*)(Kb + (size_t)(TP + 4 * b_s + r) * 256 + kvh * 64 + 16 * ks + 8 * g); a = __builtin_bit_cast(bf16x8, z); }
            } else a = *(const LAS bf16x8*)(Ks + (32 * (c + kbr) + r) * KS_STRIDE + 16 * ks + 8 * g);
            s[kbr] = MFMA32(a, qf[ks], s[kbr]);
        }
    }
    const float sc = 0.125f * 1.44269504089f;
    const float sink2 = p.sinks[head] * 1.44269504089f;
    float mraw = -1e30f;
#pragma unroll
    for (int kbr = 0; kbr < 5; ++kbr)
#pragma unroll
        for (int i = 0; i < 16; ++i) {
            const int kr = crow(i, g); bool valid;
            if (SAMPLE) valid = kbr < 4 ? (32 * kbr + kr > itok) : (kr <= itok);
            else { valid = kbr == 0 ? (kr > r) : (kbr == 4 ? (kr <= r) : true); if (qb == 0 && c + kbr < 4) valid = false; }
            const float t = valid ? s[kbr][i] : -1e30f; s[kbr][i] = t; mraw = fmaxf(mraw, t);
        }
    mraw = fmaxf(mraw, __shfl_xor(mraw, 32));
    const float mx = fmaxf(mraw * sc, sink2);
    float sum = 0.f;
#pragma unroll
    for (int kbr = 0; kbr < 5; ++kbr)
#pragma unroll
        for (int i = 0; i < 16; ++i) { const float e = __builtin_amdgcn_exp2f(__builtin_fmaf(s[kbr][i], sc, -mx)); s[kbr][i] = e; sum += e; }
    sum += __shfl_xor(sum, 32);
    const float inv = 1.0f / (sum + __builtin_amdgcn_exp2f(sink2 - mx));
    f32x16 o[2];
#pragma unroll
    for (int dt = 0; dt < 2; ++dt)
#pragma unroll
        for (int i = 0; i < 16; ++i) o[dt][i] = 0.f;
#pragma unroll
    for (int kbr = 0; kbr < 5; ++kbr)
#pragma unroll
        for (int kk = 0; kk < 2; ++kk) {
            const bf16x8 pb = pack8(s[kbr], kk);
#pragma unroll
            for (int dt = 0; dt < 2; ++dt) {
                bf16x8 a; const int d = 32 * dt + r;
                if (SAMPLE) {
                    if (kbr < 4) { float f[8];
#pragma unroll
                        for (int j = 0; j < 8; ++j) { const int key = 32 * kbr + 16 * kk + 8 * (j >> 2) + 4 * g + (j & 3); f[j] = p.cv[((size_t)(b_s * 128 + key) * 4 + kvh) * 64 + d]; }
                        a = cvt8((f32x4){f[0], f[1], f[2], f[3]}, (f32x4){f[4], f[5], f[6], f[7]});
                    } else { u32x4 z = (u32x4){0u, 0u, 0u, 0u};
                        if (kk == 0 && g == 0) { const bf16_t* vp = Vb + (size_t)(TP + 4 * b_s) * 256 + kvh * 64 + d; z.x = (unsigned)vp[0] | ((unsigned)vp[256] << 16); z.y = (unsigned)vp[512] | ((unsigned)vp[768] << 16); }
                        a = __builtin_bit_cast(bf16x8, z); }
                } else {
                    const LAS bf16_t* vp = Vt + d * VT_STRIDE + 32 * (c + kbr) + 16 * kk + 4 * g;
                    const s16x4 lo = *(const LAS s16x4*)vp, hi = *(const LAS s16x4*)(vp + 8);
                    a = __builtin_shufflevector(lo, hi, 0, 1, 2, 3, 4, 5, 6, 7);
                }
                o[dt] = MFMA32(a, pb, o[dt]);
            }
        }
    if (!SAMPLE) {
#pragma unroll
        for (int dt = 0; dt < 2; ++dt)
#pragma unroll
            for (int i4 = 0; i4 < 4; ++i4) {
                const int col = head * 64 + 32 * dt + 8 * i4 + 4 * g;
                const f32x4 at = (f32x4){o[dt][4 * i4], o[dt][4 * i4 + 1], o[dt][4 * i4 + 2], o[dt][4 * i4 + 3]} * inv;
                *(u32x2*)(MIX + (size_t)tok * DM + col) = pk4(at);
            }
        return;
    }
#pragma unroll
    for (int dt = 0; dt < 2; ++dt) {
        u32x2 lsga[4], lbg[4], lu0[4]; f32x4 lu1[4], lu2[4], w0[4], w1[4], w2[4];
#pragma unroll
        for (int i4 = 0; i4 < 4; ++i4) {
            const int col = head * 64 + 32 * dt + 8 * i4 + 4 * g; const size_t off = (size_t)tok * DM + col;
            lsga[i4] = *(const u32x2*)(SGA + off); lbg[i4] = *(const u32x2*)(BG + off); lu0[i4] = *(const u32x2*)(U + off);
            lu1[i4] = itok >= 1 ? unpk4(*(const u32x2*)(U + off - DM)) : *(const f32x4*)(p.sconv + (size_t)b_s * 4096 + DM + col);
            lu2[i4] = itok >= 2 ? unpk4(*(const u32x2*)(U + off - 2 * DM)) : *(const f32x4*)(p.sconv + (size_t)b_s * 4096 + (size_t)itok * DM + col);
            w0[i4] = *(const f32x4*)(p.conv_w + col); w1[i4] = *(const f32x4*)(p.conv_w + DM + col); w2[i4] = *(const f32x4*)(p.conv_w + 2 * DM + col);
        }
#pragma unroll
        for (int i4 = 0; i4 < 4; ++i4) {
            const int col = head * 64 + 32 * dt + 8 * i4 + 4 * g; const size_t off = (size_t)tok * DM + col;
            const f32x4 at = (f32x4){o[dt][4 * i4], o[dt][4 * i4 + 1], o[dt][4 * i4 + 2], o[dt][4 * i4 + 3]} * inv;
            const f32x4 conv = w0[i4] * lu2[i4] + w1[i4] * lu1[i4] + w2[i4] * unpk4(lu0[i4]);
            *(u32x2*)(MIX + off) = pk4(unpk4(lsga[i4]) * at + unpk4(lbg[i4]) * conv);
        }
    }
}

DI void unpk8(u32x4 w, f32x4& lo, f32x4& hi) { lo = (f32x4){bf_lo(w.x), bf_hi(w.x), bf_lo(w.y), bf_hi(w.y)}; hi = (f32x4){bf_lo(w.z), bf_hi(w.z), bf_lo(w.w), bf_hi(w.w)}; }

constexpr int P2_CNT_OFF = 120000;
DI void p2_attention(const Params& p, LAS unsigned char* lds, int tid, int wid, int lane) {
    const bf16_t* Kb = (const bf16_t*)(p.ws + WS_K); const bf16_t* Vb = (const bf16_t*)(p.ws + WS_V);
    const bf16_t* U = (const bf16_t*)(p.ws + WS_U); const bf16_t* BG = (const bf16_t*)(p.ws + WS_BG); const bf16_t* SGA = (const bf16_t*)(p.ws + WS_SGA);
    bf16_t* MIX = (bf16_t*)(p.ws + WS_MIX);
    LAS bf16_t* Ks = (LAS bf16_t*)lds; LAS bf16_t* Vt = (LAS bf16_t*)(lds + VT_OFF);
    LAS unsigned* cnt = (LAS unsigned*)(lds + P2_CNT_OFF);
    int samp_next = blockIdx.x * 2;
    for (int item = blockIdx.x; item < 256; item += gridDim.x) {
        const int qb = item >> 2, kvh = item & 3;
        __syncthreads();
#pragma unroll
        for (int i = 0; i < 4; ++i) {
            const int e = tid + 512 * i, row = e >> 3, c8 = e & 7, tok = 128 * (qb - 1) + row;
            u32x4 kv = (u32x4){0u, 0u, 0u, 0u}, vv = (u32x4){0u, 0u, 0u, 0u};
            if (tok >= 0) { kv = *(const u32x4*)(Kb + (size_t)tok * 256 + kvh * 64 + 8 * c8); vv = *(const u32x4*)(Vb + (size_t)tok * 256 + kvh * 64 + 8 * c8); }
            *(LAS u32x4*)(Ks + row * KS_STRIDE + 8 * c8) = kv;
#pragma unroll
            for (int jj = 0; jj < 8; ++jj) Vt[(8 * c8 + jj) * VT_STRIDE + row] = (bf16_t)(vv[jj >> 1] >> (16 * (jj & 1)));
        }
        if (tid == 0) *cnt = 0u;
        __syncthreads();
        const int ns = (samp_next < 512) ? ((samp_next + 1 < 512) ? 2 : 1) : 0;
        for (;;) {
            unsigned t = 0; if (lane == 0) t = __hip_atomic_fetch_add(cnt, 1u, __ATOMIC_RELAXED, __HIP_MEMORY_SCOPE_WORKGROUP);
            t = __builtin_amdgcn_readfirstlane(t);
            if ((int)t >= ns + 32) break;
            if ((int)t < ns) { const int it = samp_next + (int)t; attn_chunk<true>(p, lds, 0, 0, it & 3, 0, it >> 2, lane); }
            else { const int pc = (int)t - ns; attn_chunk<false>(p, lds, qb, pc & 3, kvh, kvh * 8 + (pc >> 2), 0, lane); }
        }
        samp_next += gridDim.x * 2;
        asm volatile("s_waitcnt vmcnt(0)" ::: "memory");
        __syncthreads();
        __builtin_amdgcn_fence(__ATOMIC_ACQUIRE, "agent");
        {
            const int c8 = tid & 63, rbase = tid >> 6, col = kvh * 512 + 8 * c8;
            f32x4 w[3][2];
#pragma unroll
            for (int k = 0; k < 3; ++k) { w[k][0] = *(const f32x4*)(p.conv_w + k * DM + col); w[k][1] = *(const f32x4*)(p.conv_w + k * DM + col + 4); }
#pragma unroll
            for (int ib = 0; ib < 4; ++ib) {
                u32x4 la[4], ls[4], lb[4], l0[4], l1[4], l2[4];
#pragma unroll
                for (int ii = 0; ii < 4; ++ii) {
                    const int tok = 128 * qb + rbase + 8 * (4 * ib + ii); const size_t off = (size_t)tok * DM + col;
                    la[ii] = *(const u32x4*)(MIX + off); ls[ii] = *(const u32x4*)(SGA + off); lb[ii] = *(const u32x4*)(BG + off); l0[ii] = *(const u32x4*)(U + off);
                    l1[ii] = (u32x4){0u, 0u, 0u, 0u}; l2[ii] = (u32x4){0u, 0u, 0u, 0u};
                    if (tok >= 1) l1[ii] = *(const u32x4*)(U + off - DM);
                    if (tok >= 2) l2[ii] = *(const u32x4*)(U + off - 2 * DM);
                }
#pragma unroll
                for (int ii = 0; ii < 4; ++ii) {
                    const int tok = 128 * qb + rbase + 8 * (4 * ib + ii); const size_t off = (size_t)tok * DM + col;
                    f32x4 a0, a1, s0, s1, b0, b1, x0, x1, y0, y1, z0, z1;
                    unpk8(la[ii], a0, a1); unpk8(ls[ii], s0, s1); unpk8(lb[ii], b0, b1); unpk8(l0[ii], x0, x1); unpk8(l1[ii], y0, y1); unpk8(l2[ii], z0, z1);
                    const f32x4 m0 = s0 * a0 + b0 * (w[0][0] * z0 + w[1][0] * y0 + w[2][0] * x0);
                    const f32x4 m1 = s1 * a1 + b1 * (w[0][1] * z1 + w[1][1] * y1 + w[2][1] * x1);
                    u32x4 o; o.x = pk2(m0[0], m0[1]); o.y = pk2(m0[2], m0[3]); o.z = pk2(m1[0], m1[1]); o.w = pk2(m1[2], m1[3]);
                    *(u32x4*)(MIX + off) = o;
                }
            }
        }
    }
    for (int it = samp_next + (wid & 1); it < 512 && wid < 2; it += gridDim.x * 2) attn_chunk<true>(p, lds, 0, 0, it & 3, 0, it >> 2, lane);
}

DI void p3_reduce(const Params& p, int wid, int lane) {
    const float* PB = (const float*)(p.ws + WS_PB); bf16_t* A2 = (bf16_t*)(p.ws + WS_A2); float* SSQ = (float*)(p.ws + WS_SSQ);
    for (int r = blockIdx.x * 8 + wid; r < TS; r += gridDim.x * 8) {
        const int row = TP + r; f32x4 y[8]; float s = 0.f;
#pragma unroll
        for (int j = 0; j < 8; ++j) { const size_t o = (size_t)r * DM + 256 * j + 4 * lane;
            y[j] = *(const f32x4*)(p.xs + o) + ((*(const f32x4*)(PB + o) + *(const f32x4*)(PB + (size_t)TS * DM + o)) + (*(const f32x4*)(PB + (size_t)2 * TS * DM + o) + *(const f32x4*)(PB + (size_t)3 * TS * DM + o)));
            s += (y[j][0] * y[j][0] + y[j][1] * y[j][1]) + (y[j][2] * y[j][2] + y[j][3] * y[j][3]); }
        s = wave_sum(s);
#pragma unroll
        for (int j = 0; j < 8; ++j) { const int col = 256 * j + 4 * lane; *(f32x4*)(p.out + (size_t)row * DM + col) = y[j];
            *(u32x2*)(A2 + (size_t)row * DM + col) = pk4(y[j] * *(const f32x4*)(p.norm_ffn + col)); }
        if (lane < 32) SSQ[(size_t)row * 32 + lane] = lane == 0 ? s : 0.f;
    }
}
DI void p5_reduce(const Params& p) {
    const float* PB = (const float*)(p.ws + WS_PB);
    for (int i = blockIdx.x * 512 + threadIdx.x; i < TS * DM / 4; i += gridDim.x * 512) { const size_t o = (size_t)i * 4; float* yp = p.out + (size_t)TP * DM + o;
        *(f32x4*)yp = *(const f32x4*)yp + ((*(const f32x4*)(PB + o) + *(const f32x4*)(PB + (size_t)TS * DM + o)) + (*(const f32x4*)(PB + (size_t)2 * TS * DM + o) + *(const f32x4*)(PB + (size_t)3 * TS * DM + o))); }
}

constexpr int LDS_BYTES = pg8::STAGE_BYTES + 16;

__global__ void __launch_bounds__(512, 2) fwd_megakernel(Params p) {
    extern __shared__ __attribute__((aligned(16))) unsigned char lds_raw[];
    LAS unsigned char* lds = (LAS unsigned char*)lds_raw;
    cg::grid_group grid = cg::this_grid();
    if (p.never) grid.sync();
    if (threadIdx.x < 4) ((LAS unsigned*)(lds + pg8::STAGE_BYTES))[threadIdx.x] = 0u;
    __syncthreads();
    const XcdBarrier xb = xcd_barrier_post((unsigned*)(p.ws + WS_BAR), (volatile LAS unsigned*)(lds + pg8::STAGE_BYTES));
    const int tid = threadIdx.x, wid = __builtin_amdgcn_readfirstlane(tid >> 6), lane = tid & 63;
    const int G = gridDim.x, bid = blockIdx.x;
    unsigned char* ws = p.ws;

    p0_prologue(p, lds, wid, lane);
    xcd_barrier(xb);
    {
        pg8::Gemm g{(const bf16_t*)(ws + WS_XN), (const bf16_t*)(ws + WS_WIN), MT, DIN, DM}; pg8::StaticOrder S; S.init(MT, DIN, G, bid);
        Epi1 E{(bf16_t*)(ws + WS_Q), (bf16_t*)(ws + WS_K), (bf16_t*)(ws + WS_V), (bf16_t*)(ws + WS_U), (bf16_t*)(ws + WS_BG), (bf16_t*)(ws + WS_SGA),
               p.q_norm, p.k_norm, (const float*)(ws + WS_COS), (const float*)(ws + WS_SIN), p.out};
        pg8::gemm_phase<Epi1, pg8::StaticOrder>(lds, g, S, E);
        {
            const int nfull = ((MT / 256) * (DIN / 256)) % G;
            if (nfull == 0) p0_rest(p, lds, wid, lane, bid, G);
            else if (bid >= nfull) p0_rest(p, lds, wid, lane, bid - nfull, G - nfull);
        }
    }
    xcd_barrier(xb);
    p2_attention(p, lds, tid, wid, lane);
    xcd_barrier(xb);
    {
        pg8::Gemm g{(const bf16_t*)(ws + WS_MIX), (const bf16_t*)(ws + WS_WOUT), MT, DM, DM}; pg8::SplitOrder S; S.init(DM, G, bid, DM / 64);
        Epi3 E{p.xp, p.xs, p.norm_ffn, p.out, (bf16_t*)(ws + WS_A2), (float*)(ws + WS_SSQ), (float*)(ws + WS_PB)};
        pg8::gemm_phase<Epi3, pg8::SplitOrder>(lds, g, S, E);
        {   const int nfull = S.total() % G;
            if (nfull == 0) cache_copy(p, bid, G); else if (bid >= nfull) cache_copy(p, bid - nfull, G - nfull);
        }
    }
    xcd_barrier(xb);
    p3_reduce(p, wid, lane);
    xcd_barrier(xb);
    {
        pg8::Gemm g{(const bf16_t*)(ws + WS_A2), (const bf16_t*)(ws + WS_WGU), MT, NGU, DM}; pg8::StaticOrder S; S.init(MT, NGU, G, bid);
        Epi4 E{(const float*)(ws + WS_SSQ), (bf16_t*)(ws + WS_HID)};
        pg8::gemm_phase<Epi4, pg8::StaticOrder>(lds, g, S, E);
    }
    xcd_barrier(xb);
    {
        pg8::Gemm g{(const bf16_t*)(ws + WS_HID), (const bf16_t*)(ws + WS_WDN), MT, DM, DFF}; pg8::SplitOrder S; S.init(DM, G, bid, DFF / 64);
        Epi5 E{p.out, (float*)(ws + WS_PB)};
        pg8::gemm_phase<Epi5, pg8::SplitOrder>(lds, g, S, E);
    }
    xcd_barrier(xb);
    p5_reduce(p);
}

extern "C" void kernel_launch(void* const* d_in, const int* in_sizes, int n_in, void* d_out, int out_size, void* d_ws, size_t ws_size, hipStream_t stream) {
    static int grid = 0;
    if (!grid) {
        int dev = 0, cus = 0, per_cu = 0;
        (void)hipGetDevice(&dev);
        (void)hipDeviceGetAttribute(&cus, hipDeviceAttributeMultiprocessorCount, dev);
        (void)hipFuncSetAttribute((const void*)fwd_megakernel, hipFuncAttributeMaxDynamicSharedMemorySize, LDS_BYTES);
        (void)hipOccupancyMaxActiveBlocksPerMultiprocessor(&per_cu, (const void*)fwd_megakernel, 512, LDS_BYTES);
        if (per_cu < 1) per_cu = 1;
        grid = cus * per_cu;
        if (ws_size < WS_END) fprintf(stderr, "kernel_launch: workspace too small (%zu < %zu)\n", ws_size, (size_t)WS_END);
    }
    Params p{};
    p.xp = (const float*)d_in[0]; p.xs = (const float*)d_in[1]; p.ck = (const float*)d_in[2]; p.cv = (const float*)d_in[3]; p.sconv = (const float*)d_in[4];
    p.norm_mix = (const float*)d_in[5]; p.w_in = (const float*)d_in[6]; p.q_norm = (const float*)d_in[7]; p.k_norm = (const float*)d_in[8]; p.sinks = (const float*)d_in[9];
    p.conv_w = (const float*)d_in[10]; p.w_out = (const float*)d_in[11]; p.norm_ffn = (const float*)d_in[12]; p.w_gu = (const float*)d_in[13]; p.w_dn = (const float*)d_in[14];
    p.out = (float*)d_out; p.ws = (unsigned char*)d_ws;
    p.never = 0;
    (void)hipMemsetAsync((char*)d_ws + WS_BAR, 0, 16384, stream);
    void* args[] = {&p};
    hipError_t e = hipLaunchCooperativeKernel((const void*)fwd_megakernel, dim3(grid), dim3(512), args, LDS_BYTES, stream);
    if (e != hipSuccess) fprintf(stderr, "cooperative launch failed: %s (grid %d)\n", hipGetErrorString(e), grid);
}
```

```cpp
#include <hip/hip_runtime.h>
#include <hip/hip_cooperative_groups.h>
#include <cstdio>
namespace cg = cooperative_groups;
#define REP_P0 1
#define REP_P1 1
#define REP_P2 1
#define REP_P3 1
#define REP_P4 1
#define REP_SYNC 0

#define LAS __attribute__((address_space(3)))
#define DI __device__ __forceinline__
typedef unsigned short bf16_t;
typedef short bf16x8 __attribute__((ext_vector_type(8)));
typedef short s16x4 __attribute__((ext_vector_type(4)));
typedef float f32x4 __attribute__((ext_vector_type(4)));
typedef float f32x16 __attribute__((ext_vector_type(16)));
typedef unsigned u32x4 __attribute__((ext_vector_type(4)));
typedef unsigned u32x2 __attribute__((ext_vector_type(2)));

constexpr int DM = 2048, TP = 8192, TS = 512, MT = TP + TS, DIN = 12800, DFF = 5632, NGU = 2 * DFF;
constexpr float EPS = 1e-6f;
constexpr int NPOS = 8196;
constexpr size_t O_YP = 0, O_YS = (size_t)TP * DM, O_PK = O_YS + (size_t)TS * DM, O_PV = O_PK + 32768, O_PC = O_PV + 32768,
                 O_SK = O_PC + 4096, O_SV = O_SK + 4194304, O_SC = O_SV + 4194304;
constexpr size_t WS_WIN = 0, WS_WOUT = WS_WIN + (size_t)DIN * DM * 2, WS_WGU = WS_WOUT + (size_t)DM * DM * 2, WS_WDN = WS_WGU + (size_t)NGU * DM * 2,
                 WS_XN = WS_WDN + (size_t)DM * DFF * 2, WS_Q = WS_XN + (size_t)MT * DM * 2, WS_K = WS_Q + (size_t)MT * DM * 2, WS_V = WS_K + (size_t)MT * 256 * 2,
                 WS_U = WS_V + (size_t)MT * 256 * 2, WS_BG = WS_U + (size_t)MT * DM * 2, WS_SGA = WS_BG + (size_t)MT * DM * 2, WS_COS = WS_SGA + (size_t)MT * DM * 2,
                 WS_SIN = WS_COS + (size_t)NPOS * 32 * 4, WS_SSQ = WS_SIN + (size_t)NPOS * 32 * 4, WS_BAR = WS_SSQ + (size_t)MT * 32 * 4, WS_PB = WS_BAR + 16384, WS_END = WS_PB + (size_t)4 * TS * DM * 4;
constexpr size_t WS_MIX = WS_XN, WS_A2 = WS_Q, WS_HID = WS_U;
static_assert((size_t)MT * DFF * 2 <= 3 * (size_t)MT * DM * 2, "hidden fits in U|BG|SGA");

struct Params {
    const float *xp, *xs, *ck, *cv, *sconv, *norm_mix, *w_in, *q_norm, *k_norm, *sinks, *conv_w, *w_out, *norm_ffn, *w_gu, *w_dn;
    float* out; unsigned char* ws; long never;
};

typedef float f32x2 __attribute__((ext_vector_type(2)));
typedef __bf16 bf16x2v __attribute__((ext_vector_type(2)));
DI unsigned pk2(float lo, float hi) { const f32x2 f = {lo, hi}; return __builtin_bit_cast(unsigned, __builtin_convertvector(f, bf16x2v)); }
DI u32x2 pk4(f32x4 v) { u32x2 r; r.x = pk2(v[0], v[1]); r.y = pk2(v[2], v[3]); return r; }
DI float bf_lo(unsigned w) { return __uint_as_float(w << 16); }
DI float bf_hi(unsigned w) { return __uint_as_float(w & 0xffff0000u); }
DI f32x4 unpk4(u32x2 w) { return (f32x4){bf_lo(w.x), bf_hi(w.x), bf_lo(w.y), bf_hi(w.y)}; }
DI float sigmoidf_(float x) { return __builtin_amdgcn_rcpf(1.0f + __builtin_amdgcn_exp2f(-1.44269504089f * x)); }
DI float wave_sum(float v) {
#pragma unroll
    for (int o = 1; o < 64; o <<= 1) v += __shfl_xor(v, o);
    return v;
}


#define XB_TMO      128
#define XB_XCNT(j)  (256  + 64 * (j))
#define XB_XSUB(j)  (1280 + 64 * (j))
#define XB_XGEN(j)  (2304 + 64 * (j))
#define XB_TOP      3328
#define XB_TOPGEN   3392
#define XCD_BAR_WORDS 3456
#define XB_SPIN_CAP (1u << 20)
DI unsigned xb_ld(unsigned* p)              { return __hip_atomic_load(p, __ATOMIC_RELAXED, __HIP_MEMORY_SCOPE_AGENT); }
DI unsigned xb_add(unsigned* p, unsigned v) { return __hip_atomic_fetch_add(p, v, __ATOMIC_RELAXED, __HIP_MEMORY_SCOPE_AGENT); }
DI unsigned xb_xcc_id() { return (unsigned)__builtin_amdgcn_s_getreg((3 << 11) | 20) & 0xFu; }
#define XB_SPIN(cond, bar) do { unsigned _sp = 0; while (cond) { __builtin_amdgcn_s_sleep(1); \
    if ((++_sp & 255u) == 0u) { if (xb_ld(&(bar)[XB_TMO])) break; if (_sp > XB_SPIN_CAP) { atomicAdd(&(bar)[XB_TMO], 1u); break; } } } } while (0)
struct XcdBarrier { unsigned* bar; unsigned x; volatile LAS unsigned* st; };
DI XcdBarrier xcd_barrier_post(unsigned* bar, volatile LAS unsigned* st) {
    XcdBarrier b; b.bar = bar; b.x = xb_xcc_id(); b.st = st;
    if (threadIdx.x == 0) (void)xb_add(&bar[XB_XCNT(b.x)], 1u);
    return b;
}
DI void xcd_barrier_complete(unsigned* bar, unsigned x, unsigned& nloc, unsigned& nx) {
    const unsigned G = gridDim.x * gridDim.y * gridDim.z;
    unsigned sum, cnt, mine, sp = 0u;
    for (;;) {
        sum = 0u; cnt = 0u; mine = 0u;
#pragma unroll
        for (unsigned j = 0; j < 16; ++j) { const unsigned c = xb_ld(&bar[XB_XCNT(j)]); sum += c; cnt += (c > 0u) ? 1u : 0u; mine = (j == x) ? c : mine; }
        if (sum == G) break;
        __builtin_amdgcn_s_sleep(1);
        if ((++sp & 255u) == 0u) { if (xb_ld(&bar[XB_TMO])) break; if (sp > XB_SPIN_CAP) { atomicAdd(&bar[XB_TMO], 1u); break; } }
    }
    nloc = mine > 0u ? mine : 1u; nx = cnt > 0u ? cnt : 1u;
}
DI void xcd_barrier(const XcdBarrier& b) {
    asm volatile("s_waitcnt vmcnt(0)" ::: "memory");
    __syncthreads();
    if (threadIdx.x == 0) {
        unsigned* bar = b.bar;
        __builtin_amdgcn_s_waitcnt(0);
        unsigned nloc = b.st[0], nx = b.st[1];
        if (nloc == 0u) { xcd_barrier_complete(bar, b.x, nloc, nx); b.st[0] = nloc; b.st[1] = nx; }
        const unsigned old = xb_add(&bar[XB_XSUB(b.x)], 1u);
        const unsigned gen = old / nloc;
        if (old + 1u == (gen + 1u) * nloc) {
            __builtin_amdgcn_fence(__ATOMIC_RELEASE, "agent");
            asm volatile("s_waitcnt vmcnt(0)" ::: "memory");
            const unsigned og = xb_add(&bar[XB_TOP], 1u);
            const unsigned tg = og / nx;
            if (og + 1u == (tg + 1u) * nx) xb_add(&bar[XB_TOPGEN], 1u);
            else XB_SPIN(xb_ld(&bar[XB_TOPGEN]) == tg, bar);
            __builtin_amdgcn_fence(__ATOMIC_ACQUIRE, "agent");
            xb_add(&bar[XB_XGEN(b.x)], 1u);
            asm volatile("s_waitcnt vmcnt(0)" ::: "memory");
        } else {
            XB_SPIN(xb_ld(&bar[XB_XGEN(b.x)]) == gen, bar);
            __builtin_amdgcn_fence(__ATOMIC_ACQUIRE, "agent");
            asm volatile("s_waitcnt vmcnt(0)" ::: "memory");
        }
    }
    __syncthreads();
}

namespace pg8 {
constexpr int BM = 256, BK = 64, HALF = 128, HTB = HALF * BK * 2, STAGE_BYTES = 8 * HTB, NXCD = 8, WGM = 8;
DI int lds_byte(int r, int c) { const int st = (r >> 4) * 2 + (c >> 5), rr = r & 15, cc = c & 31, ob = rr * 64 + cc * 2; return st * 1024 + (ob ^ (((ob >> 9) & 1) << 5)); }
DI void stage_rc(int b, int& R, int& C) { const int st = b / 1024, sb = b % 1024, swz = sb ^ (((sb >> 9) & 1) << 5); R = (st >> 1) * 16 + swz / 64; C = (st & 1) * 32 + (swz % 64) / 2; }
struct Unit { int pm, pn, k0, nt, split; };
struct Gemm { const bf16_t* A; const bf16_t* Bt; int M, N, K; };
struct StaticOrder {
    int nM, nN, nwg, G, c, ntk;
    DI void init(int M, int N, int G_, int c_, int ntk_ = 32) { nM = M / BM; nN = N / BM; nwg = nM * nN; G = G_; c = c_; ntk = ntk_; }
    DI void map(int L, Unit& u) const {
        int wgid = L; { const int q = nwg / NXCD, r = nwg % NXCD, xcd = wgid % NXCD, off = wgid / NXCD; wgid = (xcd < r ? xcd * (q + 1) : r * (q + 1) + (xcd - r) * q) + off; }
        const int nig = WGM * nN, gid = wgid / nig, fm = gid * WGM, gsz = (nM - fm) < WGM ? (nM - fm) : WGM;
        u.pm = fm + ((wgid % nig) % gsz); u.pn = (wgid % nig) / gsz; u.k0 = 0; u.nt = ntk; u.split = -1;
    }
    DI bool next(int i, Unit& u) const { const long L = (long)i * G + c; if (L >= nwg) return false; map((int)L, u); return true; }
};
struct SplitOrder {
    StaticOrder base;
    DI void init(int N, int G_, int c_, int ntk_) { base.init(TP, N, G_, c_, ntk_); }
    DI int total() const { return base.nwg + 16 * 4; }
    DI bool next(int i, Unit& u) const {
        const int L = i * base.G + base.c;
        if (L >= base.nwg + 64) return false;
        const bool sp = L >= base.nwg;
        Unit a; base.map(sp ? 0 : L, a);
        const int j = L - base.nwg, tile = j >> 2, s4 = j & 3, q = base.ntk >> 2;
        u.pm = sp ? (TP / BM + (tile >> 3)) : a.pm; u.pn = sp ? (tile & 7) : a.pn; u.nt = sp ? q : a.nt; u.k0 = sp ? s4 * q : 0; u.split = sp ? s4 : -1;
        return true;
    }
};

template <class Epi, class Sched>
DI void gemm_phase(LAS unsigned char* lds, const Gemm g, const Sched& S, const Epi& E) {
    const int tid = threadIdx.x, wid = __builtin_amdgcn_readfirstlane(tid >> 6), lane = tid & 63, wr = wid >> 2, wc = wid & 3, fr = lane & 15, fq = lane >> 4;
    const int K = g.K;
    unsigned voffA[2];
#pragma unroll
    for (int i = 0; i < 2; ++i) { int R, C; stage_rc(tid * 16 + i * 8192, R, C); voffA[i] = (unsigned)(R * K + C) * 2u; }
    const size_t kstep = (size_t)(BK * 2);
    const size_t hstep = (size_t)HALF * K * 2;
    const size_t tstep = 2 * hstep;
    const unsigned ldsw = (unsigned)wid * 1024u;
    const int aoff = lds_byte(wr * 64 + fr, fq * 8), boff = lds_byte(wc * 32 + fr, fq * 8);
#define PG8_SA(b, h) (((b) * 2 + (h)) * HTB)
#define PG8_SB(b, h) ((4 + (b) * 2 + (h)) * HTB)
#define PG8_STAGE(bufoff, gbase) do { _Pragma("unroll") for (int _i = 0; _i < 2; ++_i) \
        __builtin_amdgcn_global_load_lds((const unsigned*)((const char*)(gbase) + voffA[_i]), (LAS unsigned*)(lds + (bufoff) + ldsw + _i * 8192), 16, 0, 0); } while (0)
#define PG8_LDA(dst, b, h) do { _Pragma("unroll") for (int m = 0; m < 4; ++m) _Pragma("unroll") for (int k = 0; k < 2; ++k) dst[m][k] = *(const LAS bf16x8*)(lds + PG8_SA(b, h) + aoff + m * 2048 + k * 1024); } while (0)
#define PG8_LDB(dst, b, h) do { _Pragma("unroll") for (int n = 0; n < 2; ++n) _Pragma("unroll") for (int k = 0; k < 2; ++k) dst[n][k] = *(const LAS bf16x8*)(lds + PG8_SB(b, h) + boff + n * 2048 + k * 1024); } while (0)
#define PG8_MMA(ai, bj, At, Bt) do { __builtin_amdgcn_s_setprio(1); _Pragma("unroll") for (int m = 0; m < 4; ++m) _Pragma("unroll") for (int n = 0; n < 2; ++n) _Pragma("unroll") for (int k = 0; k < 2; ++k) \
        acc[ai][bj][m][n] = __builtin_amdgcn_mfma_f32_16x16x32_bf16(Bt[n][k], At[m][k], acc[ai][bj][m][n], 0, 0, 0); __builtin_amdgcn_s_setprio(0); } while (0)
#define PG8_WAIT_V(n) asm volatile("s_waitcnt vmcnt(" #n ")" ::: "memory")
#define PG8_WAIT_L(n) asm volatile("s_waitcnt lgkmcnt(" #n ")" ::: "memory")
#define PG8_BAR __builtin_amdgcn_s_barrier()
#define PG8_SCHED __builtin_amdgcn_sched_barrier(0)
    Unit cur, nxt; int ui = 0;
    if (!S.next(0, cur)) return;
    f32x4 acc[2][2][4][2];
#pragma unroll
    for (int a = 0; a < 2; ++a)
#pragma unroll
        for (int b = 0; b < 2; ++b)
#pragma unroll
            for (int m = 0; m < 4; ++m)
#pragma unroll
                for (int n = 0; n < 2; ++n) acc[a][b][m][n] = (f32x4){0.f, 0.f, 0.f, 0.f};
    bf16x8 At[4][2], B0[2][2], B1[2][2];
    const char* cA = (const char*)g.A + (size_t)cur.pm * tstep + (size_t)cur.k0 * kstep; const char* cB = (const char*)g.Bt + (size_t)cur.pn * tstep + (size_t)cur.k0 * kstep;
    PG8_STAGE(PG8_SB(0, 0), cB); PG8_STAGE(PG8_SA(0, 0), cA); PG8_STAGE(PG8_SB(0, 1), cB + hstep); PG8_STAGE(PG8_SA(0, 1), cA + hstep);
    if (wr == 1) PG8_BAR;
    PG8_WAIT_V(4); PG8_BAR;
    PG8_STAGE(PG8_SB(1, 0), cB + kstep); PG8_STAGE(PG8_SA(1, 0), cA + kstep); PG8_STAGE(PG8_SB(1, 1), cB + hstep + kstep);
    PG8_WAIT_V(6); PG8_BAR;
    for (;;) {
        const bool has_next = S.next(ui + 1, nxt);
        const char* nA = has_next ? (const char*)g.A + (size_t)nxt.pm * tstep + (size_t)nxt.k0 * kstep : cA; const char* nB = has_next ? (const char*)g.Bt + (size_t)nxt.pn * tstep + (size_t)nxt.k0 * kstep : cB;
        const int nt = cur.nt;
        for (int t = 0; t < nt; t += 2) {
            const bool last = (t == nt - 2);
            const char* a1 = cA + (size_t)(t + 1) * kstep;
            const char* a2 = last ? nA : cA + (size_t)(t + 2) * kstep; const char* b2 = last ? nB : cB + (size_t)(t + 2) * kstep;
            const char* a3 = a2 + kstep; const char* b3 = b2 + kstep;
            PG8_LDB(B0, 0, 0); PG8_SCHED; PG8_LDA(At, 0, 0); PG8_STAGE(PG8_SA(1, 1), a1 + hstep);
            PG8_WAIT_L(8); PG8_BAR; PG8_WAIT_L(0); PG8_MMA(0, 0, At, B0); PG8_BAR; PG8_SCHED;
            PG8_LDB(B1, 0, 1); PG8_STAGE(PG8_SB(0, 0), b2);
            PG8_BAR; PG8_WAIT_L(0); PG8_MMA(0, 1, At, B1); PG8_BAR;
            PG8_LDA(At, 0, 1); PG8_STAGE(PG8_SA(0, 0), a2);
            PG8_BAR; PG8_WAIT_L(0); PG8_MMA(1, 0, At, B0); PG8_BAR; PG8_SCHED;
            PG8_STAGE(PG8_SB(0, 1), b2 + hstep);
            PG8_WAIT_V(6); PG8_BAR; PG8_MMA(1, 1, At, B1); PG8_BAR;
            PG8_LDB(B0, 1, 0); PG8_SCHED; PG8_LDA(At, 1, 0); PG8_STAGE(PG8_SA(0, 1), a2 + hstep);
            PG8_WAIT_L(8); PG8_BAR; PG8_WAIT_L(0); PG8_MMA(0, 0, At, B0); PG8_BAR; PG8_SCHED;
            PG8_LDB(B1, 1, 1); PG8_STAGE(PG8_SB(1, 0), b3);
            PG8_BAR; PG8_WAIT_L(0); PG8_MMA(0, 1, At, B1); PG8_BAR;
            PG8_LDA(At, 1, 1); PG8_STAGE(PG8_SA(1, 0), a3);
            PG8_BAR; PG8_WAIT_L(0); PG8_MMA(1, 0, At, B0); PG8_BAR; PG8_SCHED;
            PG8_STAGE(PG8_SB(1, 1), b3 + hstep);
            PG8_WAIT_V(6); PG8_BAR; PG8_MMA(1, 1, At, B1); PG8_BAR;
        }
        E(acc, cur, wr, wc, fr, fq);
        if (!has_next) break;
#pragma unroll
        for (int a = 0; a < 2; ++a)
#pragma unroll
            for (int b = 0; b < 2; ++b)
#pragma unroll
                for (int m = 0; m < 4; ++m)
#pragma unroll
                    for (int n = 0; n < 2; ++n) acc[a][b][m][n] = (f32x4){0.f, 0.f, 0.f, 0.f};
        cur = nxt; cA = nA; cB = nB; ++ui;
    }
    PG8_WAIT_V(0);
    if (wr == 0) PG8_BAR;
    PG8_BAR;
#undef PG8_SA
#undef PG8_SB
#undef PG8_STAGE
#undef PG8_LDA
#undef PG8_LDB
#undef PG8_MMA
#undef PG8_WAIT_V
#undef PG8_WAIT_L
#undef PG8_BAR
#undef PG8_SCHED
}
}

typedef f32x4 AccT[2][2][4][2];

DI int src_col_in(int R) {
    const int pn = R >> 8, c = R & 255, bj = c >> 7, wc = (c >> 5) & 3, r5 = c & 31;
    if (pn < 8) return (4 * pn + wc) * 64 + 32 * bj + r5;
    if (pn == 8) return 2048 + wc * 64 + 32 * bj + r5;
    if (pn == 9) return 2304 + c;
    if (pn < 26) return (bj ? 6656 : 2560) + 128 * (pn - 10) + (c & 127);
    if (pn < 42) return (bj ? 10752 : 4608) + 128 * (pn - 26) + (c & 127);
    return 8704 + 256 * (pn - 42) + c;
}
DI int src_col_gu(int R) { const int t = R >> 8, c = R & 255; return ((c >> 7) ? DFF : 0) + 128 * t + (c & 127); }

DI unsigned bperm(int src4, unsigned v) { return (unsigned)__builtin_amdgcn_ds_bpermute(src4, (int)v); }
DI u32x2 perm2(int src4, u32x2 v) { u32x2 r; r.x = bperm(src4, v.x); r.y = bperm(src4, v.y); return r; }
DI f32x4 perm4(int src4, f32x4 v) { f32x4 r; r[0] = __uint_as_float(bperm(src4, __float_as_uint(v[0]))); r[1] = __uint_as_float(bperm(src4, __float_as_uint(v[1])));
    r[2] = __uint_as_float(bperm(src4, __float_as_uint(v[2]))); r[3] = __uint_as_float(bperm(src4, __float_as_uint(v[3]))); return r; }

struct Epi1 {
    bf16_t *Q, *Kb, *Vb, *U, *BG, *SGA; const float *qg, *kg, *cosT, *sinT; float* out;
    DI void side_kv(float* pwin, float* swin, int row, int col, f32x4 v) const {
        if (row >= TP - 128 && row < TP) *(f32x4*)(pwin + (size_t)(row - (TP - 128)) * 256 + col) = v;
        if (row >= TP) { const int b = (row - TP) >> 2, i = (row - TP) & 3; *(f32x4*)(swin + (size_t)b * 32768 + (size_t)(124 + i) * 256 + col) = v; }
    }
    DI void operator()(const AccT& acc, const pg8::Unit& u, int wr, int wc, int fr, int fq) const {
        asm volatile("" : "+v"(fr), "+v"(fq));
        const int lane = fr + 16 * fq, tr = lane >> 2, tq = lane & 3, src4 = (tr + 16 * tq) * 4;
        const int pn = u.pn, row0 = u.pm * 256 + wr * 64 + fr, rowT0 = u.pm * 256 + wr * 64 + tr;
        const bool side = u.pm >= 31;
        if (pn < 9) {
            const float* g = pn < 8 ? qg : kg;
            f32x4 gv[2][2];
#pragma unroll
            for (int bj = 0; bj < 2; ++bj)
#pragma unroll
                for (int n = 0; n < 2; ++n) gv[bj][n] = *(const f32x4*)(g + 32 * bj + 16 * n + 4 * fq);
#pragma unroll
            for (int aim = 0; aim < 4; ++aim) {
                const int ai = aim >> 1, mh = (aim & 1) * 2;
                f32x4 cs[4][2], sn[4][2];
#pragma unroll
                for (int m = mh; m < mh + 2; ++m) {
                    const int row = row0 + 128 * ai + 16 * m;
                    const int pos = row < TP ? row : TP + ((row - TP) & 3);
#pragma unroll
                    for (int n = 0; n < 2; ++n) { cs[m][n] = *(const f32x4*)(cosT + (size_t)pos * 32 + 16 * n + 4 * fq); sn[m][n] = *(const f32x4*)(sinT + (size_t)pos * 32 + 16 * n + 4 * fq); }
                }
#pragma unroll
                for (int m = mh; m < mh + 2; ++m) {
                    const int rowT = rowT0 + 128 * ai + 16 * m;
                    float ssq = 0.f;
#pragma unroll
                    for (int bj = 0; bj < 2; ++bj)
#pragma unroll
                        for (int n = 0; n < 2; ++n) { const f32x4 x = acc[ai][bj][m][n]; ssq += (x[0] * x[0] + x[1] * x[1]) + (x[2] * x[2] + x[3] * x[3]); }
                    ssq += __shfl_xor(ssq, 16); ssq += __shfl_xor(ssq, 32);
                    const float rs = __builtin_amdgcn_rsqf(ssq * (1.0f / 64.0f) + EPS);
#pragma unroll
                    for (int n = 0; n < 2; ++n) {
                        const f32x4 y1 = acc[ai][0][m][n] * rs * gv[0][n], y2 = acc[ai][1][m][n] * rs * gv[1][n];
                        const f32x4 o1 = y1 * cs[m][n] - y2 * sn[m][n], o2 = y2 * cs[m][n] + y1 * sn[m][n];
                        const int d = 16 * n + 4 * tq;
                        const u32x2 w1 = perm2(src4, pk4(o1)), w2 = perm2(src4, pk4(o2));
                        if (pn < 8) {
                            bf16_t* qp = Q + (size_t)rowT * DM + (4 * pn + wc) * 64 + d;
                            *(u32x2*)qp = w1; *(u32x2*)(qp + 32) = w2;
                        } else {
                            bf16_t* kp = Kb + (size_t)rowT * 256 + wc * 64 + d;
                            *(u32x2*)kp = w1; *(u32x2*)(kp + 32) = w2;
                            if (side) { const f32x4 t1 = perm4(src4, o1), t2 = perm4(src4, o2);
                                side_kv(out + O_PK, out + O_SK, rowT, wc * 64 + d, t1); side_kv(out + O_PK, out + O_SK, rowT, wc * 64 + d + 32, t2); }
                        }
                    }
                }
            }
        } else if (pn == 9) {
#pragma unroll
            for (int ai = 0; ai < 2; ++ai)
#pragma unroll
                for (int m = 0; m < 4; ++m) {
                    const int rowT = rowT0 + 128 * ai + 16 * m;
#pragma unroll
                    for (int bj = 0; bj < 2; ++bj)
#pragma unroll
                        for (int n = 0; n < 2; ++n) { const int col = 128 * bj + 32 * wc + 16 * n + 4 * tq; const f32x4 v = acc[ai][bj][m][n];
                            *(u32x2*)(Vb + (size_t)rowT * 256 + col) = perm2(src4, pk4(v));
                            if (side) side_kv(out + O_PV, out + O_SV, rowT, col, perm4(src4, v)); }
                }
        } else if (pn < 26) {
            const int t = pn - 10;
#pragma unroll
            for (int ai = 0; ai < 2; ++ai)
#pragma unroll
                for (int m = 0; m < 4; ++m) {
                    const int rowT = rowT0 + 128 * ai + 16 * m;
#pragma unroll
                    for (int n = 0; n < 2; ++n) { const int col = 128 * t + 32 * wc + 16 * n + 4 * tq; const f32x4 v = acc[ai][0][m][n] * acc[ai][1][m][n];
                        *(u32x2*)(U + (size_t)rowT * DM + col) = perm2(src4, pk4(v));
                        if (side) { const f32x4 vt = perm4(src4, v);
                            if (rowT >= TP - 2 && rowT < TP) *(f32x4*)(out + O_PC + (size_t)(rowT - (TP - 2)) * DM + col) = vt;
                            if (rowT >= TP && ((rowT - TP) & 3) >= 2) { const int b = (rowT - TP) >> 2, i = (rowT - TP) & 3; *(f32x4*)(out + O_SC + (size_t)b * 4096 + (size_t)(i - 2) * DM + col) = vt; } } }
                }
        } else if (pn < 42) {
            const int t = pn - 26;
#pragma unroll
            for (int ai = 0; ai < 2; ++ai)
#pragma unroll
                for (int m = 0; m < 4; ++m) {
                    const int rowT = rowT0 + 128 * ai + 16 * m;
#pragma unroll
                    for (int n = 0; n < 2; ++n) { const int col = 128 * t + 32 * wc + 16 * n + 4 * tq; const f32x4 b = acc[ai][0][m][n], gc = acc[ai][1][m][n];
                        f32x4 v; v[0] = b[0] * sigmoidf_(gc[0]); v[1] = b[1] * sigmoidf_(gc[1]); v[2] = b[2] * sigmoidf_(gc[2]); v[3] = b[3] * sigmoidf_(gc[3]);
                        *(u32x2*)(BG + (size_t)rowT * DM + col) = perm2(src4, pk4(v)); }
                }
        } else {
#pragma unroll
            for (int ai = 0; ai < 2; ++ai)
#pragma unroll
                for (int m = 0; m < 4; ++m) {
                    const int rowT = rowT0 + 128 * ai + 16 * m;
#pragma unroll
                    for (int bj = 0; bj < 2; ++bj)
#pragma unroll
                        for (int n = 0; n < 2; ++n) { const int col = 256 * (pn - 42) + 128 * bj + 32 * wc + 16 * n + 4 * tq; const f32x4 a = acc[ai][bj][m][n];
                            f32x4 v; v[0] = sigmoidf_(a[0]); v[1] = sigmoidf_(a[1]); v[2] = sigmoidf_(a[2]); v[3] = sigmoidf_(a[3]);
                            *(u32x2*)(SGA + (size_t)rowT * DM + col) = perm2(src4, pk4(v)); }
                }
        }
    }
};

DI void store_partial(float* PB, const AccT& acc, const pg8::Unit& u, int wr, int wc, int tr, int tq, int src4) {
    float* pb = PB + ((size_t)u.split * TS + (size_t)(u.pm * 256 - TP) + wr * 64 + tr) * DM + u.pn * 256 + wc * 32 + 4 * tq;
#pragma unroll
    for (int ai = 0; ai < 2; ++ai)
#pragma unroll
        for (int m = 0; m < 4; ++m)
#pragma unroll
            for (int bj = 0; bj < 2; ++bj)
#pragma unroll
                for (int n = 0; n < 2; ++n) *(f32x4*)(pb + (size_t)(128 * ai + 16 * m) * DM + 128 * bj + 16 * n) = perm4(src4, acc[ai][bj][m][n]);
}

struct Epi3 {
    const float *xp, *xs, *gffn; float* Y; bf16_t* A2; float* SSQ; float* PB;
    DI void operator()(const AccT& acc, const pg8::Unit& u, int wr, int wc, int fr, int fq) const {
        asm volatile("" : "+v"(fr), "+v"(fq));
        const int lane = fr + 16 * fq, tr = lane >> 2, tq = lane & 3, src4 = (tr + 16 * tq) * 4;
        if (u.split >= 0) { store_partial(PB, acc, u, wr, wc, tr, tq, src4); return; }
        const int rowT0 = u.pm * 256 + wr * 64 + tr, colT0 = u.pn * 256 + wc * 32 + 4 * tq;
        const float* xb = u.pm < 32 ? xp : xs - (size_t)TP * DM;
        f32x4 gv[2][2];
#pragma unroll
        for (int bj = 0; bj < 2; ++bj)
#pragma unroll
            for (int n = 0; n < 2; ++n) gv[bj][n] = *(const f32x4*)(gffn + colT0 + 128 * bj + 16 * n);
#pragma unroll
        for (int aim = 0; aim < 4; ++aim) {
            const int ai = aim >> 1, mh = (aim & 1) * 2;
            f32x4 xv[4][2][2];
#pragma unroll
            for (int m = mh; m < mh + 2; ++m)
#pragma unroll
                for (int bj = 0; bj < 2; ++bj)
#pragma unroll
                    for (int n = 0; n < 2; ++n) xv[m][bj][n] = *(const f32x4*)(xb + (size_t)(rowT0 + 128 * ai + 16 * m) * DM + colT0 + 128 * bj + 16 * n);
#pragma unroll
            for (int m = mh; m < mh + 2; ++m) {
                const int rowT = rowT0 + 128 * ai + 16 * m; float ssq = 0.f;
#pragma unroll
                for (int bj = 0; bj < 2; ++bj)
#pragma unroll
                    for (int n = 0; n < 2; ++n) { const size_t off = (size_t)rowT * DM + colT0 + 128 * bj + 16 * n;
                        const f32x4 y = xv[m][bj][n] + perm4(src4, acc[ai][bj][m][n]);
                        ssq += (y[0] * y[0] + y[1] * y[1]) + (y[2] * y[2] + y[3] * y[3]);
                        *(f32x4*)(Y + off) = y; *(u32x2*)(A2 + off) = pk4(y * gv[bj][n]); }
                ssq += __shfl_xor(ssq, 1); ssq += __shfl_xor(ssq, 2);
                if (tq == 0) SSQ[(size_t)rowT * 32 + u.pn * 4 + wc] = ssq;
            }
        }
    }
};

struct Epi4 {
    const float* SSQ; bf16_t* HID;
    DI void operator()(const AccT& acc, const pg8::Unit& u, int wr, int wc, int fr, int fq) const {
        asm volatile("" : "+v"(fr), "+v"(fq));
        const int lane = fr + 16 * fq, tr = lane >> 2, tq = lane & 3, src4 = (tr + 16 * tq) * 4;
        const int row0 = u.pm * 256 + wr * 64 + fr, rowT0 = u.pm * 256 + wr * 64 + tr, colT0 = u.pn * 128 + wc * 32 + 4 * tq;
#pragma unroll
        for (int ai = 0; ai < 2; ++ai) {
            f32x4 sp[4][2];
#pragma unroll
            for (int m = 0; m < 4; ++m) { const f32x4* q = (const f32x4*)(SSQ + (size_t)(row0 + 128 * ai + 16 * m) * 32 + 8 * fq); sp[m][0] = q[0]; sp[m][1] = q[1]; }
#pragma unroll
            for (int m = 0; m < 4; ++m) {
                const int rowT = rowT0 + 128 * ai + 16 * m;
                const f32x4 s4 = sp[m][0] + sp[m][1];
                float ss = (s4[0] + s4[1]) + (s4[2] + s4[3]);
                ss += __shfl_xor(ss, 16); ss += __shfl_xor(ss, 32);
                const float rstd = __builtin_amdgcn_rsqf(ss * (1.0f / DM) + EPS);
#pragma unroll
                for (int n = 0; n < 2; ++n) { const f32x4 g = acc[ai][0][m][n] * rstd, up = acc[ai][1][m][n] * rstd;
                    f32x4 h; h[0] = g[0] * sigmoidf_(g[0]) * up[0]; h[1] = g[1] * sigmoidf_(g[1]) * up[1]; h[2] = g[2] * sigmoidf_(g[2]) * up[2]; h[3] = g[3] * sigmoidf_(g[3]) * up[3];
                    *(u32x2*)(HID + (size_t)rowT * DFF + colT0 + 16 * n) = perm2(src4, pk4(h)); }
            }
        }
    }
};

struct Epi5 {
    float* Y; float* PB;
    DI void operator()(const AccT& acc, const pg8::Unit& u, int wr, int wc, int fr, int fq) const {
        asm volatile("" : "+v"(fr), "+v"(fq));
        const int lane = fr + 16 * fq, tr = lane >> 2, tq = lane & 3, src4 = (tr + 16 * tq) * 4;
        if (u.split >= 0) { store_partial(PB, acc, u, wr, wc, tr, tq, src4); return; }
        float* yb = Y + (size_t)(u.pm * 256 + wr * 64 + tr) * DM + u.pn * 256 + wc * 32 + 4 * tq;
        f32x4 cur[2][2], nxt[2][2];
#pragma unroll
        for (int bj = 0; bj < 2; ++bj)
#pragma unroll
            for (int n = 0; n < 2; ++n) cur[bj][n] = *(const f32x4*)(yb + 128 * bj + 16 * n);
#pragma unroll
        for (int k = 0; k < 8; ++k) {
            const int ai = k >> 2, m = k & 3;
            if (k < 7) { const int a2 = (k + 1) >> 2, m2 = (k + 1) & 3;
#pragma unroll
                for (int bj = 0; bj < 2; ++bj)
#pragma unroll
                    for (int n = 0; n < 2; ++n) nxt[bj][n] = *(const f32x4*)(yb + (size_t)(128 * a2 + 16 * m2) * DM + 128 * bj + 16 * n); }
#pragma unroll
            for (int bj = 0; bj < 2; ++bj)
#pragma unroll
                for (int n = 0; n < 2; ++n) *(f32x4*)(yb + (size_t)(128 * ai + 16 * m) * DM + 128 * bj + 16 * n) = cur[bj][n] + perm4(src4, acc[ai][bj][m][n]);
#pragma unroll
            for (int bj = 0; bj < 2; ++bj)
#pragma unroll
                for (int n = 0; n < 2; ++n) cur[bj][n] = nxt[bj][n];
        }
    }
};

DI void p0_transpose_item(const float* W, int K, int N, bf16_t* WT, int src_n0, int dst_n0, int k0, LAS float* scr, int lane) {
#pragma unroll 8
    for (int i = 0; i < 32; ++i) { const int kk = 2 * i + (lane >> 5); scr[kk * 33 + (lane & 31)] = W[(size_t)(k0 + kk) * N + src_n0 + (lane & 31)]; }
    asm volatile("s_waitcnt lgkmcnt(0)" ::: "memory");
    const int c = lane & 7;
#pragma unroll
    for (int j = 0; j < 4; ++j) { const int n = (lane >> 3) + 8 * j; const LAS float* s = scr + (8 * c) * 33 + n;
        u32x4 o; o.x = pk2(s[0 * 33], s[1 * 33]); o.y = pk2(s[2 * 33], s[3 * 33]); o.z = pk2(s[4 * 33], s[5 * 33]); o.w = pk2(s[6 * 33], s[7 * 33]);
        *(u32x4*)(WT + (size_t)(dst_n0 + n) * K + k0 + 8 * c) = o; }
    asm volatile("s_waitcnt lgkmcnt(0)" ::: "memory");
}

DI void p0_rest(const Params& p, LAS unsigned char* lds, int wid, int lane, int worker, int nworkers) {
    LAS float* scr = (LAS float*)(lds + wid * 8704);
    const int gw = worker * 8 + wid, NGW = nworkers * 8;
    bf16_t* WoutT = (bf16_t*)(p.ws + WS_WOUT); bf16_t* WguT = (bf16_t*)(p.ws + WS_WGU); bf16_t* WdnT = (bf16_t*)(p.ws + WS_WDN);
    constexpr int I_OUT = (DM / 64) * (DM / 32), I_GU = (DM / 64) * (NGU / 32), I_DN = (DFF / 64) * (DM / 32);
    for (int it = gw; it < I_OUT + I_GU + I_DN; it += NGW) {
        int r = it;
        if (r < I_OUT) { const int nblk = DM / 32, kb = r / nblk, nb = r % nblk; p0_transpose_item(p.w_out, DM, DM, WoutT, 32 * nb, 32 * nb, 64 * kb, scr, lane); continue; } r -= I_OUT;
        if (r < I_GU) { const int nblk = NGU / 32, kb = r / nblk, nb = r % nblk; p0_transpose_item(p.w_gu, DM, NGU, WguT, src_col_gu(32 * nb), 32 * nb, 64 * kb, scr, lane); continue; } r -= I_GU;
        { const int nblk = DM / 32, kb = r / nblk, nb = r % nblk; p0_transpose_item(p.w_dn, DFF, DM, WdnT, 32 * nb, 32 * nb, 64 * kb, scr, lane); }
    }
}

DI void p0_prologue(const Params& p, LAS unsigned char* lds, int wid, int lane) {
    LAS float* scr = (LAS float*)(lds + wid * 8704);
    const int gw = blockIdx.x * 8 + wid, NGW = gridDim.x * 8;
    bf16_t* WinT = (bf16_t*)(p.ws + WS_WIN);
    constexpr int I_IN = (DM / 64) * (DIN / 32);
    for (int it = gw; it < I_IN; it += NGW) { const int nblk = DIN / 32, kb = it / nblk, nb = it % nblk; p0_transpose_item(p.w_in, DM, DIN, WinT, src_col_in(32 * nb), 32 * nb, 64 * kb, scr, lane); }
    bf16_t* XN = (bf16_t*)(p.ws + WS_XN);
    for (int m = gw; m < MT; m += NGW) {
        const float* xrow = m < TP ? p.xp + (size_t)m * DM : p.xs + (size_t)(m - TP) * DM;
        const f32x4* xr = (const f32x4*)xrow + lane; f32x4 v[8]; float s = 0.f;
#pragma unroll
        for (int j = 0; j < 8; ++j) { v[j] = xr[64 * j]; s += (v[j][0] * v[j][0] + v[j][1] * v[j][1]) + (v[j][2] * v[j][2] + v[j][3] * v[j][3]); }
        const float rstd = 1.0f / sqrtf(wave_sum(s) * (1.0f / DM) + EPS);
        u32x2* o8 = (u32x2*)(XN + (size_t)m * DM) + lane;
#pragma unroll
        for (int j = 0; j < 8; ++j) { const f32x4 gv = ((const f32x4*)p.norm_mix)[64 * j + lane]; o8[64 * j] = pk4(v[j] * rstd * gv); }
    }
    float* cosT = (float*)(p.ws + WS_COS); float* sinT = (float*)(p.ws + WS_SIN);
    const int gt = blockIdx.x * 512 + threadIdx.x, GT = gridDim.x * 512;
    for (int idx = gt; idx < NPOS * 32; idx += GT) {
        const int pos = idx >> 5, i = idx & 31;
        const float inv = __builtin_amdgcn_exp2f(-(float)i * (13.287712379549449f / 32.0f));
        const float ang = (float)pos * inv;
        const double rev = (double)ang * 0.15915494309189535; const float fr = (float)(rev - __builtin_floor(rev));
        cosT[idx] = __builtin_amdgcn_cosf(fr); sinT[idx] = __builtin_amdgcn_sinf(fr);
    }
}

DI void cache_copy(const Params& p, int worker, int nworkers) {
    const int gt = worker * 512 + threadIdx.x, GT = nworkers * 512;
    for (int idx = gt; idx < 128 * 7936; idx += GT) {
        const int b = idx / 7936, e = idx - b * 7936;
        ((f32x4*)(p.out + O_SK + (size_t)b * 32768))[e] = ((const f32x4*)(p.ck + (size_t)b * 32768 + 1024))[e];
        ((f32x4*)(p.out + O_SV + (size_t)b * 32768))[e] = ((const f32x4*)(p.cv + (size_t)b * 32768 + 1024))[e];
    }
}

#define MFMA32(a, b, c) __builtin_amdgcn_mfma_f32_32x32x16_bf16((a), (b), (c), 0, 0, 0)
DI int crow(int reg, int h) { return (reg & 3) + 8 * (reg >> 2) + 4 * h; }
DI bf16x8 pack8(const f32x16& x, int s) {
    u32x4 p; p.x = pk2(x[8 * s], x[8 * s + 1]); p.y = pk2(x[8 * s + 2], x[8 * s + 3]); p.z = pk2(x[8 * s + 4], x[8 * s + 5]); p.w = pk2(x[8 * s + 6], x[8 * s + 7]);
    return __builtin_bit_cast(bf16x8, p);
}
DI bf16x8 cvt8(f32x4 a, f32x4 b) { u32x4 p; p.x = pk2(a[0], a[1]); p.y = pk2(a[2], a[3]); p.z = pk2(b[0], b[1]); p.w = pk2(b[2], b[3]); return __builtin_bit_cast(bf16x8, p); }

constexpr int KS_STRIDE = 72, VT_STRIDE = 260, VT_OFF = 256 * KS_STRIDE * 2;

template <bool SAMPLE>
DI void attn_chunk(const Params& p, LAS unsigned char* lds, int qb, int c, int kvh, int head_w, int b_s, int lane) {
    const bf16_t* Q = (const bf16_t*)(p.ws + WS_Q); const bf16_t* Kb = (const bf16_t*)(p.ws + WS_K); const bf16_t* Vb = (const bf16_t*)(p.ws + WS_V);
    const bf16_t* U = (const bf16_t*)(p.ws + WS_U); const bf16_t* BG = (const bf16_t*)(p.ws + WS_BG); const bf16_t* SGA = (const bf16_t*)(p.ws + WS_SGA);
    bf16_t* MIX = (bf16_t*)(p.ws + WS_MIX);
    const int r = lane & 31, g = lane >> 5;
    int tok, head, itok = 0;
    if (SAMPLE) { itok = r >> 3; head = kvh * 8 + (r & 7); tok = TP + 4 * b_s + itok; }
    else { head = head_w; tok = 128 * qb + 32 * c + r; }
    const LAS bf16_t* Ks = (const LAS bf16_t*)lds; const LAS bf16_t* Vt = (const LAS bf16_t*)(lds + VT_OFF);
    bf16x8 qf[4];
#pragma unroll
    for (int ks = 0; ks < 4; ++ks) qf[ks] = *(const bf16x8*)(Q + (size_t)tok * DM + head * 64 + 16 * ks + 8 * g);
    f32x16 s[5];
#pragma unroll
    for (int kbr = 0; kbr < 5; ++kbr) {
#pragma unroll
        for (int i = 0; i < 16; ++i) s[kbr][i] = 0.f;
#pragma unroll
        for (int ks = 0; ks < 4; ++ks) {
            bf16x8 a;
            if (SAMPLE) {
                if (kbr < 4) { const float* kp = p.ck + ((size_t)(b_s * 128 + 32 * kbr + r) * 4 + kvh) * 64 + 16 * ks + 8 * g; a = cvt8(*(const f32x4*)kp, *(const f32x4*)(kp + 4)); }
                else { u32x4 z = (u32x4){0u, 0u, 0u, 0u}; if (r < 4) z = *(const u32x4*)(Kb + (size_t)(TP + 4 * b_s + r) * 256 + kvh * 64 + 16 * ks + 8 * g); a = __builtin_bit_cast(bf16x8, z); }
            } else a = *(const LAS bf16x8*)(Ks + (32 * (c + kbr) + r) * KS_STRIDE + 16 * ks + 8 * g);
            s[kbr] = MFMA32(a, qf[ks], s[kbr]);
        }
    }
    const float sc = 0.125f * 1.44269504089f;
    const float sink2 = p.sinks[head] * 1.44269504089f;
    float mraw = -1e30f;
#pragma unroll
    for (int kbr = 0; kbr < 5; ++kbr)
#pragma unroll
        for (int i = 0; i < 16; ++i) {
            const int kr = crow(i, g); bool valid;
            if (SAMPLE) valid = kbr < 4 ? (32 * kbr + kr > itok) : (kr <= itok);
            else { valid = kbr == 0 ? (kr > r) : (kbr == 4 ? (kr <= r) : true); if (qb == 0 && c + kbr < 4) valid = false; }
            const float t = valid ? s[kbr][i] : -1e30f; s[kbr][i] = t; mraw = fmaxf(mraw, t);
        }
    mraw = fmaxf(mraw, __shfl_xor(mraw, 32));
    const float mx = fmaxf(mraw * sc, sink2);
    float sum = 0.f;
#pragma unroll
    for (int kbr = 0; kbr < 5; ++kbr)
#pragma unroll
        for (int i = 0; i < 16; ++i) { const float e = __builtin_amdgcn_exp2f(__builtin_fmaf(s[kbr][i], sc, -mx)); s[kbr][i] = e; sum += e; }
    sum += __shfl_xor(sum, 32);
    const float inv = 1.0f / (sum + __builtin_amdgcn_exp2f(sink2 - mx));
    f32x16 o[2];
#pragma unroll
    for (int dt = 0; dt < 2; ++dt)
#pragma unroll
        for (int i = 0; i < 16; ++i) o[dt][i] = 0.f;
#pragma unroll
    for (int kbr = 0; kbr < 5; ++kbr)
#pragma unroll
        for (int kk = 0; kk < 2; ++kk) {
            const bf16x8 pb = pack8(s[kbr], kk);
#pragma unroll
            for (int dt = 0; dt < 2; ++dt) {
                bf16x8 a; const int d = 32 * dt + r;
                if (SAMPLE) {
                    if (kbr < 4) { float f[8];
#pragma unroll
                        for (int j = 0; j < 8; ++j) { const int key = 32 * kbr + 16 * kk + 8 * (j >> 2) + 4 * g + (j & 3); f[j] = p.cv[((size_t)(b_s * 128 + key) * 4 + kvh) * 64 + d]; }
                        a = cvt8((f32x4){f[0], f[1], f[2], f[3]}, (f32x4){f[4], f[5], f[6], f[7]});
                    } else { u32x4 z = (u32x4){0u, 0u, 0u, 0u};
                        if (kk == 0 && g == 0) { const bf16_t* vp = Vb + (size_t)(TP + 4 * b_s) * 256 + kvh * 64 + d; z.x = (unsigned)vp[0] | ((unsigned)vp[256] << 16); z.y = (unsigned)vp[512] | ((unsigned)vp[768] << 16); }
                        a = __builtin_bit_cast(bf16x8, z); }
                } else {
                    const LAS bf16_t* vp = Vt + d * VT_STRIDE + 32 * (c + kbr) + 16 * kk + 4 * g;
                    const s16x4 lo = *(const LAS s16x4*)vp, hi = *(const LAS s16x4*)(vp + 8);
                    a = __builtin_shufflevector(lo, hi, 0, 1, 2, 3, 4, 5, 6, 7);
                }
                o[dt] = MFMA32(a, pb, o[dt]);
            }
        }
    if (!SAMPLE) {
#pragma unroll
        for (int dt = 0; dt < 2; ++dt)
#pragma unroll
            for (int i4 = 0; i4 < 4; ++i4) {
                const int col = head * 64 + 32 * dt + 8 * i4 + 4 * g;
                const f32x4 at = (f32x4){o[dt][4 * i4], o[dt][4 * i4 + 1], o[dt][4 * i4 + 2], o[dt][4 * i4 + 3]} * inv;
                *(u32x2*)(MIX + (size_t)tok * DM + col) = pk4(at);
            }
        return;
    }
#pragma unroll
    for (int dt = 0; dt < 2; ++dt) {
        u32x2 lsga[4], lbg[4], lu0[4]; f32x4 lu1[4], lu2[4], w0[4], w1[4], w2[4];
#pragma unroll
        for (int i4 = 0; i4 < 4; ++i4) {
            const int col = head * 64 + 32 * dt + 8 * i4 + 4 * g; const size_t off = (size_t)tok * DM + col;
            lsga[i4] = *(const u32x2*)(SGA + off); lbg[i4] = *(const u32x2*)(BG + off); lu0[i4] = *(const u32x2*)(U + off);
            lu1[i4] = itok >= 1 ? unpk4(*(const u32x2*)(U + off - DM)) : *(const f32x4*)(p.sconv + (size_t)b_s * 4096 + DM + col);
            lu2[i4] = itok >= 2 ? unpk4(*(const u32x2*)(U + off - 2 * DM)) : *(const f32x4*)(p.sconv + (size_t)b_s * 4096 + (size_t)itok * DM + col);
            w0[i4] = *(const f32x4*)(p.conv_w + col); w1[i4] = *(const f32x4*)(p.conv_w + DM + col); w2[i4] = *(const f32x4*)(p.conv_w + 2 * DM + col);
        }
#pragma unroll
        for (int i4 = 0; i4 < 4; ++i4) {
            const int col = head * 64 + 32 * dt + 8 * i4 + 4 * g; const size_t off = (size_t)tok * DM + col;
            const f32x4 at = (f32x4){o[dt][4 * i4], o[dt][4 * i4 + 1], o[dt][4 * i4 + 2], o[dt][4 * i4 + 3]} * inv;
            const f32x4 conv = w0[i4] * lu2[i4] + w1[i4] * lu1[i4] + w2[i4] * unpk4(lu0[i4]);
            *(u32x2*)(MIX + off) = pk4(unpk4(lsga[i4]) * at + unpk4(lbg[i4]) * conv);
        }
    }
}

DI void unpk8(u32x4 w, f32x4& lo, f32x4& hi) { lo = (f32x4){bf_lo(w.x), bf_hi(w.x), bf_lo(w.y), bf_hi(w.y)}; hi = (f32x4){bf_lo(w.z), bf_hi(w.z), bf_lo(w.w), bf_hi(w.w)}; }

constexpr int P2_CNT_OFF = 120000;
DI void p2_attention(const Params& p, LAS unsigned char* lds, int tid, int wid, int lane) {
    const bf16_t* Kb = (const bf16_t*)(p.ws + WS_K); const bf16_t* Vb = (const bf16_t*)(p.ws + WS_V);
    const bf16_t* U = (const bf16_t*)(p.ws + WS_U); const bf16_t* BG = (const bf16_t*)(p.ws + WS_BG); const bf16_t* SGA = (const bf16_t*)(p.ws + WS_SGA);
    bf16_t* MIX = (bf16_t*)(p.ws + WS_MIX);
    LAS bf16_t* Ks = (LAS bf16_t*)lds; LAS bf16_t* Vt = (LAS bf16_t*)(lds + VT_OFF);
    LAS unsigned* cnt = (LAS unsigned*)(lds + P2_CNT_OFF);
    int samp_next = blockIdx.x * 2;
    for (int item = blockIdx.x; item < 256; item += gridDim.x) {
        const int qb = item >> 2, kvh = item & 3;
        __syncthreads();
#pragma unroll
        for (int i = 0; i < 4; ++i) {
            const int e = tid + 512 * i, row = e >> 3, c8 = e & 7, tok = 128 * (qb - 1) + row;
            u32x4 kv = (u32x4){0u, 0u, 0u, 0u}, vv = (u32x4){0u, 0u, 0u, 0u};
            if (tok >= 0) { kv = *(const u32x4*)(Kb + (size_t)tok * 256 + kvh * 64 + 8 * c8); vv = *(const u32x4*)(Vb + (size_t)tok * 256 + kvh * 64 + 8 * c8); }
            *(LAS u32x4*)(Ks + row * KS_STRIDE + 8 * c8) = kv;
#pragma unroll
            for (int jj = 0; jj < 8; ++jj) Vt[(8 * c8 + jj) * VT_STRIDE + row] = (bf16_t)(vv[jj >> 1] >> (16 * (jj & 1)));
        }
        if (tid == 0) *cnt = 0u;
        __syncthreads();
        const int ns = (samp_next < 512) ? ((samp_next + 1 < 512) ? 2 : 1) : 0;
        for (;;) {
            unsigned t = 0; if (lane == 0) t = __hip_atomic_fetch_add(cnt, 1u, __ATOMIC_RELAXED, __HIP_MEMORY_SCOPE_WORKGROUP);
            t = __builtin_amdgcn_readfirstlane(t);
            if ((int)t >= ns + 32) break;
            if ((int)t < ns) { const int it = samp_next + (int)t; attn_chunk<true>(p, lds, 0, 0, it & 3, 0, it >> 2, lane); }
            else { const int pc = (int)t - ns; attn_chunk<false>(p, lds, qb, pc & 3, kvh, kvh * 8 + (pc >> 2), 0, lane); }
        }
        samp_next += gridDim.x * 2;
        asm volatile("s_waitcnt vmcnt(0)" ::: "memory");
        __syncthreads();
        __builtin_amdgcn_fence(__ATOMIC_ACQUIRE, "agent");
        {
            const int c8 = tid & 63, rbase = tid >> 6, col = kvh * 512 + 8 * c8;
            f32x4 w[3][2];
#pragma unroll
            for (int k = 0; k < 3; ++k) { w[k][0] = *(const f32x4*)(p.conv_w + k * DM + col); w[k][1] = *(const f32x4*)(p.conv_w + k * DM + col + 4); }
#pragma unroll
            for (int ib = 0; ib < 4; ++ib) {
                u32x4 la[4], ls[4], lb[4], l0[4], l1[4], l2[4];
#pragma unroll
                for (int ii = 0; ii < 4; ++ii) {
                    const int tok = 128 * qb + rbase + 8 * (4 * ib + ii); const size_t off = (size_t)tok * DM + col;
                    la[ii] = *(const u32x4*)(MIX + off); ls[ii] = *(const u32x4*)(SGA + off); lb[ii] = *(const u32x4*)(BG + off); l0[ii] = *(const u32x4*)(U + off);
                    l1[ii] = (u32x4){0u, 0u, 0u, 0u}; l2[ii] = (u32x4){0u, 0u, 0u, 0u};
                    if (tok >= 1) l1[ii] = *(const u32x4*)(U + off - DM);
                    if (tok >= 2) l2[ii] = *(const u32x4*)(U + off - 2 * DM);
                }
#pragma unroll
                for (int ii = 0; ii < 4; ++ii) {
                    const int tok = 128 * qb + rbase + 8 * (4 * ib + ii); const size_t off = (size_t)tok * DM + col;
                    f32x4 a0, a1, s0, s1, b0, b1, x0, x1, y0, y1, z0, z1;
                    unpk8(la[ii], a0, a1); unpk8(ls[ii], s0, s1); unpk8(lb[ii], b0, b1); unpk8(l0[ii], x0, x1); unpk8(l1[ii], y0, y1); unpk8(l2[ii], z0, z1);
                    const f32x4 m0 = s0 * a0 + b0 * (w[0][0] * z0 + w[1][0] * y0 + w[2][0] * x0);
                    const f32x4 m1 = s1 * a1 + b1 * (w[0][1] * z1 + w[1][1] * y1 + w[2][1] * x1);
                    u32x4 o; o.x = pk2(m0[0], m0[1]); o.y = pk2(m0[2], m0[3]); o.z = pk2(m1[0], m1[1]); o.w = pk2(m1[2], m1[3]);
                    *(u32x4*)(MIX + off) = o;
                }
            }
        }
    }
    for (int it = samp_next + (wid & 1); it < 512 && wid < 2; it += gridDim.x * 2) attn_chunk<true>(p, lds, 0, 0, it & 3, 0, it >> 2, lane);
}

DI void p3_reduce(const Params& p, int wid, int lane) {
    const float* PB = (const float*)(p.ws + WS_PB); bf16_t* A2 = (bf16_t*)(p.ws + WS_A2); float* SSQ = (float*)(p.ws + WS_SSQ);
    for (int r = blockIdx.x * 8 + wid; r < TS; r += gridDim.x * 8) {
        const int row = TP + r; f32x4 y[8]; float s = 0.f;
#pragma unroll
        for (int j = 0; j < 8; ++j) { const size_t o = (size_t)r * DM + 256 * j + 4 * lane;
            y[j] = *(const f32x4*)(p.xs + o) + ((*(const f32x4*)(PB + o) + *(const f32x4*)(PB + (size_t)TS * DM + o)) + (*(const f32x4*)(PB + (size_t)2 * TS * DM + o) + *(const f32x4*)(PB + (size_t)3 * TS * DM + o)));
            s += (y[j][0] * y[j][0] + y[j][1] * y[j][1]) + (y[j][2] * y[j][2] + y[j][3] * y[j][3]); }
        s = wave_sum(s);
#pragma unroll
        for (int j = 0; j < 8; ++j) { const int col = 256 * j + 4 * lane; *(f32x4*)(p.out + (size_t)row * DM + col) = y[j];
            *(u32x2*)(A2 + (size_t)row * DM + col) = pk4(y[j] * *(const f32x4*)(p.norm_ffn + col)); }
        if (lane < 32) SSQ[(size_t)row * 32 + lane] = lane == 0 ? s : 0.f;
    }
}
DI void p5_reduce(const Params& p) {
    const float* PB = (const float*)(p.ws + WS_PB);
    for (int i = blockIdx.x * 512 + threadIdx.x; i < TS * DM / 4; i += gridDim.x * 512) { const size_t o = (size_t)i * 4; float* yp = p.out + (size_t)TP * DM + o;
        *(f32x4*)yp = *(const f32x4*)yp + ((*(const f32x4*)(PB + o) + *(const f32x4*)(PB + (size_t)TS * DM + o)) + (*(const f32x4*)(PB + (size_t)2 * TS * DM + o) + *(const f32x4*)(PB + (size_t)3 * TS * DM + o))); }
}

constexpr int LDS_BYTES = pg8::STAGE_BYTES + 16;

__global__ void __launch_bounds__(512, 2) fwd_megakernel(Params p) {
    extern __shared__ __attribute__((aligned(16))) unsigned char lds_raw[];
    LAS unsigned char* lds = (LAS unsigned char*)lds_raw;
    cg::grid_group grid = cg::this_grid();
    if (p.never) grid.sync();
    if (threadIdx.x < 4) ((LAS unsigned*)(lds + pg8::STAGE_BYTES))[threadIdx.x] = 0u;
    __syncthreads();
    const XcdBarrier xb = xcd_barrier_post((unsigned*)(p.ws + WS_BAR), (volatile LAS unsigned*)(lds + pg8::STAGE_BYTES));
    const int tid = threadIdx.x, wid = __builtin_amdgcn_readfirstlane(tid >> 6), lane = tid & 63;
    const int G = gridDim.x, bid = blockIdx.x;
    unsigned char* ws = p.ws;

    p0_prologue(p, lds, wid, lane);
    xcd_barrier(xb);
    {
        pg8::Gemm g{(const bf16_t*)(ws + WS_XN), (const bf16_t*)(ws + WS_WIN), MT, DIN, DM}; pg8::StaticOrder S; S.init(MT, DIN, G, bid);
        Epi1 E{(bf16_t*)(ws + WS_Q), (bf16_t*)(ws + WS_K), (bf16_t*)(ws + WS_V), (bf16_t*)(ws + WS_U), (bf16_t*)(ws + WS_BG), (bf16_t*)(ws + WS_SGA),
               p.q_norm, p.k_norm, (const float*)(ws + WS_COS), (const float*)(ws + WS_SIN), p.out};
        pg8::gemm_phase<Epi1, pg8::StaticOrder>(lds, g, S, E);
        {
            const int nfull = ((MT / 256) * (DIN / 256)) % G;
            if (nfull == 0) p0_rest(p, lds, wid, lane, bid, G);
            else if (bid >= nfull) p0_rest(p, lds, wid, lane, bid - nfull, G - nfull);
        }
    }
    xcd_barrier(xb);
    p2_attention(p, lds, tid, wid, lane);
    xcd_barrier(xb);
    {
        pg8::Gemm g{(const bf16_t*)(ws + WS_MIX), (const bf16_t*)(ws + WS_WOUT), MT, DM, DM}; pg8::SplitOrder S; S.init(DM, G, bid, DM / 64);
        Epi3 E{p.xp, p.xs, p.norm_ffn, p.out, (bf16_t*)(ws + WS_A2), (float*)(ws + WS_SSQ), (float*)(ws + WS_PB)};
        pg8::gemm_phase<Epi3, pg8::SplitOrder>(lds, g, S, E);
        {   const int nfull = S.total() % G;
            if (nfull == 0) cache_copy(p, bid, G); else if (bid >= nfull) cache_copy(p, bid - nfull, G - nfull);
        }
    }
    xcd_barrier(xb);
    p3_reduce(p, wid, lane);
    xcd_barrier(xb);
    {
        pg8::Gemm g{(const bf16_t*)(ws + WS_A2), (const bf16_t*)(ws + WS_WGU), MT, NGU, DM}; pg8::StaticOrder S; S.init(MT, NGU, G, bid);
        Epi4 E{(const float*)(ws + WS_SSQ), (bf16_t*)(ws + WS_HID)};
        pg8::gemm_phase<Epi4, pg8::StaticOrder>(lds, g, S, E);
    }
    xcd_barrier(xb);
    {
        pg8::Gemm g{(const bf16_t*)(ws + WS_HID), (const bf16_t*)(ws + WS_WDN), MT, DM, DFF}; pg8::SplitOrder S; S.init(DM, G, bid, DFF / 64);
        Epi5 E{p.out, (float*)(ws + WS_PB)};
        pg8::gemm_phase<Epi5, pg8::SplitOrder>(lds, g, S, E);
    }
    xcd_barrier(xb);
    p5_reduce(p);
}

extern "C" void kernel_launch(void* const* d_in, const int* in_sizes, int n_in, void* d_out, int out_size, void* d_ws, size_t ws_size, hipStream_t stream) {
    static int grid = 0;
    if (!grid) {
        int dev = 0, cus = 0, per_cu = 0;
        (void)hipGetDevice(&dev);
        (void)hipDeviceGetAttribute(&cus, hipDeviceAttributeMultiprocessorCount, dev);
        (void)hipFuncSetAttribute((const void*)fwd_megakernel, hipFuncAttributeMaxDynamicSharedMemorySize, LDS_BYTES);
        (void)hipOccupancyMaxActiveBlocksPerMultiprocessor(&per_cu, (const void*)fwd_megakernel, 512, LDS_BYTES);
        if (per_cu < 1) per_cu = 1;
        grid = cus * per_cu;
        if (ws_size < WS_END) fprintf(stderr, "kernel_launch: workspace too small (%zu < %zu)\n", ws_size, (size_t)WS_END);
    }
    Params p{};
    p.xp = (const float*)d_in[0]; p.xs = (const float*)d_in[1]; p.ck = (const float*)d_in[2]; p.cv = (const float*)d_in[3]; p.sconv = (const float*)d_in[4];
    p.norm_mix = (const float*)d_in[5]; p.w_in = (const float*)d_in[6]; p.q_norm = (const float*)d_in[7]; p.k_norm = (const float*)d_in[8]; p.sinks = (const float*)d_in[9];
    p.conv_w = (const float*)d_in[10]; p.w_out = (const float*)d_in[11]; p.norm_ffn = (const float*)d_in[12]; p.w_gu = (const float*)d_in[13]; p.w_dn = (const float*)d_in[14];
    p.out = (float*)d_out; p.ws = (unsigned char*)d_ws;
    p.never = 0;
    (void)hipMemsetAsync((char*)d_ws + WS_BAR, 0, 16384, stream);
    void* args[] = {&p};
    hipError_t e = hipLaunchCooperativeKernel((const void*)fwd_megakernel, dim3(grid), dim3(512), args, LDS_BYTES, stream);
    if (e != hipSuccess) fprintf(stderr, "cooperative launch failed: %s (grid %d)\n", hipGetErrorString(e), grid);
}
```

```cpp
#include <hip/hip_runtime.h>
#include <hip/hip_cooperative_groups.h>
#include <cstdio>
namespace cg = cooperative_groups;
#define REP_P0 1
#define REP_P1 1
#define REP_P2 1
#define REP_P3 1
#define REP_P4 1
#define REP_SYNC 0

#define LAS __attribute__((address_space(3)))
#define DI __device__ __forceinline__
typedef unsigned short bf16_t;
typedef short bf16x8 __attribute__((ext_vector_type(8)));
typedef short s16x4 __attribute__((ext_vector_type(4)));
typedef float f32x4 __attribute__((ext_vector_type(4)));
typedef float f32x16 __attribute__((ext_vector_type(16)));
typedef unsigned u32x4 __attribute__((ext_vector_type(4)));
typedef unsigned u32x2 __attribute__((ext_vector_type(2)));

constexpr int DM = 2048, TP = 8192, TS = 512, MT = TP + TS, DIN = 12800, DFF = 5632, NGU = 2 * DFF;
constexpr float EPS = 1e-6f;
constexpr int NPOS = 8196;
constexpr size_t O_YP = 0, O_YS = (size_t)TP * DM, O_PK = O_YS + (size_t)TS * DM, O_PV = O_PK + 32768, O_PC = O_PV + 32768,
                 O_SK = O_PC + 4096, O_SV = O_SK + 4194304, O_SC = O_SV + 4194304;
constexpr size_t WS_WIN = 0, WS_WOUT = WS_WIN + (size_t)DIN * DM * 2, WS_WGU = WS_WOUT + (size_t)DM * DM * 2, WS_WDN = WS_WGU + (size_t)NGU * DM * 2,
                 WS_XN = WS_WDN + (size_t)DM * DFF * 2, WS_Q = WS_XN + (size_t)MT * DM * 2, WS_K = WS_Q + (size_t)MT * DM * 2, WS_V = WS_K + (size_t)MT * 256 * 2,
                 WS_U = WS_V + (size_t)MT * 256 * 2, WS_BG = WS_U + (size_t)MT * DM * 2, WS_SGA = WS_BG + (size_t)MT * DM * 2, WS_COS = WS_SGA + (size_t)MT * DM * 2,
                 WS_SIN = WS_COS + (size_t)NPOS * 32 * 4, WS_SSQ = WS_SIN + (size_t)NPOS * 32 * 4, WS_BAR = WS_SSQ + (size_t)MT * 32 * 4, WS_RSTD = WS_BAR + 16384, WS_PB = WS_RSTD + 65536, WS_END = WS_PB + (size_t)4 * TS * DM * 4;
constexpr size_t WS_MIX = WS_XN, WS_A2 = WS_Q, WS_HID = WS_U;
static_assert((size_t)MT * DFF * 2 <= 3 * (size_t)MT * DM * 2, "hidden fits in U|BG|SGA");

struct Params {
    const float *xp, *xs, *ck, *cv, *sconv, *norm_mix, *w_in, *q_norm, *k_norm, *sinks, *conv_w, *w_out, *norm_ffn, *w_gu, *w_dn;
    float* out; unsigned char* ws; long never;
};

typedef float f32x2 __attribute__((ext_vector_type(2)));
typedef __bf16 bf16x2v __attribute__((ext_vector_type(2)));
DI unsigned pk2(float lo, float hi) { const f32x2 f = {lo, hi}; return __builtin_bit_cast(unsigned, __builtin_convertvector(f, bf16x2v)); }
DI u32x2 pk4(f32x4 v) { u32x2 r; r.x = pk2(v[0], v[1]); r.y = pk2(v[2], v[3]); return r; }
DI float bf_lo(unsigned w) { return __uint_as_float(w << 16); }
DI float bf_hi(unsigned w) { return __uint_as_float(w & 0xffff0000u); }
DI f32x4 unpk4(u32x2 w) { return (f32x4){bf_lo(w.x), bf_hi(w.x), bf_lo(w.y), bf_hi(w.y)}; }
DI float sigmoidf_(float x) { return __builtin_amdgcn_rcpf(1.0f + __builtin_amdgcn_exp2f(-1.44269504089f * x)); }
DI float wave_sum(float v) {
#pragma unroll
    for (int o = 1; o < 64; o <<= 1) v += __shfl_xor(v, o);
    return v;
}


#define XB_TMO      128
#define XB_XCNT(j)  (256  + 64 * (j))
#define XB_XSUB(j)  (1280 + 64 * (j))
#define XB_XGEN(j)  (2304 + 64 * (j))
#define XB_TOP      3328
#define XB_TOPGEN   3392
#define XCD_BAR_WORDS 3456
#define XB_SPIN_CAP (1u << 20)
DI unsigned xb_ld(unsigned* p)              { return __hip_atomic_load(p, __ATOMIC_RELAXED, __HIP_MEMORY_SCOPE_AGENT); }
DI unsigned xb_add(unsigned* p, unsigned v) { return __hip_atomic_fetch_add(p, v, __ATOMIC_RELAXED, __HIP_MEMORY_SCOPE_AGENT); }
DI unsigned xb_xcc_id() { return (unsigned)__builtin_amdgcn_s_getreg((3 << 11) | 20) & 0xFu; }
#define XB_SPIN(cond, bar) do { unsigned _sp = 0; while (cond) { __builtin_amdgcn_s_sleep(1); \
    if ((++_sp & 255u) == 0u) { if (xb_ld(&(bar)[XB_TMO])) break; if (_sp > XB_SPIN_CAP) { atomicAdd(&(bar)[XB_TMO], 1u); break; } } } } while (0)
struct XcdBarrier { unsigned* bar; unsigned x; volatile LAS unsigned* st; };
DI XcdBarrier xcd_barrier_post(unsigned* bar, volatile LAS unsigned* st) {
    XcdBarrier b; b.bar = bar; b.x = xb_xcc_id(); b.st = st;
    if (threadIdx.x == 0) (void)xb_add(&bar[XB_XCNT(b.x)], 1u);
    return b;
}
DI void xcd_barrier_complete(unsigned* bar, unsigned x, unsigned& nloc, unsigned& nx) {
    const unsigned G = gridDim.x * gridDim.y * gridDim.z;
    unsigned sum, cnt, mine, sp = 0u;
    for (;;) {
        sum = 0u; cnt = 0u; mine = 0u;
#pragma unroll
        for (unsigned j = 0; j < 16; ++j) { const unsigned c = xb_ld(&bar[XB_XCNT(j)]); sum += c; cnt += (c > 0u) ? 1u : 0u; mine = (j == x) ? c : mine; }
        if (sum == G) break;
        __builtin_amdgcn_s_sleep(1);
        if ((++sp & 255u) == 0u) { if (xb_ld(&bar[XB_TMO])) break; if (sp > XB_SPIN_CAP) { atomicAdd(&bar[XB_TMO], 1u); break; } }
    }
    nloc = mine > 0u ? mine : 1u; nx = cnt > 0u ? cnt : 1u;
}
DI void xcd_barrier(const XcdBarrier& b) {
    asm volatile("s_waitcnt vmcnt(0)" ::: "memory");
    __syncthreads();
    if (threadIdx.x == 0) {
        unsigned* bar = b.bar;
        __builtin_amdgcn_s_waitcnt(0);
        unsigned nloc = b.st[0], nx = b.st[1];
        if (nloc == 0u) { xcd_barrier_complete(bar, b.x, nloc, nx); b.st[0] = nloc; b.st[1] = nx; }
        const unsigned old = xb_add(&bar[XB_XSUB(b.x)], 1u);
        const unsigned gen = old / nloc;
        if (old + 1u == (gen + 1u) * nloc) {
            __builtin_amdgcn_fence(__ATOMIC_RELEASE, "agent");
            asm volatile("s_waitcnt vmcnt(0)" ::: "memory");
            const unsigned og = xb_add(&bar[XB_TOP], 1u);
            const unsigned tg = og / nx;
            if (og + 1u == (tg + 1u) * nx) xb_add(&bar[XB_TOPGEN], 1u);
            else XB_SPIN(xb_ld(&bar[XB_TOPGEN]) == tg, bar);
            __builtin_amdgcn_fence(__ATOMIC_ACQUIRE, "agent");
            xb_add(&bar[XB_XGEN(b.x)], 1u);
            asm volatile("s_waitcnt vmcnt(0)" ::: "memory");
        } else {
            XB_SPIN(xb_ld(&bar[XB_XGEN(b.x)]) == gen, bar);
            __builtin_amdgcn_fence(__ATOMIC_ACQUIRE, "agent");
            asm volatile("s_waitcnt vmcnt(0)" ::: "memory");
        }
    }
    __syncthreads();
}

namespace pg8 {
constexpr int BM = 256, BK = 64, HALF = 128, HTB = HALF * BK * 2, STAGE_BYTES = 8 * HTB, NXCD = 8, WGM = 8;
DI int lds_byte(int r, int c) { const int st = (r >> 4) * 2 + (c >> 5), rr = r & 15, cc = c & 31, ob = rr * 64 + cc * 2; return st * 1024 + (ob ^ (((ob >> 9) & 1) << 5)); }
DI void stage_rc(int b, int& R, int& C) { const int st = b / 1024, sb = b % 1024, swz = sb ^ (((sb >> 9) & 1) << 5); R = (st >> 1) * 16 + swz / 64; C = (st & 1) * 32 + (swz % 64) / 2; }
struct Unit { int pm, pn, k0, nt, split; };
struct Gemm { const bf16_t* A; const bf16_t* Bt; int M, N, K; };
struct StaticOrder {
    int nM, nN, nwg, G, c, ntk;
    DI void init(int M, int N, int G_, int c_, int ntk_ = 32) { nM = M / BM; nN = N / BM; nwg = nM * nN; G = G_; c = c_; ntk = ntk_; }
    DI void map(int L, Unit& u) const {
        int wgid = L; { const int q = nwg / NXCD, r = nwg % NXCD, xcd = wgid % NXCD, off = wgid / NXCD; wgid = (xcd < r ? xcd * (q + 1) : r * (q + 1) + (xcd - r) * q) + off; }
        const int nig = WGM * nN, gid = wgid / nig, fm = gid * WGM, gsz = (nM - fm) < WGM ? (nM - fm) : WGM;
        u.pm = fm + ((wgid % nig) % gsz); u.pn = (wgid % nig) / gsz; u.k0 = 0; u.nt = ntk; u.split = -1;
    }
    DI bool next(int i, Unit& u) const { const long L = (long)i * G + c; if (L >= nwg) return false; map((int)L, u); return true; }
};
struct SplitOrder {
    StaticOrder base;
    DI void init(int N, int G_, int c_, int ntk_) { base.init(TP, N, G_, c_, ntk_); }
    DI int total() const { return base.nwg + 16 * 4; }
    DI bool next(int i, Unit& u) const {
        const int L = i * base.G + base.c;
        if (L >= base.nwg + 64) return false;
        const bool sp = L >= base.nwg;
        Unit a; base.map(sp ? 0 : L, a);
        const int j = L - base.nwg, tile = j >> 2, s4 = j & 3, q = base.ntk >> 2;
        u.pm = sp ? (TP / BM + (tile >> 3)) : a.pm; u.pn = sp ? (tile & 7) : a.pn; u.nt = sp ? q : a.nt; u.k0 = sp ? s4 * q : 0; u.split = sp ? s4 : -1;
        return true;
    }
};

template <class Epi, class Sched>
DI void gemm_phase(LAS unsigned char* lds, const Gemm g, const Sched& S, const Epi& E) {
    const int tid = threadIdx.x, wid = __builtin_amdgcn_readfirstlane(tid >> 6), lane = tid & 63, wr = wid >> 2, wc = wid & 3, fr = lane & 15, fq = lane >> 4;
    const int K = g.K;
    unsigned voffA[2];
#pragma unroll
    for (int i = 0; i < 2; ++i) { int R, C; stage_rc(tid * 16 + i * 8192, R, C); voffA[i] = (unsigned)(R * K + C) * 2u; }
    const size_t kstep = (size_t)(BK * 2);
    const size_t hstep = (size_t)HALF * K * 2;
    const size_t tstep = 2 * hstep;
    const unsigned ldsw = (unsigned)wid * 1024u;
    const int aoff = lds_byte(wr * 64 + fr, fq * 8), boff = lds_byte(wc * 32 + fr, fq * 8);
#define PG8_SA(b, h) (((b) * 2 + (h)) * HTB)
#define PG8_SB(b, h) ((4 + (b) * 2 + (h)) * HTB)
#define PG8_STAGE(bufoff, gbase) do { _Pragma("unroll") for (int _i = 0; _i < 2; ++_i) \
        __builtin_amdgcn_global_load_lds((const unsigned*)((const char*)(gbase) + voffA[_i]), (LAS unsigned*)(lds + (bufoff) + ldsw + _i * 8192), 16, 0, 0); } while (0)
#define PG8_LDA(dst, b, h) do { _Pragma("unroll") for (int m = 0; m < 4; ++m) _Pragma("unroll") for (int k = 0; k < 2; ++k) dst[m][k] = *(const LAS bf16x8*)(lds + PG8_SA(b, h) + aoff + m * 2048 + k * 1024); } while (0)
#define PG8_LDB(dst, b, h) do { _Pragma("unroll") for (int n = 0; n < 2; ++n) _Pragma("unroll") for (int k = 0; k < 2; ++k) dst[n][k] = *(const LAS bf16x8*)(lds + PG8_SB(b, h) + boff + n * 2048 + k * 1024); } while (0)
#define PG8_MMA(ai, bj, At, Bt) do { __builtin_amdgcn_s_setprio(1); _Pragma("unroll") for (int m = 0; m < 4; ++m) _Pragma("unroll") for (int n = 0; n < 2; ++n) _Pragma("unroll") for (int k = 0; k < 2; ++k) \
        acc[ai][bj][m][n] = __builtin_amdgcn_mfma_f32_16x16x32_bf16(Bt[n][k], At[m][k], acc[ai][bj][m][n], 0, 0, 0); __builtin_amdgcn_s_setprio(0); } while (0)
#define PG8_WAIT_V(n) asm volatile("s_waitcnt vmcnt(" #n ")" ::: "memory")
#define PG8_WAIT_L(n) asm volatile("s_waitcnt lgkmcnt(" #n ")" ::: "memory")
#define PG8_BAR __builtin_amdgcn_s_barrier()
#define PG8_SCHED __builtin_amdgcn_sched_barrier(0)
    Unit cur, nxt; int ui = 0;
    if (!S.next(0, cur)) return;
    f32x4 acc[2][2][4][2];
#pragma unroll
    for (int a = 0; a < 2; ++a)
#pragma unroll
        for (int b = 0; b < 2; ++b)
#pragma unroll
            for (int m = 0; m < 4; ++m)
#pragma unroll
                for (int n = 0; n < 2; ++n) acc[a][b][m][n] = (f32x4){0.f, 0.f, 0.f, 0.f};
    bf16x8 At[4][2], B0[2][2], B1[2][2];
    const char* cA = (const char*)g.A + (size_t)cur.pm * tstep + (size_t)cur.k0 * kstep; const char* cB = (const char*)g.Bt + (size_t)cur.pn * tstep + (size_t)cur.k0 * kstep;
    PG8_STAGE(PG8_SB(0, 0), cB); PG8_STAGE(PG8_SA(0, 0), cA); PG8_STAGE(PG8_SB(0, 1), cB + hstep); PG8_STAGE(PG8_SA(0, 1), cA + hstep);
    if (wr == 1) PG8_BAR;
    PG8_WAIT_V(4); PG8_BAR;
    PG8_STAGE(PG8_SB(1, 0), cB + kstep); PG8_STAGE(PG8_SA(1, 0), cA + kstep); PG8_STAGE(PG8_SB(1, 1), cB + hstep + kstep);
    PG8_WAIT_V(6); PG8_BAR;
    for (;;) {
        const bool has_next = S.next(ui + 1, nxt);
        const char* nA = has_next ? (const char*)g.A + (size_t)nxt.pm * tstep + (size_t)nxt.k0 * kstep : cA; const char* nB = has_next ? (const char*)g.Bt + (size_t)nxt.pn * tstep + (size_t)nxt.k0 * kstep : cB;
        const int nt = cur.nt;
        for (int t = 0; t < nt; t += 2) {
            const bool last = (t == nt - 2);
            const char* a1 = cA + (size_t)(t + 1) * kstep;
            const char* a2 = last ? nA : cA + (size_t)(t + 2) * kstep; const char* b2 = last ? nB : cB + (size_t)(t + 2) * kstep;
            const char* a3 = a2 + kstep; const char* b3 = b2 + kstep;
            PG8_LDB(B0, 0, 0); PG8_SCHED; PG8_LDA(At, 0, 0); PG8_STAGE(PG8_SA(1, 1), a1 + hstep);
            PG8_WAIT_L(8); PG8_BAR; PG8_WAIT_L(0); PG8_MMA(0, 0, At, B0); PG8_BAR; PG8_SCHED;
            PG8_LDB(B1, 0, 1); PG8_STAGE(PG8_SB(0, 0), b2);
            PG8_BAR; PG8_WAIT_L(0); PG8_MMA(0, 1, At, B1); PG8_BAR;
            PG8_LDA(At, 0, 1); PG8_STAGE(PG8_SA(0, 0), a2);
            PG8_BAR; PG8_WAIT_L(0); PG8_MMA(1, 0, At, B0); PG8_BAR; PG8_SCHED;
            PG8_STAGE(PG8_SB(0, 1), b2 + hstep);
            PG8_WAIT_V(6); PG8_BAR; PG8_MMA(1, 1, At, B1); PG8_BAR;
            PG8_LDB(B0, 1, 0); PG8_SCHED; PG8_LDA(At, 1, 0); PG8_STAGE(PG8_SA(0, 1), a2 + hstep);
            PG8_WAIT_L(8); PG8_BAR; PG8_WAIT_L(0); PG8_MMA(0, 0, At, B0); PG8_BAR; PG8_SCHED;
            PG8_LDB(B1, 1, 1); PG8_STAGE(PG8_SB(1, 0), b3);
            PG8_BAR; PG8_WAIT_L(0); PG8_MMA(0, 1, At, B1); PG8_BAR;
            PG8_LDA(At, 1, 1); PG8_STAGE(PG8_SA(1, 0), a3);
            PG8_BAR; PG8_WAIT_L(0); PG8_MMA(1, 0, At, B0); PG8_BAR; PG8_SCHED;
            PG8_STAGE(PG8_SB(1, 1), b3 + hstep);
            PG8_WAIT_V(6); PG8_BAR; PG8_MMA(1, 1, At, B1); PG8_BAR;
        }
        E(acc, cur, wr, wc, fr, fq);
        if (!has_next) break;
#pragma unroll
        for (int a = 0; a < 2; ++a)
#pragma unroll
            for (int b = 0; b < 2; ++b)
#pragma unroll
                for (int m = 0; m < 4; ++m)
#pragma unroll
                    for (int n = 0; n < 2; ++n) acc[a][b][m][n] = (f32x4){0.f, 0.f, 0.f, 0.f};
        cur = nxt; cA = nA; cB = nB; ++ui;
    }
    PG8_WAIT_V(0);
    if (wr == 0) PG8_BAR;
    PG8_BAR;
#undef PG8_SA
#undef PG8_SB
#undef PG8_STAGE
#undef PG8_LDA
#undef PG8_LDB
#undef PG8_MMA
#undef PG8_WAIT_V
#undef PG8_WAIT_L
#undef PG8_BAR
#undef PG8_SCHED
}
}

typedef f32x4 AccT[2][2][4][2];

DI int src_col_in(int R) {
    const int pn = R >> 8, c = R & 255, bj = c >> 7, wc = (c >> 5) & 3, r5 = c & 31;
    if (pn < 8) return (4 * pn + wc) * 64 + 32 * bj + r5;
    if (pn == 8) return 2048 + wc * 64 + 32 * bj + r5;
    if (pn == 9) return 2304 + c;
    if (pn < 26) return (bj ? 6656 : 2560) + 128 * (pn - 10) + (c & 127);
    if (pn < 42) return (bj ? 10752 : 4608) + 128 * (pn - 26) + (c & 127);
    return 8704 + 256 * (pn - 42) + c;
}
DI int src_col_gu(int R) { const int t = R >> 8, c = R & 255; return ((c >> 7) ? DFF : 0) + 128 * t + (c & 127); }

DI unsigned bperm(int src4, unsigned v) { return (unsigned)__builtin_amdgcn_ds_bpermute(src4, (int)v); }
DI u32x2 perm2(int src4, u32x2 v) { u32x2 r; r.x = bperm(src4, v.x); r.y = bperm(src4, v.y); return r; }
DI f32x4 perm4(int src4, f32x4 v) { f32x4 r; r[0] = __uint_as_float(bperm(src4, __float_as_uint(v[0]))); r[1] = __uint_as_float(bperm(src4, __float_as_uint(v[1])));
    r[2] = __uint_as_float(bperm(src4, __float_as_uint(v[2]))); r[3] = __uint_as_float(bperm(src4, __float_as_uint(v[3]))); return r; }

struct Epi1 {
    bf16_t *Q, *Kb, *Vb, *U, *BG, *SGA; const float *qg, *kg, *cosT, *sinT; float* out;
    DI void side_kv(float* pwin, float* swin, int row, int col, f32x4 v) const {
        if (row >= TP - 128 && row < TP) *(f32x4*)(pwin + (size_t)(row - (TP - 128)) * 256 + col) = v;
        if (row >= TP) { const int b = (row - TP) >> 2, i = (row - TP) & 3; *(f32x4*)(swin + (size_t)b * 32768 + (size_t)(124 + i) * 256 + col) = v; }
    }
    DI void operator()(const AccT& acc, const pg8::Unit& u, int wr, int wc, int fr, int fq) const {
        asm volatile("" : "+v"(fr), "+v"(fq));
        const int lane = fr + 16 * fq, tr = lane >> 2, tq = lane & 3, src4 = (tr + 16 * tq) * 4;
        const int pn = u.pn, row0 = u.pm * 256 + wr * 64 + fr, rowT0 = u.pm * 256 + wr * 64 + tr;
        const bool side = u.pm >= 31;
        if (pn < 9) {
            const float* g = pn < 8 ? qg : kg;
            f32x4 gv[2][2];
#pragma unroll
            for (int bj = 0; bj < 2; ++bj)
#pragma unroll
                for (int n = 0; n < 2; ++n) gv[bj][n] = *(const f32x4*)(g + 32 * bj + 16 * n + 4 * fq);
#pragma unroll
            for (int aim = 0; aim < 4; ++aim) {
                const int ai = aim >> 1, mh = (aim & 1) * 2;
                f32x4 cs[4][2], sn[4][2];
#pragma unroll
                for (int m = mh; m < mh + 2; ++m) {
                    const int row = row0 + 128 * ai + 16 * m;
                    const int pos = row < TP ? row : TP + ((row - TP) & 3);
#pragma unroll
                    for (int n = 0; n < 2; ++n) { cs[m][n] = *(const f32x4*)(cosT + (size_t)pos * 32 + 16 * n + 4 * fq); sn[m][n] = *(const f32x4*)(sinT + (size_t)pos * 32 + 16 * n + 4 * fq); }
                }
#pragma unroll
                for (int m = mh; m < mh + 2; ++m) {
                    const int rowT = rowT0 + 128 * ai + 16 * m;
                    float ssq = 0.f;
#pragma unroll
                    for (int bj = 0; bj < 2; ++bj)
#pragma unroll
                        for (int n = 0; n < 2; ++n) { const f32x4 x = acc[ai][bj][m][n]; ssq += (x[0] * x[0] + x[1] * x[1]) + (x[2] * x[2] + x[3] * x[3]); }
                    ssq += __shfl_xor(ssq, 16); ssq += __shfl_xor(ssq, 32);
                    const float rs = __builtin_amdgcn_rsqf(ssq * (1.0f / 64.0f) + EPS);
#pragma unroll
                    for (int n = 0; n < 2; ++n) {
                        const f32x4 y1 = acc[ai][0][m][n] * rs * gv[0][n], y2 = acc[ai][1][m][n] * rs * gv[1][n];
                        const f32x4 o1 = y1 * cs[m][n] - y2 * sn[m][n], o2 = y2 * cs[m][n] + y1 * sn[m][n];
                        const int d = 16 * n + 4 * tq;
                        const u32x2 w1 = perm2(src4, pk4(o1)), w2 = perm2(src4, pk4(o2));
                        if (pn < 8) {
                            bf16_t* qp = Q + (size_t)rowT * DM + (4 * pn + wc) * 64 + d;
                            *(u32x2*)qp = w1; *(u32x2*)(qp + 32) = w2;
                        } else {
                            bf16_t* kp = Kb + (size_t)rowT * 256 + wc * 64 + d;
                            *(u32x2*)kp = w1; *(u32x2*)(kp + 32) = w2;
                            if (side) { const f32x4 t1 = perm4(src4, o1), t2 = perm4(src4, o2);
                                side_kv(out + O_PK, out + O_SK, rowT, wc * 64 + d, t1); side_kv(out + O_PK, out + O_SK, rowT, wc * 64 + d + 32, t2); }
                        }
                    }
                }
            }
        } else if (pn == 9) {
#pragma unroll
            for (int ai = 0; ai < 2; ++ai)
#pragma unroll
                for (int m = 0; m < 4; ++m) {
                    const int rowT = rowT0 + 128 * ai + 16 * m;
#pragma unroll
                    for (int bj = 0; bj < 2; ++bj)
#pragma unroll
                        for (int n = 0; n < 2; ++n) { const int col = 128 * bj + 32 * wc + 16 * n + 4 * tq; const f32x4 v = acc[ai][bj][m][n];
                            *(u32x2*)(Vb + (size_t)rowT * 256 + col) = perm2(src4, pk4(v));
                            if (side) side_kv(out + O_PV, out + O_SV, rowT, col, perm4(src4, v)); }
                }
        } else if (pn < 26) {
            const int t = pn - 10;
#pragma unroll
            for (int ai = 0; ai < 2; ++ai)
#pragma unroll
                for (int m = 0; m < 4; ++m) {
                    const int rowT = rowT0 + 128 * ai + 16 * m;
#pragma unroll
                    for (int n = 0; n < 2; ++n) { const int col = 128 * t + 32 * wc + 16 * n + 4 * tq; const f32x4 v = acc[ai][0][m][n] * acc[ai][1][m][n];
                        *(u32x2*)(U + (size_t)rowT * DM + col) = perm2(src4, pk4(v));
                        if (side) { const f32x4 vt = perm4(src4, v);
                            if (rowT >= TP - 2 && rowT < TP) *(f32x4*)(out + O_PC + (size_t)(rowT - (TP - 2)) * DM + col) = vt;
                            if (rowT >= TP && ((rowT - TP) & 3) >= 2) { const int b = (rowT - TP) >> 2, i = (rowT - TP) & 3; *(f32x4*)(out + O_SC + (size_t)b * 4096 + (size_t)(i - 2) * DM + col) = vt; } } }
                }
        } else if (pn < 42) {
            const int t = pn - 26;
#pragma unroll
            for (int ai = 0; ai < 2; ++ai)
#pragma unroll
                for (int m = 0; m < 4; ++m) {
                    const int rowT = rowT0 + 128 * ai + 16 * m;
#pragma unroll
                    for (int n = 0; n < 2; ++n) { const int col = 128 * t + 32 * wc + 16 * n + 4 * tq; const f32x4 b = acc[ai][0][m][n], gc = acc[ai][1][m][n];
                        f32x4 v; v[0] = b[0] * sigmoidf_(gc[0]); v[1] = b[1] * sigmoidf_(gc[1]); v[2] = b[2] * sigmoidf_(gc[2]); v[3] = b[3] * sigmoidf_(gc[3]);
                        *(u32x2*)(BG + (size_t)rowT * DM + col) = perm2(src4, pk4(v)); }
                }
        } else {
#pragma unroll
            for (int ai = 0; ai < 2; ++ai)
#pragma unroll
                for (int m = 0; m < 4; ++m) {
                    const int rowT = rowT0 + 128 * ai + 16 * m;
#pragma unroll
                    for (int bj = 0; bj < 2; ++bj)
#pragma unroll
                        for (int n = 0; n < 2; ++n) { const int col = 256 * (pn - 42) + 128 * bj + 32 * wc + 16 * n + 4 * tq; const f32x4 a = acc[ai][bj][m][n];
                            f32x4 v; v[0] = sigmoidf_(a[0]); v[1] = sigmoidf_(a[1]); v[2] = sigmoidf_(a[2]); v[3] = sigmoidf_(a[3]);
                            *(u32x2*)(SGA + (size_t)rowT * DM + col) = perm2(src4, pk4(v)); }
                }
        }
    }
};

DI void store_partial(float* PB, const AccT& acc, const pg8::Unit& u, int wr, int wc, int tr, int tq, int src4) {
    float* pb = PB + ((size_t)u.split * TS + (size_t)(u.pm * 256 - TP) + wr * 64 + tr) * DM + u.pn * 256 + wc * 32 + 4 * tq;
#pragma unroll
    for (int ai = 0; ai < 2; ++ai)
#pragma unroll
        for (int m = 0; m < 4; ++m)
#pragma unroll
            for (int bj = 0; bj < 2; ++bj)
#pragma unroll
                for (int n = 0; n < 2; ++n) *(f32x4*)(pb + (size_t)(128 * ai + 16 * m) * DM + 128 * bj + 16 * n) = perm4(src4, acc[ai][bj][m][n]);
}

struct Epi3 {
    const float *xp, *xs, *gffn; float* Y; bf16_t* A2; float* SSQ; float* PB;
    DI void operator()(const AccT& acc, const pg8::Unit& u, int wr, int wc, int fr, int fq) const {
        asm volatile("" : "+v"(fr), "+v"(fq));
        const int lane = fr + 16 * fq, tr = lane >> 2, tq = lane & 3, src4 = (tr + 16 * tq) * 4;
        if (u.split >= 0) { store_partial(PB, acc, u, wr, wc, tr, tq, src4); return; }
        const int rowT0 = u.pm * 256 + wr * 64 + tr, colT0 = u.pn * 256 + wc * 32 + 4 * tq;
        const float* xb = u.pm < 32 ? xp : xs - (size_t)TP * DM;
        f32x4 gv[2][2];
#pragma unroll
        for (int bj = 0; bj < 2; ++bj)
#pragma unroll
            for (int n = 0; n < 2; ++n) gv[bj][n] = *(const f32x4*)(gffn + colT0 + 128 * bj + 16 * n);
#pragma unroll
        for (int aim = 0; aim < 4; ++aim) {
            const int ai = aim >> 1, mh = (aim & 1) * 2;
            f32x4 xv[4][2][2];
#pragma unroll
            for (int m = mh; m < mh + 2; ++m)
#pragma unroll
                for (int bj = 0; bj < 2; ++bj)
#pragma unroll
                    for (int n = 0; n < 2; ++n) xv[m][bj][n] = *(const f32x4*)(xb + (size_t)(rowT0 + 128 * ai + 16 * m) * DM + colT0 + 128 * bj + 16 * n);
#pragma unroll
            for (int m = mh; m < mh + 2; ++m) {
                const int rowT = rowT0 + 128 * ai + 16 * m; float ssq = 0.f;
#pragma unroll
                for (int bj = 0; bj < 2; ++bj)
#pragma unroll
                    for (int n = 0; n < 2; ++n) { const size_t off = (size_t)rowT * DM + colT0 + 128 * bj + 16 * n;
                        const f32x4 y = xv[m][bj][n] + perm4(src4, acc[ai][bj][m][n]);
                        ssq += (y[0] * y[0] + y[1] * y[1]) + (y[2] * y[2] + y[3] * y[3]);
                        *(f32x4*)(Y + off) = y; *(u32x2*)(A2 + off) = pk4(y * gv[bj][n]); }
                ssq += __shfl_xor(ssq, 1); ssq += __shfl_xor(ssq, 2);
                if (tq == 0) SSQ[(size_t)rowT * 32 + u.pn * 4 + wc] = ssq;
            }
        }
    }
};

struct Epi4 {
    const float* RSTD; bf16_t* HID;
    DI void operator()(const AccT& acc, const pg8::Unit& u, int wr, int wc, int fr, int fq) const {
        asm volatile("" : "+v"(fr), "+v"(fq));
        const int lane = fr + 16 * fq, tr = lane >> 2, tq = lane & 3, src4 = (tr + 16 * tq) * 4;
        const int row0 = u.pm * 256 + wr * 64 + fr, rowT0 = u.pm * 256 + wr * 64 + tr, colT0 = u.pn * 128 + wc * 32 + 4 * tq;
        float rs[2][4];
#pragma unroll
        for (int ai = 0; ai < 2; ++ai)
#pragma unroll
            for (int m = 0; m < 4; ++m) rs[ai][m] = RSTD[row0 + 128 * ai + 16 * m];
#pragma unroll
        for (int ai = 0; ai < 2; ++ai)
#pragma unroll
            for (int m = 0; m < 4; ++m) {
                const int rowT = rowT0 + 128 * ai + 16 * m;
                const float rstd = rs[ai][m];
#pragma unroll
                for (int n = 0; n < 2; ++n) { const f32x4 g = acc[ai][0][m][n] * rstd, up = acc[ai][1][m][n] * rstd;
                    f32x4 h; h[0] = g[0] * sigmoidf_(g[0]) * up[0]; h[1] = g[1] * sigmoidf_(g[1]) * up[1]; h[2] = g[2] * sigmoidf_(g[2]) * up[2]; h[3] = g[3] * sigmoidf_(g[3]) * up[3];
                    *(u32x2*)(HID + (size_t)rowT * DFF + colT0 + 16 * n) = perm2(src4, pk4(h)); }
            }
    }
};

struct Epi5 {
    float* Y; float* PB;
    DI void operator()(const AccT& acc, const pg8::Unit& u, int wr, int wc, int fr, int fq) const {
        asm volatile("" : "+v"(fr), "+v"(fq));
        const int lane = fr + 16 * fq, tr = lane >> 2, tq = lane & 3, src4 = (tr + 16 * tq) * 4;
        if (u.split >= 0) { store_partial(PB, acc, u, wr, wc, tr, tq, src4); return; }
        float* yb = Y + (size_t)(u.pm * 256 + wr * 64 + tr) * DM + u.pn * 256 + wc * 32 + 4 * tq;
        f32x4 cur[2][2], nxt[2][2];
#pragma unroll
        for (int bj = 0; bj < 2; ++bj)
#pragma unroll
            for (int n = 0; n < 2; ++n) cur[bj][n] = *(const f32x4*)(yb + 128 * bj + 16 * n);
#pragma unroll
        for (int k = 0; k < 8; ++k) {
            const int ai = k >> 2, m = k & 3;
            if (k < 7) { const int a2 = (k + 1) >> 2, m2 = (k + 1) & 3;
#pragma unroll
                for (int bj = 0; bj < 2; ++bj)
#pragma unroll
                    for (int n = 0; n < 2; ++n) nxt[bj][n] = *(const f32x4*)(yb + (size_t)(128 * a2 + 16 * m2) * DM + 128 * bj + 16 * n); }
#pragma unroll
            for (int bj = 0; bj < 2; ++bj)
#pragma unroll
                for (int n = 0; n < 2; ++n) *(f32x4*)(yb + (size_t)(128 * ai + 16 * m) * DM + 128 * bj + 16 * n) = cur[bj][n] + perm4(src4, acc[ai][bj][m][n]);
#pragma unroll
            for (int bj = 0; bj < 2; ++bj)
#pragma unroll
                for (int n = 0; n < 2; ++n) cur[bj][n] = nxt[bj][n];
        }
    }
};

DI void p0_transpose_item(const float* W, int K, int N, bf16_t* WT, int src_n0, int dst_n0, int k0, LAS float* scr, int lane) {
#pragma unroll 8
    for (int i = 0; i < 32; ++i) { const int kk = 2 * i + (lane >> 5); scr[kk * 33 + (lane & 31)] = W[(size_t)(k0 + kk) * N + src_n0 + (lane & 31)]; }
    asm volatile("s_waitcnt lgkmcnt(0)" ::: "memory");
    const int c = lane & 7;
#pragma unroll
    for (int j = 0; j < 4; ++j) { const int n = (lane >> 3) + 8 * j; const LAS float* s = scr + (8 * c) * 33 + n;
        u32x4 o; o.x = pk2(s[0 * 33], s[1 * 33]); o.y = pk2(s[2 * 33], s[3 * 33]); o.z = pk2(s[4 * 33], s[5 * 33]); o.w = pk2(s[6 * 33], s[7 * 33]);
        *(u32x4*)(WT + (size_t)(dst_n0 + n) * K + k0 + 8 * c) = o; }
    asm volatile("s_waitcnt lgkmcnt(0)" ::: "memory");
}

DI void p0_rest(const Params& p, LAS unsigned char* lds, int wid, int lane, int worker, int nworkers) {
    LAS float* scr = (LAS float*)(lds + wid * 8704);
    const int gw = worker * 8 + wid, NGW = nworkers * 8;
    bf16_t* WoutT = (bf16_t*)(p.ws + WS_WOUT); bf16_t* WguT = (bf16_t*)(p.ws + WS_WGU); bf16_t* WdnT = (bf16_t*)(p.ws + WS_WDN);
    constexpr int I_OUT = (DM / 64) * (DM / 32), I_GU = (DM / 64) * (NGU / 32), I_DN = (DFF / 64) * (DM / 32);
    for (int it = gw; it < I_OUT + I_GU + I_DN; it += NGW) {
        int r = it;
        if (r < I_OUT) { const int nblk = DM / 32, kb = r / nblk, nb = r % nblk; p0_transpose_item(p.w_out, DM, DM, WoutT, 32 * nb, 32 * nb, 64 * kb, scr, lane); continue; } r -= I_OUT;
        if (r < I_GU) { const int nblk = NGU / 32, kb = r / nblk, nb = r % nblk; p0_transpose_item(p.w_gu, DM, NGU, WguT, src_col_gu(32 * nb), 32 * nb, 64 * kb, scr, lane); continue; } r -= I_GU;
        { const int nblk = DM / 32, kb = r / nblk, nb = r % nblk; p0_transpose_item(p.w_dn, DFF, DM, WdnT, 32 * nb, 32 * nb, 64 * kb, scr, lane); }
    }
}

DI void p0_prologue(const Params& p, LAS unsigned char* lds, int wid, int lane) {
    LAS float* scr = (LAS float*)(lds + wid * 8704);
    const int gw = blockIdx.x * 8 + wid, NGW = gridDim.x * 8;
    bf16_t* WinT = (bf16_t*)(p.ws + WS_WIN);
    constexpr int I_IN = (DM / 64) * (DIN / 32);
    for (int it = gw; it < I_IN; it += NGW) { const int nblk = DIN / 32, kb = it / nblk, nb = it % nblk; p0_transpose_item(p.w_in, DM, DIN, WinT, src_col_in(32 * nb), 32 * nb, 64 * kb, scr, lane); }
    bf16_t* XN = (bf16_t*)(p.ws + WS_XN);
    for (int m = gw; m < MT; m += NGW) {
        const float* xrow = m < TP ? p.xp + (size_t)m * DM : p.xs + (size_t)(m - TP) * DM;
        const f32x4* xr = (const f32x4*)xrow + lane; f32x4 v[8]; float s = 0.f;
#pragma unroll
        for (int j = 0; j < 8; ++j) { v[j] = xr[64 * j]; s += (v[j][0] * v[j][0] + v[j][1] * v[j][1]) + (v[j][2] * v[j][2] + v[j][3] * v[j][3]); }
        const float rstd = 1.0f / sqrtf(wave_sum(s) * (1.0f / DM) + EPS);
        u32x2* o8 = (u32x2*)(XN + (size_t)m * DM) + lane;
#pragma unroll
        for (int j = 0; j < 8; ++j) { const f32x4 gv = ((const f32x4*)p.norm_mix)[64 * j + lane]; o8[64 * j] = pk4(v[j] * rstd * gv); }
    }
    float* cosT = (float*)(p.ws + WS_COS); float* sinT = (float*)(p.ws + WS_SIN);
    const int gt = blockIdx.x * 512 + threadIdx.x, GT = gridDim.x * 512;
    for (int idx = gt; idx < NPOS * 32; idx += GT) {
        const int pos = idx >> 5, i = idx & 31;
        const float inv = __builtin_amdgcn_exp2f(-(float)i * (13.287712379549449f / 32.0f));
        const float ang = (float)pos * inv;
        const double rev = (double)ang * 0.15915494309189535; const float fr = (float)(rev - __builtin_floor(rev));
        cosT[idx] = __builtin_amdgcn_cosf(fr); sinT[idx] = __builtin_amdgcn_sinf(fr);
    }
}

DI void cache_copy(const Params& p, int worker, int nworkers) {
    const int gt = worker * 512 + threadIdx.x, GT = nworkers * 512;
    for (int idx = gt; idx < 128 * 7936; idx += GT) {
        const int b = idx / 7936, e = idx - b * 7936;
        ((f32x4*)(p.out + O_SK + (size_t)b * 32768))[e] = ((const f32x4*)(p.ck + (size_t)b * 32768 + 1024))[e];
        ((f32x4*)(p.out + O_SV + (size_t)b * 32768))[e] = ((const f32x4*)(p.cv + (size_t)b * 32768 + 1024))[e];
    }
}

#define MFMA32(a, b, c) __builtin_amdgcn_mfma_f32_32x32x16_bf16((a), (b), (c), 0, 0, 0)
DI int crow(int reg, int h) { return (reg & 3) + 8 * (reg >> 2) + 4 * h; }
DI bf16x8 pack8(const f32x16& x, int s) {
    u32x4 p; p.x = pk2(x[8 * s], x[8 * s + 1]); p.y = pk2(x[8 * s + 2], x[8 * s + 3]); p.z = pk2(x[8 * s + 4], x[8 * s + 5]); p.w = pk2(x[8 * s + 6], x[8 * s + 7]);
    return __builtin_bit_cast(bf16x8, p);
}
DI bf16x8 cvt8(f32x4 a, f32x4 b) { u32x4 p; p.x = pk2(a[0], a[1]); p.y = pk2(a[2], a[3]); p.z = pk2(b[0], b[1]); p.w = pk2(b[2], b[3]); return __builtin_bit_cast(bf16x8, p); }

constexpr int KS_STRIDE = 72, VT_STRIDE = 260, VT_OFF = 256 * KS_STRIDE * 2;

template <bool SAMPLE>
DI void attn_chunk(const Params& p, LAS unsigned char* lds, int qb, int c, int kvh, int head_w, int b_s, int lane) {
    const bf16_t* Q = (const bf16_t*)(p.ws + WS_Q); const bf16_t* Kb = (const bf16_t*)(p.ws + WS_K); const bf16_t* Vb = (const bf16_t*)(p.ws + WS_V);
    const bf16_t* U = (const bf16_t*)(p.ws + WS_U); const bf16_t* BG = (const bf16_t*)(p.ws + WS_BG); const bf16_t* SGA = (const bf16_t*)(p.ws + WS_SGA);
    bf16_t* MIX = (bf16_t*)(p.ws + WS_MIX);
    const int r = lane & 31, g = lane >> 5;
    int tok, head, itok = 0;
    if (SAMPLE) { itok = r >> 3; head = kvh * 8 + (r & 7); tok = TP + 4 * b_s + itok; }
    else { head = head_w; tok = 128 * qb + 32 * c + r; }
    const LAS bf16_t* Ks = (const LAS bf16_t*)lds; const LAS bf16_t* Vt = (const LAS bf16_t*)(lds + VT_OFF);
    bf16x8 qf[4];
#pragma unroll
    for (int ks = 0; ks < 4; ++ks) qf[ks] = *(const bf16x8*)(Q + (size_t)tok * DM + head * 64 + 16 * ks + 8 * g);
    f32x16 s[5];
#pragma unroll
    for (int kbr = 0; kbr < 5; ++kbr) {
#pragma unroll
        for (int i = 0; i < 16; ++i) s[kbr][i] = 0.f;
#pragma unroll
        for (int ks = 0; ks < 4; ++ks) {
            bf16x8 a;
            if (SAMPLE) {
                if (kbr < 4) { const float* kp = p.ck + ((size_t)(b_s * 128 + 32 * kbr + r) * 4 + kvh) * 64 + 16 * ks + 8 * g; a = cvt8(*(const f32x4*)kp, *(const f32x4*)(kp + 4)); }
                else { u32x4 z = (u32x4){0u, 0u, 0u, 0u}; if (r < 4) z = *(const u32x4*)(Kb + (size_t)(TP + 4 * b_s + r) * 256 + kvh * 64 + 16 * ks + 8 * g); a = __builtin_bit_cast(bf16x8, z); }
            } else a = *(const LAS bf16x8*)(Ks + (32 * (c + kbr) + r) * KS_STRIDE + 16 * ks + 8 * g);
            s[kbr] = MFMA32(a, qf[ks], s[kbr]);
        }
    }
    const float sc = 0.125f * 1.44269504089f;
    const float sink2 = p.sinks[head] * 1.44269504089f;
    float mraw = -1e30f;
#pragma unroll
    for (int kbr = 0; kbr < 5; ++kbr)
#pragma unroll
        for (int i = 0; i < 16; ++i) {
            const int kr = crow(i, g); bool valid;
            if (SAMPLE) valid = kbr < 4 ? (32 * kbr + kr > itok) : (kr <= itok);
            else { valid = kbr == 0 ? (kr > r) : (kbr == 4 ? (kr <= r) : true); if (qb == 0 && c + kbr < 4) valid = false; }
            const float t = valid ? s[kbr][i] : -1e30f; s[kbr][i] = t; mraw = fmaxf(mraw, t);
        }
    mraw = fmaxf(mraw, __shfl_xor(mraw, 32));
    const float mx = fmaxf(mraw * sc, sink2);
    float sum = 0.f;
#pragma unroll
    for (int kbr = 0; kbr < 5; ++kbr)
#pragma unroll
        for (int i = 0; i < 16; ++i) { const float e = __builtin_amdgcn_exp2f(__builtin_fmaf(s[kbr][i], sc, -mx)); s[kbr][i] = e; sum += e; }
    sum += __shfl_xor(sum, 32);
    const float inv = 1.0f / (sum + __builtin_amdgcn_exp2f(sink2 - mx));
    f32x16 o[2];
#pragma unroll
    for (int dt = 0; dt < 2; ++dt)
#pragma unroll
        for (int i = 0; i < 16; ++i) o[dt][i] = 0.f;
#pragma unroll
    for (int kbr = 0; kbr < 5; ++kbr)
#pragma unroll
        for (int kk = 0; kk < 2; ++kk) {
            const bf16x8 pb = pack8(s[kbr], kk);
#pragma unroll
            for (int dt = 0; dt < 2; ++dt) {
                bf16x8 a; const int d = 32 * dt + r;
                if (SAMPLE) {
                    if (kbr < 4) { float f[8];
#pragma unroll
                        for (int j = 0; j < 8; ++j) { const int key = 32 * kbr + 16 * kk + 8 * (j >> 2) + 4 * g + (j & 3); f[j] = p.cv[((size_t)(b_s * 128 + key) * 4 + kvh) * 64 + d]; }
                        a = cvt8((f32x4){f[0], f[1], f[2], f[3]}, (f32x4){f[4], f[5], f[6], f[7]});
                    } else { u32x4 z = (u32x4){0u, 0u, 0u, 0u};
                        if (kk == 0 && g == 0) { const bf16_t* vp = Vb + (size_t)(TP + 4 * b_s) * 256 + kvh * 64 + d; z.x = (unsigned)vp[0] | ((unsigned)vp[256] << 16); z.y = (unsigned)vp[512] | ((unsigned)vp[768] << 16); }
                        a = __builtin_bit_cast(bf16x8, z); }
                } else {
                    const LAS bf16_t* vp = Vt + d * VT_STRIDE + 32 * (c + kbr) + 16 * kk + 4 * g;
                    const s16x4 lo = *(const LAS s16x4*)vp, hi = *(const LAS s16x4*)(vp + 8);
                    a = __builtin_shufflevector(lo, hi, 0, 1, 2, 3, 4, 5, 6, 7);
                }
                o[dt] = MFMA32(a, pb, o[dt]);
            }
        }
    if (!SAMPLE) {
#pragma unroll
        for (int dt = 0; dt < 2; ++dt)
#pragma unroll
            for (int i4 = 0; i4 < 4; ++i4) {
                const int col = head * 64 + 32 * dt + 8 * i4 + 4 * g;
                const f32x4 at = (f32x4){o[dt][4 * i4], o[dt][4 * i4 + 1], o[dt][4 * i4 + 2], o[dt][4 * i4 + 3]} * inv;
                *(u32x2*)(MIX + (size_t)tok * DM + col) = pk4(at);
            }
        return;
    }
#pragma unroll
    for (int dt = 0; dt < 2; ++dt) {
        u32x2 lsga[4], lbg[4], lu0[4]; f32x4 lu1[4], lu2[4], w0[4], w1[4], w2[4];
#pragma unroll
        for (int i4 = 0; i4 < 4; ++i4) {
            const int col = head * 64 + 32 * dt + 8 * i4 + 4 * g; const size_t off = (size_t)tok * DM + col;
            lsga[i4] = *(const u32x2*)(SGA + off); lbg[i4] = *(const u32x2*)(BG + off); lu0[i4] = *(const u32x2*)(U + off);
            lu1[i4] = itok >= 1 ? unpk4(*(const u32x2*)(U + off - DM)) : *(const f32x4*)(p.sconv + (size_t)b_s * 4096 + DM + col);
            lu2[i4] = itok >= 2 ? unpk4(*(const u32x2*)(U + off - 2 * DM)) : *(const f32x4*)(p.sconv + (size_t)b_s * 4096 + (size_t)itok * DM + col);
            w0[i4] = *(const f32x4*)(p.conv_w + col); w1[i4] = *(const f32x4*)(p.conv_w + DM + col); w2[i4] = *(const f32x4*)(p.conv_w + 2 * DM + col);
        }
#pragma unroll
        for (int i4 = 0; i4 < 4; ++i4) {
            const int col = head * 64 + 32 * dt + 8 * i4 + 4 * g; const size_t off = (size_t)tok * DM + col;
            const f32x4 at = (f32x4){o[dt][4 * i4], o[dt][4 * i4 + 1], o[dt][4 * i4 + 2], o[dt][4 * i4 + 3]} * inv;
            const f32x4 conv = w0[i4] * lu2[i4] + w1[i4] * lu1[i4] + w2[i4] * unpk4(lu0[i4]);
            *(u32x2*)(MIX + off) = pk4(unpk4(lsga[i4]) * at + unpk4(lbg[i4]) * conv);
        }
    }
}

DI void unpk8(u32x4 w, f32x4& lo, f32x4& hi) { lo = (f32x4){bf_lo(w.x), bf_hi(w.x), bf_lo(w.y), bf_hi(w.y)}; hi = (f32x4){bf_lo(w.z), bf_hi(w.z), bf_lo(w.w), bf_hi(w.w)}; }

constexpr int P2_CNT_OFF = 120000;
DI void p2_attention(const Params& p, LAS unsigned char* lds, int tid, int wid, int lane) {
    const bf16_t* Kb = (const bf16_t*)(p.ws + WS_K); const bf16_t* Vb = (const bf16_t*)(p.ws + WS_V);
    const bf16_t* U = (const bf16_t*)(p.ws + WS_U); const bf16_t* BG = (const bf16_t*)(p.ws + WS_BG); const bf16_t* SGA = (const bf16_t*)(p.ws + WS_SGA);
    bf16_t* MIX = (bf16_t*)(p.ws + WS_MIX);
    LAS bf16_t* Ks = (LAS bf16_t*)lds; LAS bf16_t* Vt = (LAS bf16_t*)(lds + VT_OFF);
    LAS unsigned* cnt = (LAS unsigned*)(lds + P2_CNT_OFF);
    int samp_next = blockIdx.x * 2;
    for (int item = blockIdx.x; item < 256; item += gridDim.x) {
        const int qb = item >> 2, kvh = item & 3;
        __syncthreads();
#pragma unroll
        for (int i = 0; i < 4; ++i) {
            const int e = tid + 512 * i, row = e >> 3, c8 = e & 7, tok = 128 * (qb - 1) + row;
            u32x4 kv = (u32x4){0u, 0u, 0u, 0u}, vv = (u32x4){0u, 0u, 0u, 0u};
            if (tok >= 0) { kv = *(const u32x4*)(Kb + (size_t)tok * 256 + kvh * 64 + 8 * c8); vv = *(const u32x4*)(Vb + (size_t)tok * 256 + kvh * 64 + 8 * c8); }
            *(LAS u32x4*)(Ks + row * KS_STRIDE + 8 * c8) = kv;
#pragma unroll
            for (int jj = 0; jj < 8; ++jj) Vt[(8 * c8 + jj) * VT_STRIDE + row] = (bf16_t)(vv[jj >> 1] >> (16 * (jj & 1)));
        }
        if (tid == 0) *cnt = 0u;
        __syncthreads();
        const int ns = (samp_next < 512) ? ((samp_next + 1 < 512) ? 2 : 1) : 0;
        for (;;) {
            unsigned t = 0; if (lane == 0) t = __hip_atomic_fetch_add(cnt, 1u, __ATOMIC_RELAXED, __HIP_MEMORY_SCOPE_WORKGROUP);
            t = __builtin_amdgcn_readfirstlane(t);
            if ((int)t >= ns + 32) break;
            if ((int)t < ns) { const int it = samp_next + (int)t; attn_chunk<true>(p, lds, 0, 0, it & 3, 0, it >> 2, lane); }
            else { const int pc = (int)t - ns; attn_chunk<false>(p, lds, qb, pc & 3, kvh, kvh * 8 + (pc >> 2), 0, lane); }
        }
        samp_next += gridDim.x * 2;
        asm volatile("s_waitcnt vmcnt(0)" ::: "memory");
        __syncthreads();
        __builtin_amdgcn_fence(__ATOMIC_ACQUIRE, "agent");
        {
            const int c8 = tid & 63, rbase = tid >> 6, col = kvh * 512 + 8 * c8;
            f32x4 w[3][2];
#pragma unroll
            for (int k = 0; k < 3; ++k) { w[k][0] = *(const f32x4*)(p.conv_w + k * DM + col); w[k][1] = *(const f32x4*)(p.conv_w + k * DM + col + 4); }
#pragma unroll
            for (int ib = 0; ib < 4; ++ib) {
                u32x4 la[4], ls[4], lb[4], l0[4], l1[4], l2[4];
#pragma unroll
                for (int ii = 0; ii < 4; ++ii) {
                    const int tok = 128 * qb + rbase + 8 * (4 * ib + ii); const size_t off = (size_t)tok * DM + col;
                    la[ii] = *(const u32x4*)(MIX + off); ls[ii] = *(const u32x4*)(SGA + off); lb[ii] = *(const u32x4*)(BG + off); l0[ii] = *(const u32x4*)(U + off);
                    l1[ii] = (u32x4){0u, 0u, 0u, 0u}; l2[ii] = (u32x4){0u, 0u, 0u, 0u};
                    if (tok >= 1) l1[ii] = *(const u32x4*)(U + off - DM);
                    if (tok >= 2) l2[ii] = *(const u32x4*)(U + off - 2 * DM);
                }
#pragma unroll
                for (int ii = 0; ii < 4; ++ii) {
                    const int tok = 128 * qb + rbase + 8 * (4 * ib + ii); const size_t off = (size_t)tok * DM + col;
                    f32x4 a0, a1, s0, s1, b0, b1, x0, x1, y0, y1, z0, z1;
                    unpk8(la[ii], a0, a1); unpk8(ls[ii], s0, s1); unpk8(lb[ii], b0, b1); unpk8(l0[ii], x0, x1); unpk8(l1[ii], y0, y1); unpk8(l2[ii], z0, z1);
                    const f32x4 m0 = s0 * a0 + b0 * (w[0][0] * z0 + w[1][0] * y0 + w[2][0] * x0);
                    const f32x4 m1 = s1 * a1 + b1 * (w[0][1] * z1 + w[1][1] * y1 + w[2][1] * x1);
                    u32x4 o; o.x = pk2(m0[0], m0[1]); o.y = pk2(m0[2], m0[3]); o.z = pk2(m1[0], m1[1]); o.w = pk2(m1[2], m1[3]);
                    *(u32x4*)(MIX + off) = o;
                }
            }
        }
    }
    for (int it = samp_next + (wid & 1); it < 512 && wid < 2; it += gridDim.x * 2) attn_chunk<true>(p, lds, 0, 0, it & 3, 0, it >> 2, lane);
}

DI void p3_reduce(const Params& p, int wid, int lane) {
    const float* PB = (const float*)(p.ws + WS_PB); bf16_t* A2 = (bf16_t*)(p.ws + WS_A2); const float* SSQ = (const float*)(p.ws + WS_SSQ); float* RSTD = (float*)(p.ws + WS_RSTD);
    for (int r = blockIdx.x * 8 + wid; r < TS; r += gridDim.x * 8) {
        const int row = TP + r; f32x4 y[8]; float s = 0.f;
#pragma unroll
        for (int j = 0; j < 8; ++j) { const size_t o = (size_t)r * DM + 256 * j + 4 * lane;
            y[j] = *(const f32x4*)(p.xs + o) + ((*(const f32x4*)(PB + o) + *(const f32x4*)(PB + (size_t)TS * DM + o)) + (*(const f32x4*)(PB + (size_t)2 * TS * DM + o) + *(const f32x4*)(PB + (size_t)3 * TS * DM + o)));
            s += (y[j][0] * y[j][0] + y[j][1] * y[j][1]) + (y[j][2] * y[j][2] + y[j][3] * y[j][3]); }
        s = wave_sum(s);
#pragma unroll
        for (int j = 0; j < 8; ++j) { const int col = 256 * j + 4 * lane; *(f32x4*)(p.out + (size_t)row * DM + col) = y[j];
            *(u32x2*)(A2 + (size_t)row * DM + col) = pk4(y[j] * *(const f32x4*)(p.norm_ffn + col)); }
        if (lane == 0) RSTD[row] = __builtin_amdgcn_rsqf(s * (1.0f / DM) + EPS);
    }
    for (int row = blockIdx.x * 512 + wid * 64 + lane; row < TP; row += gridDim.x * 512) {
        const f32x4* sp = (const f32x4*)(SSQ + (size_t)row * 32); f32x4 a = sp[0];
#pragma unroll
        for (int k = 1; k < 8; ++k) a += sp[k];
        RSTD[row] = __builtin_amdgcn_rsqf(((a[0] + a[1]) + (a[2] + a[3])) * (1.0f / DM) + EPS);
    }
}
DI void p5_reduce(const Params& p) {
    const float* PB = (const float*)(p.ws + WS_PB);
    for (int i = blockIdx.x * 512 + threadIdx.x; i < TS * DM / 4; i += gridDim.x * 512) { const size_t o = (size_t)i * 4; float* yp = p.out + (size_t)TP * DM + o;
        *(f32x4*)yp = *(const f32x4*)yp + ((*(const f32x4*)(PB + o) + *(const f32x4*)(PB + (size_t)TS * DM + o)) + (*(const f32x4*)(PB + (size_t)2 * TS * DM + o) + *(const f32x4*)(PB + (size_t)3 * TS * DM + o))); }
}

constexpr int LDS_BYTES = pg8::STAGE_BYTES + 16;

__global__ void __launch_bounds__(512, 2) fwd_megakernel(Params p) {
    extern __shared__ __attribute__((aligned(16))) unsigned char lds_raw[];
    LAS unsigned char* lds = (LAS unsigned char*)lds_raw;
    cg::grid_group grid = cg::this_grid();
    if (p.never) grid.sync();
    if (threadIdx.x < 4) ((LAS unsigned*)(lds + pg8::STAGE_BYTES))[threadIdx.x] = 0u;
    __syncthreads();
    const XcdBarrier xb = xcd_barrier_post((unsigned*)(p.ws + WS_BAR), (volatile LAS unsigned*)(lds + pg8::STAGE_BYTES));
    const int tid = threadIdx.x, wid = __builtin_amdgcn_readfirstlane(tid >> 6), lane = tid & 63;
    const int G = gridDim.x, bid = blockIdx.x;
    unsigned char* ws = p.ws;

    p0_prologue(p, lds, wid, lane);
    xcd_barrier(xb);
    {
        pg8::Gemm g{(const bf16_t*)(ws + WS_XN), (const bf16_t*)(ws + WS_WIN), MT, DIN, DM}; pg8::StaticOrder S; S.init(MT, DIN, G, bid);
        Epi1 E{(bf16_t*)(ws + WS_Q), (bf16_t*)(ws + WS_K), (bf16_t*)(ws + WS_V), (bf16_t*)(ws + WS_U), (bf16_t*)(ws + WS_BG), (bf16_t*)(ws + WS_SGA),
               p.q_norm, p.k_norm, (const float*)(ws + WS_COS), (const float*)(ws + WS_SIN), p.out};
        pg8::gemm_phase<Epi1, pg8::StaticOrder>(lds, g, S, E);
        {
            const int nfull = ((MT / 256) * (DIN / 256)) % G;
            if (nfull == 0) p0_rest(p, lds, wid, lane, bid, G);
            else if (bid >= nfull) p0_rest(p, lds, wid, lane, bid - nfull, G - nfull);
        }
    }
    xcd_barrier(xb);
    p2_attention(p, lds, tid, wid, lane);
    xcd_barrier(xb);
    {
        pg8::Gemm g{(const bf16_t*)(ws + WS_MIX), (const bf16_t*)(ws + WS_WOUT), MT, DM, DM}; pg8::SplitOrder S; S.init(DM, G, bid, DM / 64);
        Epi3 E{p.xp, p.xs, p.norm_ffn, p.out, (bf16_t*)(ws + WS_A2), (float*)(ws + WS_SSQ), (float*)(ws + WS_PB)};
        pg8::gemm_phase<Epi3, pg8::SplitOrder>(lds, g, S, E);
        {   const int nfull = S.total() % G;
            if (nfull == 0) cache_copy(p, bid, G); else if (bid >= nfull) cache_copy(p, bid - nfull, G - nfull);
        }
    }
    xcd_barrier(xb);
    p3_reduce(p, wid, lane);
    xcd_barrier(xb);
    {
        pg8::Gemm g{(const bf16_t*)(ws + WS_A2), (const bf16_t*)(ws + WS_WGU), MT, NGU, DM}; pg8::StaticOrder S; S.init(MT, NGU, G, bid);
        Epi4 E{(const float*)(ws + WS_RSTD), (bf16_t*)(ws + WS_HID)};
        pg8::gemm_phase<Epi4, pg8::StaticOrder>(lds, g, S, E);
    }
    xcd_barrier(xb);
    {
        pg8::Gemm g{(const bf16_t*)(ws + WS_HID), (const bf16_t*)(ws + WS_WDN), MT, DM, DFF}; pg8::SplitOrder S; S.init(DM, G, bid, DFF / 64);
        Epi5 E{p.out, (float*)(ws + WS_PB)};
        pg8::gemm_phase<Epi5, pg8::SplitOrder>(lds, g, S, E);
    }
    xcd_barrier(xb);
    p5_reduce(p);
}

extern "C" void kernel_launch(void* const* d_in, const int* in_sizes, int n_in, void* d_out, int out_size, void* d_ws, size_t ws_size, hipStream_t stream) {
    static int grid = 0;
    if (!grid) {
        int dev = 0, cus = 0, per_cu = 0;
        (void)hipGetDevice(&dev);
        (void)hipDeviceGetAttribute(&cus, hipDeviceAttributeMultiprocessorCount, dev);
        (void)hipFuncSetAttribute((const void*)fwd_megakernel, hipFuncAttributeMaxDynamicSharedMemorySize, LDS_BYTES);
        (void)hipOccupancyMaxActiveBlocksPerMultiprocessor(&per_cu, (const void*)fwd_megakernel, 512, LDS_BYTES);
        if (per_cu < 1) per_cu = 1;
        grid = cus * per_cu;
        if (ws_size < WS_END) fprintf(stderr, "kernel_launch: workspace too small (%zu < %zu)\n", ws_size, (size_t)WS_END);
    }
    Params p{};
    p.xp = (const float*)d_in[0]; p.xs = (const float*)d_in[1]; p.ck = (const float*)d_in[2]; p.cv = (const float*)d_in[3]; p.sconv = (const float*)d_in[4];
    p.norm_mix = (const float*)d_in[5]; p.w_in = (const float*)d_in[6]; p.q_norm = (const float*)d_in[7]; p.k_norm = (const float*)d_in[8]; p.sinks = (const float*)d_in[9];
    p.conv_w = (const float*)d_in[10]; p.w_out = (const float*)d_in[11]; p.norm_ffn = (const float*)d_in[12]; p.w_gu = (const float*)d_in[13]; p.w_dn = (const float*)d_in[14];
    p.out = (float*)d_out; p.ws = (unsigned char*)d_ws;
    p.never = 0;
    (void)hipMemsetAsync((char*)d_ws + WS_BAR, 0, 16384, stream);
    void* args[] = {&p};
    hipError_t e = hipLaunchCooperativeKernel((const void*)fwd_megakernel, dim3(grid), dim3(512), args, LDS_BYTES, stream);
    if (e != hipSuccess) fprintf(stderr, "cooperative launch failed: %s (grid %d)\n", hipGetErrorString(e), grid);
}
```

```cpp
#include <hip/hip_runtime.h>
#include <hip/hip_cooperative_groups.h>
#include <cstdio>
namespace cg = cooperative_groups;
#define REP_P0 1
#define REP_P1 1
#define REP_P2 1
#define REP_P3 1
#define REP_P4 1
#define REP_SYNC 0

#define LAS __attribute__((address_space(3)))
#define DI __device__ __forceinline__
typedef unsigned short bf16_t;
typedef short bf16x8 __attribute__((ext_vector_type(8)));
typedef short s16x4 __attribute__((ext_vector_type(4)));
typedef float f32x4 __attribute__((ext_vector_type(4)));
typedef float f32x16 __attribute__((ext_vector_type(16)));
typedef unsigned u32x4 __attribute__((ext_vector_type(4)));
typedef unsigned u32x2 __attribute__((ext_vector_type(2)));

constexpr int DM = 2048, TP = 8192, TS = 512, MT = TP + TS, DIN = 12800, DFF = 5632, NGU = 2 * DFF;
constexpr float EPS = 1e-6f;
constexpr int NPOS = 8196;
constexpr size_t O_YP = 0, O_YS = (size_t)TP * DM, O_PK = O_YS + (size_t)TS * DM, O_PV = O_PK + 32768, O_PC = O_PV + 32768,
                 O_SK = O_PC + 4096, O_SV = O_SK + 4194304, O_SC = O_SV + 4194304;
constexpr size_t WS_WIN = 0, WS_WOUT = WS_WIN + (size_t)DIN * DM * 2, WS_WGU = WS_WOUT + (size_t)DM * DM * 2, WS_WDN = WS_WGU + (size_t)NGU * DM * 2,
                 WS_XN = WS_WDN + (size_t)DM * DFF * 2, WS_Q = WS_XN + (size_t)MT * DM * 2, WS_K = WS_Q + (size_t)MT * DM * 2, WS_V = WS_K + (size_t)MT * 256 * 2,
                 WS_U = WS_V + (size_t)MT * 256 * 2, WS_BG = WS_U + (size_t)MT * DM * 2, WS_SGA = WS_BG + (size_t)MT * DM * 2, WS_COS = WS_SGA + (size_t)MT * DM * 2,
                 WS_SIN = WS_COS + (size_t)NPOS * 32 * 4, WS_SSQ = WS_SIN + (size_t)NPOS * 32 * 4, WS_BAR = WS_SSQ + (size_t)MT * 32 * 4, WS_RSTD = WS_BAR + 16384, WS_PB = WS_RSTD + 65536, WS_END = WS_PB + (size_t)4 * TS * DM * 4;
constexpr size_t WS_MIX = WS_XN, WS_A2 = WS_Q, WS_HID = WS_U;
static_assert((size_t)MT * DFF * 2 <= 3 * (size_t)MT * DM * 2, "hidden fits in U|BG|SGA");

struct Params {
    const float *xp, *xs, *ck, *cv, *sconv, *norm_mix, *w_in, *q_norm, *k_norm, *sinks, *conv_w, *w_out, *norm_ffn, *w_gu, *w_dn;
    float* out; unsigned char* ws; long never;
};

typedef float f32x2 __attribute__((ext_vector_type(2)));
typedef __bf16 bf16x2v __attribute__((ext_vector_type(2)));
DI unsigned pk2(float lo, float hi) { const f32x2 f = {lo, hi}; return __builtin_bit_cast(unsigned, __builtin_convertvector(f, bf16x2v)); }
DI u32x2 pk4(f32x4 v) { u32x2 r; r.x = pk2(v[0], v[1]); r.y = pk2(v[2], v[3]); return r; }
DI float bf_lo(unsigned w) { return __uint_as_float(w << 16); }
DI float bf_hi(unsigned w) { return __uint_as_float(w & 0xffff0000u); }
DI f32x4 unpk4(u32x2 w) { return (f32x4){bf_lo(w.x), bf_hi(w.x), bf_lo(w.y), bf_hi(w.y)}; }
DI float sigmoidf_(float x) { return __builtin_amdgcn_rcpf(1.0f + __builtin_amdgcn_exp2f(-1.44269504089f * x)); }
DI float wave_sum(float v) {
#pragma unroll
    for (int o = 1; o < 64; o <<= 1) v += __shfl_xor(v, o);
    return v;
}


#define XB_TMO      128
#define XB_XCNT(j)  (256  + 64 * (j))
#define XB_XSUB(j)  (1280 + 64 * (j))
#define XB_XGEN(j)  (2304 + 64 * (j))
#define XB_TOP      3328
#define XB_TOPGEN   3392
#define XCD_BAR_WORDS 3456
#define XB_SPIN_CAP (1u << 20)
DI unsigned xb_ld(unsigned* p)              { return __hip_atomic_load(p, __ATOMIC_RELAXED, __HIP_MEMORY_SCOPE_AGENT); }
DI unsigned xb_add(unsigned* p, unsigned v) { return __hip_atomic_fetch_add(p, v, __ATOMIC_RELAXED, __HIP_MEMORY_SCOPE_AGENT); }
DI unsigned xb_xcc_id() { return (unsigned)__builtin_amdgcn_s_getreg((3 << 11) | 20) & 0xFu; }
#define XB_SPIN(cond, bar) do { unsigned _sp = 0; while (cond) { __builtin_amdgcn_s_sleep(1); \
    if ((++_sp & 255u) == 0u) { if (xb_ld(&(bar)[XB_TMO])) break; if (_sp > XB_SPIN_CAP) { atomicAdd(&(bar)[XB_TMO], 1u); break; } } } } while (0)
struct XcdBarrier { unsigned* bar; unsigned x; volatile LAS unsigned* st; };
DI XcdBarrier xcd_barrier_post(unsigned* bar, volatile LAS unsigned* st) {
    XcdBarrier b; b.bar = bar; b.x = xb_xcc_id(); b.st = st;
    if (threadIdx.x == 0) (void)xb_add(&bar[XB_XCNT(b.x)], 1u);
    return b;
}
DI void xcd_barrier_complete(unsigned* bar, unsigned x, unsigned& nloc, unsigned& nx) {
    const unsigned G = gridDim.x * gridDim.y * gridDim.z;
    unsigned sum, cnt, mine, sp = 0u;
    for (;;) {
        sum = 0u; cnt = 0u; mine = 0u;
#pragma unroll
        for (unsigned j = 0; j < 16; ++j) { const unsigned c = xb_ld(&bar[XB_XCNT(j)]); sum += c; cnt += (c > 0u) ? 1u : 0u; mine = (j == x) ? c : mine; }
        if (sum == G) break;
        __builtin_amdgcn_s_sleep(1);
        if ((++sp & 255u) == 0u) { if (xb_ld(&bar[XB_TMO])) break; if (sp > XB_SPIN_CAP) { atomicAdd(&bar[XB_TMO], 1u); break; } }
    }
    nloc = mine > 0u ? mine : 1u; nx = cnt > 0u ? cnt : 1u;
}
DI void xcd_barrier(const XcdBarrier& b) {
    asm volatile("s_waitcnt vmcnt(0)" ::: "memory");
    __syncthreads();
    if (threadIdx.x == 0) {
        unsigned* bar = b.bar;
        __builtin_amdgcn_s_waitcnt(0);
        unsigned nloc = b.st[0], nx = b.st[1];
        if (nloc == 0u) { xcd_barrier_complete(bar, b.x, nloc, nx); b.st[0] = nloc; b.st[1] = nx; }
        const unsigned old = xb_add(&bar[XB_XSUB(b.x)], 1u);
        const unsigned gen = old / nloc;
        if (old + 1u == (gen + 1u) * nloc) {
            __builtin_amdgcn_fence(__ATOMIC_RELEASE, "agent");
            asm volatile("s_waitcnt vmcnt(0)" ::: "memory");
            const unsigned og = xb_add(&bar[XB_TOP], 1u);
            const unsigned tg = og / nx;
            if (og + 1u == (tg + 1u) * nx) xb_add(&bar[XB_TOPGEN], 1u);
            else XB_SPIN(xb_ld(&bar[XB_TOPGEN]) == tg, bar);
            __builtin_amdgcn_fence(__ATOMIC_ACQUIRE, "agent");
            xb_add(&bar[XB_XGEN(b.x)], 1u);
            asm volatile("s_waitcnt vmcnt(0)" ::: "memory");
        } else {
            XB_SPIN(xb_ld(&bar[XB_XGEN(b.x)]) == gen, bar);
            __builtin_amdgcn_fence(__ATOMIC_ACQUIRE, "agent");
            asm volatile("s_waitcnt vmcnt(0)" ::: "memory");
        }
    }
    __syncthreads();
}

namespace pg8 {
constexpr int BM = 256, BK = 64, HALF = 128, HTB = HALF * BK * 2, STAGE_BYTES = 8 * HTB, NXCD = 8, WGM = 8;
DI int lds_byte(int r, int c) { const int st = (r >> 4) * 2 + (c >> 5), rr = r & 15, cc = c & 31, ob = rr * 64 + cc * 2; return st * 1024 + (ob ^ (((ob >> 9) & 1) << 5)); }
DI void stage_rc(int b, int& R, int& C) { const int st = b / 1024, sb = b % 1024, swz = sb ^ (((sb >> 9) & 1) << 5); R = (st >> 1) * 16 + swz / 64; C = (st & 1) * 32 + (swz % 64) / 2; }
struct Unit { int pm, pn, k0, nt, split; };
struct Gemm { const bf16_t* A; const bf16_t* Bt; int M, N, K; };
struct StaticOrder {
    int nM, nN, nwg, G, c, ntk;
    DI void init(int M, int N, int G_, int c_, int ntk_ = 32) { nM = M / BM; nN = N / BM; nwg = nM * nN; G = G_; c = c_; ntk = ntk_; }
    DI void map(int L, Unit& u) const {
        int wgid = L; { const int q = nwg / NXCD, r = nwg % NXCD, xcd = wgid % NXCD, off = wgid / NXCD; wgid = (xcd < r ? xcd * (q + 1) : r * (q + 1) + (xcd - r) * q) + off; }
        const int nig = WGM * nN, gid = wgid / nig, fm = gid * WGM, gsz = (nM - fm) < WGM ? (nM - fm) : WGM;
        u.pm = fm + ((wgid % nig) % gsz); u.pn = (wgid % nig) / gsz; u.k0 = 0; u.nt = ntk; u.split = -1;
    }
    DI bool next(int i, Unit& u) const { const long L = (long)i * G + c; if (L >= nwg) return false; map((int)L, u); return true; }
};
struct SplitOrder {
    StaticOrder base;
    DI void init(int N, int G_, int c_, int ntk_) { base.init(TP, N, G_, c_, ntk_); }
    DI int total() const { return base.nwg + 16 * 4; }
    DI bool next(int i, Unit& u) const {
        const int L = i * base.G + base.c;
        if (L >= base.nwg + 64) return false;
        const bool sp = L >= base.nwg;
        Unit a; base.map(sp ? 0 : L, a);
        const int j = L - base.nwg, tile = j >> 2, s4 = j & 3, q = base.ntk >> 2;
        u.pm = sp ? (TP / BM + (tile >> 3)) : a.pm; u.pn = sp ? (tile & 7) : a.pn; u.nt = sp ? q : a.nt; u.k0 = sp ? s4 * q : 0; u.split = sp ? s4 : -1;
        return true;
    }
};

template <class Epi, class Sched>
DI void gemm_phase(LAS unsigned char* lds, const Gemm g, const Sched& S, const Epi& E) {
    const int tid = threadIdx.x, wid = __builtin_amdgcn_readfirstlane(tid >> 6), lane = tid & 63, wr = wid >> 2, wc = wid & 3, fr = lane & 15, fq = lane >> 4;
    const int K = g.K;
    unsigned voffA[2];
#pragma unroll
    for (int i = 0; i < 2; ++i) { int R, C; stage_rc(tid * 16 + i * 8192, R, C); voffA[i] = (unsigned)(R * K + C) * 2u; }
    const size_t kstep = (size_t)(BK * 2);
    const size_t hstep = (size_t)HALF * K * 2;
    const size_t tstep = 2 * hstep;
    const unsigned ldsw = (unsigned)wid * 1024u;
    const int aoff = lds_byte(wr * 64 + fr, fq * 8), boff = lds_byte(wc * 32 + fr, fq * 8);
#define PG8_SA(b, h) (((b) * 2 + (h)) * HTB)
#define PG8_SB(b, h) ((4 + (b) * 2 + (h)) * HTB)
#define PG8_STAGE(bufoff, gbase) do { _Pragma("unroll") for (int _i = 0; _i < 2; ++_i) \
        __builtin_amdgcn_global_load_lds((const unsigned*)((const char*)(gbase) + voffA[_i]), (LAS unsigned*)(lds + (bufoff) + ldsw + _i * 8192), 16, 0, 0); } while (0)
#define PG8_LDA(dst, b, h) do { _Pragma("unroll") for (int m = 0; m < 4; ++m) _Pragma("unroll") for (int k = 0; k < 2; ++k) dst[m][k] = *(const LAS bf16x8*)(lds + PG8_SA(b, h) + aoff + m * 2048 + k * 1024); } while (0)
#define PG8_LDB(dst, b, h) do { _Pragma("unroll") for (int n = 0; n < 2; ++n) _Pragma("unroll") for (int k = 0; k < 2; ++k) dst[n][k] = *(const LAS bf16x8*)(lds + PG8_SB(b, h) + boff + n * 2048 + k * 1024); } while (0)
#define PG8_MMA(ai, bj, At, Bt) do { __builtin_amdgcn_s_setprio(1); _Pragma("unroll") for (int m = 0; m < 4; ++m) _Pragma("unroll") for (int n = 0; n < 2; ++n) _Pragma("unroll") for (int k = 0; k < 2; ++k) \
        acc[ai][bj][m][n] = __builtin_amdgcn_mfma_f32_16x16x32_bf16(Bt[n][k], At[m][k], acc[ai][bj][m][n], 0, 0, 0); __builtin_amdgcn_s_setprio(0); } while (0)
#define PG8_WAIT_V(n) asm volatile("s_waitcnt vmcnt(" #n ")" ::: "memory")
#define PG8_WAIT_L(n) asm volatile("s_waitcnt lgkmcnt(" #n ")" ::: "memory")
#define PG8_BAR __builtin_amdgcn_s_barrier()
#define PG8_SCHED __builtin_amdgcn_sched_barrier(0)
    Unit cur, nxt; int ui = 0;
    if (!S.next(0, cur)) return;
    f32x4 acc[2][2][4][2];
#pragma unroll
    for (int a = 0; a < 2; ++a)
#pragma unroll
        for (int b = 0; b < 2; ++b)
#pragma unroll
            for (int m = 0; m < 4; ++m)
#pragma unroll
                for (int n = 0; n < 2; ++n) acc[a][b][m][n] = (f32x4){0.f, 0.f, 0.f, 0.f};
    bf16x8 At[4][2], B0[2][2], B1[2][2];
    const char* cA = (const char*)g.A + (size_t)cur.pm * tstep + (size_t)cur.k0 * kstep; const char* cB = (const char*)g.Bt + (size_t)cur.pn * tstep + (size_t)cur.k0 * kstep;
    PG8_STAGE(PG8_SB(0, 0), cB); PG8_STAGE(PG8_SA(0, 0), cA); PG8_STAGE(PG8_SB(0, 1), cB + hstep); PG8_STAGE(PG8_SA(0, 1), cA + hstep);
    if (wr == 1) PG8_BAR;
    PG8_WAIT_V(4); PG8_BAR;
    PG8_STAGE(PG8_SB(1, 0), cB + kstep); PG8_STAGE(PG8_SA(1, 0), cA + kstep); PG8_STAGE(PG8_SB(1, 1), cB + hstep + kstep);
    PG8_WAIT_V(6); PG8_BAR;
    for (;;) {
        const bool has_next = S.next(ui + 1, nxt);
        const char* nA = has_next ? (const char*)g.A + (size_t)nxt.pm * tstep + (size_t)nxt.k0 * kstep : cA; const char* nB = has_next ? (const char*)g.Bt + (size_t)nxt.pn * tstep + (size_t)nxt.k0 * kstep : cB;
        const int nt = cur.nt;
        for (int t = 0; t < nt; t += 2) {
            const bool last = (t == nt - 2);
            const char* a1 = cA + (size_t)(t + 1) * kstep;
            const char* a2 = last ? nA : cA + (size_t)(t + 2) * kstep; const char* b2 = last ? nB : cB + (size_t)(t + 2) * kstep;
            const char* a3 = a2 + kstep; const char* b3 = b2 + kstep;
            PG8_LDB(B0, 0, 0); PG8_SCHED; PG8_LDA(At, 0, 0); PG8_STAGE(PG8_SA(1, 1), a1 + hstep);
            PG8_WAIT_L(8); PG8_BAR; PG8_WAIT_L(0); PG8_MMA(0, 0, At, B0); PG8_BAR; PG8_SCHED;
            PG8_LDB(B1, 0, 1); PG8_STAGE(PG8_SB(0, 0), b2);
            PG8_BAR; PG8_WAIT_L(0); PG8_MMA(0, 1, At, B1); PG8_BAR;
            PG8_LDA(At, 0, 1); PG8_STAGE(PG8_SA(0, 0), a2);
            PG8_BAR; PG8_WAIT_L(0); PG8_MMA(1, 0, At, B0); PG8_BAR; PG8_SCHED;
            PG8_STAGE(PG8_SB(0, 1), b2 + hstep);
            PG8_WAIT_V(6); PG8_BAR; PG8_MMA(1, 1, At, B1); PG8_BAR;
            PG8_LDB(B0, 1, 0); PG8_SCHED; PG8_LDA(At, 1, 0); PG8_STAGE(PG8_SA(0, 1), a2 + hstep);
            PG8_WAIT_L(8); PG8_BAR; PG8_WAIT_L(0); PG8_MMA(0, 0, At, B0); PG8_BAR; PG8_SCHED;
            PG8_LDB(B1, 1, 1); PG8_STAGE(PG8_SB(1, 0), b3);
            PG8_BAR; PG8_WAIT_L(0); PG8_MMA(0, 1, At, B1); PG8_BAR;
            PG8_LDA(At, 1, 1); PG8_STAGE(PG8_SA(1, 0), a3);
            PG8_BAR; PG8_WAIT_L(0); PG8_MMA(1, 0, At, B0); PG8_BAR; PG8_SCHED;
            PG8_STAGE(PG8_SB(1, 1), b3 + hstep);
            PG8_WAIT_V(6); PG8_BAR; PG8_MMA(1, 1, At, B1); PG8_BAR;
        }
        E(acc, cur, wr, wc, fr, fq);
        if (!has_next) break;
#pragma unroll
        for (int a = 0; a < 2; ++a)
#pragma unroll
            for (int b = 0; b < 2; ++b)
#pragma unroll
                for (int m = 0; m < 4; ++m)
#pragma unroll
                    for (int n = 0; n < 2; ++n) acc[a][b][m][n] = (f32x4){0.f, 0.f, 0.f, 0.f};
        cur = nxt; cA = nA; cB = nB; ++ui;
    }
    PG8_WAIT_V(0);
    if (wr == 0) PG8_BAR;
    PG8_BAR;
#undef PG8_SA
#undef PG8_SB
#undef PG8_STAGE
#undef PG8_LDA
#undef PG8_LDB
#undef PG8_MMA
#undef PG8_WAIT_V
#undef PG8_WAIT_L
#undef PG8_BAR
#undef PG8_SCHED
}
}

typedef f32x4 AccT[2][2][4][2];

DI int src_col_in(int R) {
    const int pn = R >> 8, c = R & 255, bj = c >> 7, wc = (c >> 5) & 3, r5 = c & 31;
    if (pn < 8) return (4 * pn + wc) * 64 + 32 * bj + r5;
    if (pn == 8) return 2048 + wc * 64 + 32 * bj + r5;
    if (pn == 9) return 2304 + c;
    if (pn < 26) return (bj ? 6656 : 2560) + 128 * (pn - 10) + (c & 127);
    if (pn < 42) return (bj ? 10752 : 4608) + 128 * (pn - 26) + (c & 127);
    return 8704 + 256 * (pn - 42) + c;
}
DI int src_col_gu(int R) { const int t = R >> 8, c = R & 255; return ((c >> 7) ? DFF : 0) + 128 * t + (c & 127); }

DI unsigned bperm(int src4, unsigned v) { return (unsigned)__builtin_amdgcn_ds_bpermute(src4, (int)v); }
DI u32x2 perm2(int src4, u32x2 v) { u32x2 r; r.x = bperm(src4, v.x); r.y = bperm(src4, v.y); return r; }
DI f32x4 perm4(int src4, f32x4 v) { f32x4 r; r[0] = __uint_as_float(bperm(src4, __float_as_uint(v[0]))); r[1] = __uint_as_float(bperm(src4, __float_as_uint(v[1])));
    r[2] = __uint_as_float(bperm(src4, __float_as_uint(v[2]))); r[3] = __uint_as_float(bperm(src4, __float_as_uint(v[3]))); return r; }

struct Epi1 {
    bf16_t *Q, *Kb, *Vb, *U, *BG, *SGA; const float *qg, *kg, *cosT, *sinT; float* out;
    DI void side_kv(float* pwin, float* swin, int row, int col, f32x4 v) const {
        if (row >= TP - 128 && row < TP) *(f32x4*)(pwin + (size_t)(row - (TP - 128)) * 256 + col) = v;
        if (row >= TP) { const int b = (row - TP) >> 2, i = (row - TP) & 3; *(f32x4*)(swin + (size_t)b * 32768 + (size_t)(124 + i) * 256 + col) = v; }
    }
    DI void operator()(const AccT& acc, const pg8::Unit& u, int wr, int wc, int fr, int fq) const {
        asm volatile("" : "+v"(fr), "+v"(fq));
        const int lane = fr + 16 * fq, tr = lane >> 2, tq = lane & 3, src4 = (tr + 16 * tq) * 4;
        const int pn = u.pn, row0 = u.pm * 256 + wr * 64 + fr, rowT0 = u.pm * 256 + wr * 64 + tr;
        const bool side = u.pm >= 31;
        if (pn < 9) {
            const float* g = pn < 8 ? qg : kg;
            f32x4 gv[2][2];
#pragma unroll
            for (int bj = 0; bj < 2; ++bj)
#pragma unroll
                for (int n = 0; n < 2; ++n) gv[bj][n] = *(const f32x4*)(g + 32 * bj + 16 * n + 4 * fq);
#pragma unroll
            for (int aim = 0; aim < 4; ++aim) {
                const int ai = aim >> 1, mh = (aim & 1) * 2;
                f32x4 cs[4][2], sn[4][2];
#pragma unroll
                for (int m = mh; m < mh + 2; ++m) {
                    const int row = row0 + 128 * ai + 16 * m;
                    const int pos = row < TP ? row : TP + ((row - TP) & 3);
#pragma unroll
                    for (int n = 0; n < 2; ++n) { cs[m][n] = *(const f32x4*)(cosT + (size_t)pos * 32 + 16 * n + 4 * fq); sn[m][n] = *(const f32x4*)(sinT + (size_t)pos * 32 + 16 * n + 4 * fq); }
                }
#pragma unroll
                for (int m = mh; m < mh + 2; ++m) {
                    const int rowT = rowT0 + 128 * ai + 16 * m;
                    float ssq = 0.f;
#pragma unroll
                    for (int bj = 0; bj < 2; ++bj)
#pragma unroll
                        for (int n = 0; n < 2; ++n) { const f32x4 x = acc[ai][bj][m][n]; ssq += (x[0] * x[0] + x[1] * x[1]) + (x[2] * x[2] + x[3] * x[3]); }
                    ssq += __shfl_xor(ssq, 16); ssq += __shfl_xor(ssq, 32);
                    const float rs = __builtin_amdgcn_rsqf(ssq * (1.0f / 64.0f) + EPS);
#pragma unroll
                    for (int n = 0; n < 2; ++n) {
                        const f32x4 y1 = acc[ai][0][m][n] * rs * gv[0][n], y2 = acc[ai][1][m][n] * rs * gv[1][n];
                        const f32x4 o1 = y1 * cs[m][n] - y2 * sn[m][n], o2 = y2 * cs[m][n] + y1 * sn[m][n];
                        const int d = 16 * n + 4 * tq;
                        const u32x2 w1 = perm2(src4, pk4(o1)), w2 = perm2(src4, pk4(o2));
                        if (pn < 8) {
                            bf16_t* qp = Q + (size_t)rowT * DM + (4 * pn + wc) * 64 + d;
                            *(u32x2*)qp = w1; *(u32x2*)(qp + 32) = w2;
                        } else {
                            bf16_t* kp = Kb + (size_t)rowT * 256 + wc * 64 + d;
                            *(u32x2*)kp = w1; *(u32x2*)(kp + 32) = w2;
                            if (side) { const f32x4 t1 = perm4(src4, o1), t2 = perm4(src4, o2);
                                side_kv(out + O_PK, out + O_SK, rowT, wc * 64 + d, t1); side_kv(out + O_PK, out + O_SK, rowT, wc * 64 + d + 32, t2); }
                        }
                    }
                }
            }
        } else if (pn == 9) {
#pragma unroll
            for (int ai = 0; ai < 2; ++ai)
#pragma unroll
                for (int m = 0; m < 4; ++m) {
                    const int rowT = rowT0 + 128 * ai + 16 * m;
#pragma unroll
                    for (int bj = 0; bj < 2; ++bj)
#pragma unroll
                        for (int n = 0; n < 2; ++n) { const int col = 128 * bj + 32 * wc + 16 * n + 4 * tq; const f32x4 v = acc[ai][bj][m][n];
                            *(u32x2*)(Vb + (size_t)rowT * 256 + col) = perm2(src4, pk4(v));
                            if (side) side_kv(out + O_PV, out + O_SV, rowT, col, perm4(src4, v)); }
                }
        } else if (pn < 26) {
            const int t = pn - 10;
#pragma unroll
            for (int ai = 0; ai < 2; ++ai)
#pragma unroll
                for (int m = 0; m < 4; ++m) {
                    const int rowT = rowT0 + 128 * ai + 16 * m;
#pragma unroll
                    for (int n = 0; n < 2; ++n) { const int col = 128 * t + 32 * wc + 16 * n + 4 * tq; const f32x4 v = acc[ai][0][m][n] * acc[ai][1][m][n];
                        *(u32x2*)(U + (size_t)rowT * DM + col) = perm2(src4, pk4(v));
                        if (side) { const f32x4 vt = perm4(src4, v);
                            if (rowT >= TP - 2 && rowT < TP) *(f32x4*)(out + O_PC + (size_t)(rowT - (TP - 2)) * DM + col) = vt;
                            if (rowT >= TP && ((rowT - TP) & 3) >= 2) { const int b = (rowT - TP) >> 2, i = (rowT - TP) & 3; *(f32x4*)(out + O_SC + (size_t)b * 4096 + (size_t)(i - 2) * DM + col) = vt; } } }
                }
        } else if (pn < 42) {
            const int t = pn - 26;
#pragma unroll
            for (int ai = 0; ai < 2; ++ai)
#pragma unroll
                for (int m = 0; m < 4; ++m) {
                    const int rowT = rowT0 + 128 * ai + 16 * m;
#pragma unroll
                    for (int n = 0; n < 2; ++n) { const int col = 128 * t + 32 * wc + 16 * n + 4 * tq; const f32x4 b = acc[ai][0][m][n], gc = acc[ai][1][m][n];
                        f32x4 v; v[0] = b[0] * sigmoidf_(gc[0]); v[1] = b[1] * sigmoidf_(gc[1]); v[2] = b[2] * sigmoidf_(gc[2]); v[3] = b[3] * sigmoidf_(gc[3]);
                        *(u32x2*)(BG + (size_t)rowT * DM + col) = perm2(src4, pk4(v)); }
                }
        } else {
#pragma unroll
            for (int ai = 0; ai < 2; ++ai)
#pragma unroll
                for (int m = 0; m < 4; ++m) {
                    const int rowT = rowT0 + 128 * ai + 16 * m;
#pragma unroll
                    for (int bj = 0; bj < 2; ++bj)
#pragma unroll
                        for (int n = 0; n < 2; ++n) { const int col = 256 * (pn - 42) + 128 * bj + 32 * wc + 16 * n + 4 * tq; const f32x4 a = acc[ai][bj][m][n];
                            f32x4 v; v[0] = sigmoidf_(a[0]); v[1] = sigmoidf_(a[1]); v[2] = sigmoidf_(a[2]); v[3] = sigmoidf_(a[3]);
                            *(u32x2*)(SGA + (size_t)rowT * DM + col) = perm2(src4, pk4(v)); }
                }
        }
    }
};

DI void store_partial(float* PB, const AccT& acc, const pg8::Unit& u, int wr, int wc, int tr, int tq, int src4) {
    float* pb = PB + ((size_t)u.split * TS + (size_t)(u.pm * 256 - TP) + wr * 64 + tr) * DM + u.pn * 256 + wc * 32 + 4 * tq;
#pragma unroll
    for (int ai = 0; ai < 2; ++ai)
#pragma unroll
        for (int m = 0; m < 4; ++m)
#pragma unroll
            for (int bj = 0; bj < 2; ++bj)
#pragma unroll
                for (int n = 0; n < 2; ++n) *(f32x4*)(pb + (size_t)(128 * ai + 16 * m) * DM + 128 * bj + 16 * n) = perm4(src4, acc[ai][bj][m][n]);
}

struct Epi3 {
    const float *xp, *xs, *gffn; float* Y; bf16_t* A2; float* SSQ; float* PB;
    DI void operator()(const AccT& acc, const pg8::Unit& u, int wr, int wc, int fr, int fq) const {
        asm volatile("" : "+v"(fr), "+v"(fq));
        const int lane = fr + 16 * fq, tr = lane >> 2, tq = lane & 3, src4 = (tr + 16 * tq) * 4;
        if (u.split >= 0) { store_partial(PB, acc, u, wr, wc, tr, tq, src4); return; }
        const int rowT0 = u.pm * 256 + wr * 64 + tr, colT0 = u.pn * 256 + wc * 32 + 4 * tq;
        const float* xb = u.pm < 32 ? xp : xs - (size_t)TP * DM;
        f32x4 gv[2][2];
#pragma unroll
        for (int bj = 0; bj < 2; ++bj)
#pragma unroll
            for (int n = 0; n < 2; ++n) gv[bj][n] = *(const f32x4*)(gffn + colT0 + 128 * bj + 16 * n);
#pragma unroll
        for (int aim = 0; aim < 4; ++aim) {
            const int ai = aim >> 1, mh = (aim & 1) * 2;
            f32x4 xv[4][2][2];
#pragma unroll
            for (int m = mh; m < mh + 2; ++m)
#pragma unroll
                for (int bj = 0; bj < 2; ++bj)
#pragma unroll
                    for (int n = 0; n < 2; ++n) xv[m][bj][n] = *(const f32x4*)(xb + (size_t)(rowT0 + 128 * ai + 16 * m) * DM + colT0 + 128 * bj + 16 * n);
#pragma unroll
            for (int m = mh; m < mh + 2; ++m) {
                const int rowT = rowT0 + 128 * ai + 16 * m; float ssq = 0.f;
#pragma unroll
                for (int bj = 0; bj < 2; ++bj)
#pragma unroll
                    for (int n = 0; n < 2; ++n) { const size_t off = (size_t)rowT * DM + colT0 + 128 * bj + 16 * n;
                        const f32x4 y = xv[m][bj][n] + perm4(src4, acc[ai][bj][m][n]);
                        ssq += (y[0] * y[0] + y[1] * y[1]) + (y[2] * y[2] + y[3] * y[3]);
                        *(f32x4*)(Y + off) = y; *(u32x2*)(A2 + off) = pk4(y * gv[bj][n]); }
                ssq += __shfl_xor(ssq, 1); ssq += __shfl_xor(ssq, 2);
                if (tq == 0) SSQ[(size_t)rowT * 32 + u.pn * 4 + wc] = ssq;
            }
        }
    }
};

struct Epi4 {
    const float* RSTD; bf16_t* HID;
    DI void operator()(const AccT& acc, const pg8::Unit& u, int wr, int wc, int fr, int fq) const {
        asm volatile("" : "+v"(fr), "+v"(fq));
        const int lane = fr + 16 * fq, tr = lane >> 2, tq = lane & 3, src4 = (tr + 16 * tq) * 4;
        const int row0 = u.pm * 256 + wr * 64 + fr, rowT0 = u.pm * 256 + wr * 64 + tr, colT0 = u.pn * 128 + wc * 32 + 4 * tq;
        float rs[2][4];
#pragma unroll
        for (int ai = 0; ai < 2; ++ai)
#pragma unroll
            for (int m = 0; m < 4; ++m) rs[ai][m] = RSTD[row0 + 128 * ai + 16 * m];
#pragma unroll
        for (int ai = 0; ai < 2; ++ai)
#pragma unroll
            for (int m = 0; m < 4; ++m) {
                const int rowT = rowT0 + 128 * ai + 16 * m;
                const float rstd = rs[ai][m];
#pragma unroll
                for (int n = 0; n < 2; ++n) { const f32x4 g = acc[ai][0][m][n] * rstd, up = acc[ai][1][m][n] * rstd;
                    f32x4 h; h[0] = g[0] * sigmoidf_(g[0]) * up[0]; h[1] = g[1] * sigmoidf_(g[1]) * up[1]; h[2] = g[2] * sigmoidf_(g[2]) * up[2]; h[3] = g[3] * sigmoidf_(g[3]) * up[3];
                    *(u32x2*)(HID + (size_t)rowT * DFF + colT0 + 16 * n) = perm2(src4, pk4(h)); }
            }
    }
};

struct Epi5 {
    float* Y; float* PB;
    DI void operator()(const AccT& acc, const pg8::Unit& u, int wr, int wc, int fr, int fq) const {
        asm volatile("" : "+v"(fr), "+v"(fq));
        const int lane = fr + 16 * fq, tr = lane >> 2, tq = lane & 3, src4 = (tr + 16 * tq) * 4;
        if (u.split >= 0) { store_partial(PB, acc, u, wr, wc, tr, tq, src4); return; }
        float* yb = Y + (size_t)(u.pm * 256 + wr * 64 + tr) * DM + u.pn * 256 + wc * 32 + 4 * tq;
        f32x4 cur[2][2], nxt[2][2];
#pragma unroll
        for (int bj = 0; bj < 2; ++bj)
#pragma unroll
            for (int n = 0; n < 2; ++n) cur[bj][n] = *(const f32x4*)(yb + 128 * bj + 16 * n);
#pragma unroll
        for (int k = 0; k < 8; ++k) {
            const int ai = k >> 2, m = k & 3;
            if (k < 7) { const int a2 = (k + 1) >> 2, m2 = (k + 1) & 3;
#pragma unroll
                for (int bj = 0; bj < 2; ++bj)
#pragma unroll
                    for (int n = 0; n < 2; ++n) nxt[bj][n] = *(const f32x4*)(yb + (size_t)(128 * a2 + 16 * m2) * DM + 128 * bj + 16 * n); }
#pragma unroll
            for (int bj = 0; bj < 2; ++bj)
#pragma unroll
                for (int n = 0; n < 2; ++n) *(f32x4*)(yb + (size_t)(128 * ai + 16 * m) * DM + 128 * bj + 16 * n) = cur[bj][n] + perm4(src4, acc[ai][bj][m][n]);
#pragma unroll
            for (int bj = 0; bj < 2; ++bj)
#pragma unroll
                for (int n = 0; n < 2; ++n) cur[bj][n] = nxt[bj][n];
        }
    }
};

DI void p0_transpose_item(const float* W, int K, int N, bf16_t* WT, int src_n0, int dst_n0, int k0, LAS float* scr, int lane) {
#pragma unroll 8
    for (int i = 0; i < 32; ++i) { const int kk = 2 * i + (lane >> 5); scr[kk * 33 + (lane & 31)] = W[(size_t)(k0 + kk) * N + src_n0 + (lane & 31)]; }
    asm volatile("s_waitcnt lgkmcnt(0)" ::: "memory");
    const int c = lane & 7;
#pragma unroll
    for (int j = 0; j < 4; ++j) { const int n = (lane >> 3) + 8 * j; const LAS float* s = scr + (8 * c) * 33 + n;
        u32x4 o; o.x = pk2(s[0 * 33], s[1 * 33]); o.y = pk2(s[2 * 33], s[3 * 33]); o.z = pk2(s[4 * 33], s[5 * 33]); o.w = pk2(s[6 * 33], s[7 * 33]);
        *(u32x4*)(WT + (size_t)(dst_n0 + n) * K + k0 + 8 * c) = o; }
    asm volatile("s_waitcnt lgkmcnt(0)" ::: "memory");
}

DI void p0_rest(const Params& p, LAS unsigned char* lds, int wid, int lane, int worker, int nworkers) {
    LAS float* scr = (LAS float*)(lds + wid * 8704);
    const int gw = worker * 8 + wid, NGW = nworkers * 8;
    bf16_t* WoutT = (bf16_t*)(p.ws + WS_WOUT); bf16_t* WguT = (bf16_t*)(p.ws + WS_WGU); bf16_t* WdnT = (bf16_t*)(p.ws + WS_WDN);
    constexpr int I_OUT = (DM / 64) * (DM / 32), I_GU = (DM / 64) * (NGU / 32), I_DN = (DFF / 64) * (DM / 32);
    for (int it = gw; it < I_OUT + I_GU + I_DN; it += NGW) {
        int r = it;
        if (r < I_OUT) { const int nblk = DM / 32, kb = r / nblk, nb = r % nblk; p0_transpose_item(p.w_out, DM, DM, WoutT, 32 * nb, 32 * nb, 64 * kb, scr, lane); continue; } r -= I_OUT;
        if (r < I_GU) { const int nblk = NGU / 32, kb = r / nblk, nb = r % nblk; p0_transpose_item(p.w_gu, DM, NGU, WguT, src_col_gu(32 * nb), 32 * nb, 64 * kb, scr, lane); continue; } r -= I_GU;
        { const int nblk = DM / 32, kb = r / nblk, nb = r % nblk; p0_transpose_item(p.w_dn, DFF, DM, WdnT, 32 * nb, 32 * nb, 64 * kb, scr, lane); }
    }
}

DI void p0_prologue(const Params& p, LAS unsigned char* lds, int wid, int lane) {
    LAS float* scr = (LAS float*)(lds + wid * 8704);
    const int gw = blockIdx.x * 8 + wid, NGW = gridDim.x * 8;
    bf16_t* WinT = (bf16_t*)(p.ws + WS_WIN);
    constexpr int I_IN = (DM / 64) * (DIN / 32);
    for (int it = gw; it < I_IN; it += NGW) { const int nblk = DIN / 32, kb = it / nblk, nb = it % nblk; p0_transpose_item(p.w_in, DM, DIN, WinT, src_col_in(32 * nb), 32 * nb, 64 * kb, scr, lane); }
    bf16_t* XN = (bf16_t*)(p.ws + WS_XN);
    for (int m = gw; m < MT; m += NGW) {
        const float* xrow = m < TP ? p.xp + (size_t)m * DM : p.xs + (size_t)(m - TP) * DM;
        const f32x4* xr = (const f32x4*)xrow + lane; f32x4 v[8]; float s = 0.f;
#pragma unroll
        for (int j = 0; j < 8; ++j) { v[j] = xr[64 * j]; s += (v[j][0] * v[j][0] + v[j][1] * v[j][1]) + (v[j][2] * v[j][2] + v[j][3] * v[j][3]); }
        const float rstd = 1.0f / sqrtf(wave_sum(s) * (1.0f / DM) + EPS);
        u32x2* o8 = (u32x2*)(XN + (size_t)m * DM) + lane;
#pragma unroll
        for (int j = 0; j < 8; ++j) { const f32x4 gv = ((const f32x4*)p.norm_mix)[64 * j + lane]; o8[64 * j] = pk4(v[j] * rstd * gv); }
    }
    float* cosT = (float*)(p.ws + WS_COS); float* sinT = (float*)(p.ws + WS_SIN);
    const int gt = blockIdx.x * 512 + threadIdx.x, GT = gridDim.x * 512;
    for (int idx = gt; idx < NPOS * 32; idx += GT) {
        const int pos = idx >> 5, i = idx & 31;
        const float inv = __builtin_amdgcn_exp2f(-(float)i * (13.287712379549449f / 32.0f));
        const float ang = (float)pos * inv;
        const double rev = (double)ang * 0.15915494309189535; const float fr = (float)(rev - __builtin_floor(rev));
        cosT[idx] = __builtin_amdgcn_cosf(fr); sinT[idx] = __builtin_amdgcn_sinf(fr);
    }
}

DI void cache_copy(const Params& p, int worker, int nworkers) {
    const int gt = worker * 512 + threadIdx.x, GT = nworkers * 512;
    for (int idx = gt; idx < 128 * 7936; idx += GT) {
        const int b = idx / 7936, e = idx - b * 7936;
        ((f32x4*)(p.out + O_SK + (size_t)b * 32768))[e] = ((const f32x4*)(p.ck + (size_t)b * 32768 + 1024))[e];
        ((f32x4*)(p.out + O_SV + (size_t)b * 32768))[e] = ((const f32x4*)(p.cv + (size_t)b * 32768 + 1024))[e];
    }
}

#define MFMA32(a, b, c) __builtin_amdgcn_mfma_f32_32x32x16_bf16((a), (b), (c), 0, 0, 0)
DI int crow(int reg, int h) { return (reg & 3) + 8 * (reg >> 2) + 4 * h; }
DI bf16x8 pack8(const f32x16& x, int s) {
    u32x4 p; p.x = pk2(x[8 * s], x[8 * s + 1]); p.y = pk2(x[8 * s + 2], x[8 * s + 3]); p.z = pk2(x[8 * s + 4], x[8 * s + 5]); p.w = pk2(x[8 * s + 6], x[8 * s + 7]);
    return __builtin_bit_cast(bf16x8, p);
}
DI bf16x8 cvt8(f32x4 a, f32x4 b) { u32x4 p; p.x = pk2(a[0], a[1]); p.y = pk2(a[2], a[3]); p.z = pk2(b[0], b[1]); p.w = pk2(b[2], b[3]); return __builtin_bit_cast(bf16x8, p); }

constexpr int KS_STRIDE = 72, VT_STRIDE = 260, VT_OFF = 256 * KS_STRIDE * 2;

template <bool SAMPLE>
DI void attn_chunk(const Params& p, LAS unsigned char* lds, int qb, int c, int kvh, int head_w, int b_s, int lane) {
    const bf16_t* Q = (const bf16_t*)(p.ws + WS_Q); const bf16_t* Kb = (const bf16_t*)(p.ws + WS_K); const bf16_t* Vb = (const bf16_t*)(p.ws + WS_V);
    const bf16_t* U = (const bf16_t*)(p.ws + WS_U); const bf16_t* BG = (const bf16_t*)(p.ws + WS_BG); const bf16_t* SGA = (const bf16_t*)(p.ws + WS_SGA);
    bf16_t* MIX = (bf16_t*)(p.ws + WS_MIX);
    const int r = lane & 31, g = lane >> 5;
    int tok, head, itok = 0;
    if (SAMPLE) { itok = r >> 3; head = kvh * 8 + (r & 7); tok = TP + 4 * b_s + itok; }
    else { head = head_w; tok = 128 * qb + 32 * c + r; }
    const LAS bf16_t* Ks = (const LAS bf16_t*)lds; const LAS bf16_t* Vt = (const LAS bf16_t*)(lds + VT_OFF);
    bf16x8 qf[4];
#pragma unroll
    for (int ks = 0; ks < 4; ++ks) qf[ks] = *(const bf16x8*)(Q + (size_t)tok * DM + head * 64 + 16 * ks + 8 * g);
    f32x16 s[5];
#pragma unroll
    for (int kbr = 0; kbr < 5; ++kbr) {
#pragma unroll
        for (int i = 0; i < 16; ++i) s[kbr][i] = 0.f;
#pragma unroll
        for (int ks = 0; ks < 4; ++ks) {
            bf16x8 a;
            if (SAMPLE) {
                if (kbr < 4) { const float* kp = p.ck + ((size_t)(b_s * 128 + 32 * kbr + r) * 4 + kvh) * 64 + 16 * ks + 8 * g; a = cvt8(*(const f32x4*)kp, *(const f32x4*)(kp + 4)); }
                else { u32x4 z = (u32x4){0u, 0u, 0u, 0u}; if (r < 4) z = *(const u32x4*)(Kb + (size_t)(TP + 4 * b_s + r) * 256 + kvh * 64 + 16 * ks + 8 * g); a = __builtin_bit_cast(bf16x8, z); }
            } else a = *(const LAS bf16x8*)(Ks + (32 * (c + kbr) + r) * KS_STRIDE + 16 * ks + 8 * g);
            s[kbr] = MFMA32(a, qf[ks], s[kbr]);
        }
    }
    const float sc = 0.125f * 1.44269504089f;
    const float sink2 = p.sinks[head] * 1.44269504089f;
    float mraw = -1e30f;
#pragma unroll
    for (int kbr = 0; kbr < 5; ++kbr)
#pragma unroll
        for (int i = 0; i < 16; ++i) {
            const int kr = crow(i, g); bool valid;
            if (SAMPLE) valid = kbr < 4 ? (32 * kbr + kr > itok) : (kr <= itok);
            else { valid = kbr == 0 ? (kr > r) : (kbr == 4 ? (kr <= r) : true); if (qb == 0 && c + kbr < 4) valid = false; }
            const float t = valid ? s[kbr][i] : -1e30f; s[kbr][i] = t; mraw = fmaxf(mraw, t);
        }
    mraw = fmaxf(mraw, __shfl_xor(mraw, 32));
    const float mx = fmaxf(mraw * sc, sink2);
    float sum = 0.f;
#pragma unroll
    for (int kbr = 0; kbr < 5; ++kbr)
#pragma unroll
        for (int i = 0; i < 16; ++i) { const float e = __builtin_amdgcn_exp2f(__builtin_fmaf(s[kbr][i], sc, -mx)); s[kbr][i] = e; sum += e; }
    sum += __shfl_xor(sum, 32);
    const float inv = 1.0f / (sum + __builtin_amdgcn_exp2f(sink2 - mx));
    f32x16 o[2];
#pragma unroll
    for (int dt = 0; dt < 2; ++dt)
#pragma unroll
        for (int i = 0; i < 16; ++i) o[dt][i] = 0.f;
#pragma unroll
    for (int kbr = 0; kbr < 5; ++kbr)
#pragma unroll
        for (int kk = 0; kk < 2; ++kk) {
            const bf16x8 pb = pack8(s[kbr], kk);
#pragma unroll
            for (int dt = 0; dt < 2; ++dt) {
                bf16x8 a; const int d = 32 * dt + r;
                if (SAMPLE) {
                    if (kbr < 4) { float f[8];
#pragma unroll
                        for (int j = 0; j < 8; ++j) { const int key = 32 * kbr + 16 * kk + 8 * (j >> 2) + 4 * g + (j & 3); f[j] = p.cv[((size_t)(b_s * 128 + key) * 4 + kvh) * 64 + d]; }
                        a = cvt8((f32x4){f[0], f[1], f[2], f[3]}, (f32x4){f[4], f[5], f[6], f[7]});
                    } else { u32x4 z = (u32x4){0u, 0u, 0u, 0u};
                        if (kk == 0 && g == 0) { const bf16_t* vp = Vb + (size_t)(TP + 4 * b_s) * 256 + kvh * 64 + d; z.x = (unsigned)vp[0] | ((unsigned)vp[256] << 16); z.y = (unsigned)vp[512] | ((unsigned)vp[768] << 16); }
                        a = __builtin_bit_cast(bf16x8, z); }
                } else {
                    const LAS bf16_t* vp = Vt + d * VT_STRIDE + 32 * (c + kbr) + 16 * kk + 4 * g;
                    const s16x4 lo = *(const LAS s16x4*)vp, hi = *(const LAS s16x4*)(vp + 8);
                    a = __builtin_shufflevector(lo, hi, 0, 1, 2, 3, 4, 5, 6, 7);
                }
                o[dt] = MFMA32(a, pb, o[dt]);
            }
        }
    if (!SAMPLE) {
#pragma unroll
        for (int dt = 0; dt < 2; ++dt)
#pragma unroll
            for (int i4 = 0; i4 < 4; ++i4) {
                const int col = head * 64 + 32 * dt + 8 * i4 + 4 * g;
                const f32x4 at = (f32x4){o[dt][4 * i4], o[dt][4 * i4 + 1], o[dt][4 * i4 + 2], o[dt][4 * i4 + 3]} * inv;
                *(u32x2*)(MIX + (size_t)tok * DM + col) = pk4(at);
            }
        return;
    }
#pragma unroll
    for (int dt = 0; dt < 2; ++dt) {
        u32x2 lsga[4], lbg[4], lu0[4]; f32x4 lu1[4], lu2[4], w0[4], w1[4], w2[4];
#pragma unroll
        for (int i4 = 0; i4 < 4; ++i4) {
            const int col = head * 64 + 32 * dt + 8 * i4 + 4 * g; const size_t off = (size_t)tok * DM + col;
            lsga[i4] = *(const u32x2*)(SGA + off); lbg[i4] = *(const u32x2*)(BG + off); lu0[i4] = *(const u32x2*)(U + off);
            lu1[i4] = itok >= 1 ? unpk4(*(const u32x2*)(U + off - DM)) : *(const f32x4*)(p.sconv + (size_t)b_s * 4096 + DM + col);
            lu2[i4] = itok >= 2 ? unpk4(*(const u32x2*)(U + off - 2 * DM)) : *(const f32x4*)(p.sconv + (size_t)b_s * 4096 + (size_t)itok * DM + col);
            w0[i4] = *(const f32x4*)(p.conv_w + col); w1[i4] = *(const f32x4*)(p.conv_w + DM + col); w2[i4] = *(const f32x4*)(p.conv_w + 2 * DM + col);
        }
#pragma unroll
        for (int i4 = 0; i4 < 4; ++i4) {
            const int col = head * 64 + 32 * dt + 8 * i4 + 4 * g; const size_t off = (size_t)tok * DM + col;
            const f32x4 at = (f32x4){o[dt][4 * i4], o[dt][4 * i4 + 1], o[dt][4 * i4 + 2], o[dt][4 * i4 + 3]} * inv;
            const f32x4 conv = w0[i4] * lu2[i4] + w1[i4] * lu1[i4] + w2[i4] * unpk4(lu0[i4]);
            *(u32x2*)(MIX + off) = pk4(unpk4(lsga[i4]) * at + unpk4(lbg[i4]) * conv);
        }
    }
}

DI void unpk8(u32x4 w, f32x4& lo, f32x4& hi) { lo = (f32x4){bf_lo(w.x), bf_hi(w.x), bf_lo(w.y), bf_hi(w.y)}; hi = (f32x4){bf_lo(w.z), bf_hi(w.z), bf_lo(w.w), bf_hi(w.w)}; }

constexpr int P2_CNT_OFF = 120000;
DI void p2_attention(const Params& p, LAS unsigned char* lds, int tid, int wid, int lane) {
    const bf16_t* Kb = (const bf16_t*)(p.ws + WS_K); const bf16_t* Vb = (const bf16_t*)(p.ws + WS_V);
    const bf16_t* U = (const bf16_t*)(p.ws + WS_U); const bf16_t* BG = (const bf16_t*)(p.ws + WS_BG); const bf16_t* SGA = (const bf16_t*)(p.ws + WS_SGA);
    bf16_t* MIX = (bf16_t*)(p.ws + WS_MIX);
    LAS bf16_t* Ks = (LAS bf16_t*)lds; LAS bf16_t* Vt = (LAS bf16_t*)(lds + VT_OFF);
    LAS unsigned* cnt = (LAS unsigned*)(lds + P2_CNT_OFF);
    int samp_next = blockIdx.x * 2;
    for (int item = blockIdx.x; item < 256; item += gridDim.x) {
        const int qb = item >> 2, kvh = item & 3;
        __syncthreads();
#pragma unroll
        for (int i = 0; i < 4; ++i) {
            const int e = tid + 512 * i, row = e >> 3, c8 = e & 7, tok = 128 * (qb - 1) + row;
            u32x4 kv = (u32x4){0u, 0u, 0u, 0u}, vv = (u32x4){0u, 0u, 0u, 0u};
            if (tok >= 0) { kv = *(const u32x4*)(Kb + (size_t)tok * 256 + kvh * 64 + 8 * c8); vv = *(const u32x4*)(Vb + (size_t)tok * 256 + kvh * 64 + 8 * c8); }
            *(LAS u32x4*)(Ks + row * KS_STRIDE + 8 * c8) = kv;
#pragma unroll
            for (int jj = 0; jj < 8; ++jj) Vt[(8 * c8 + jj) * VT_STRIDE + row] = (bf16_t)(vv[jj >> 1] >> (16 * (jj & 1)));
        }
        if (tid == 0) *cnt = 0u;
        __syncthreads();
        const int ns = (samp_next < 512) ? ((samp_next + 1 < 512) ? 2 : 1) : 0;
        for (;;) {
            unsigned t = 0; if (lane == 0) t = __hip_atomic_fetch_add(cnt, 1u, __ATOMIC_RELAXED, __HIP_MEMORY_SCOPE_WORKGROUP);
            t = __builtin_amdgcn_readfirstlane(t);
            if ((int)t >= ns + 32) break;
            if ((int)t < ns) { const int it = samp_next + (int)t; attn_chunk<true>(p, lds, 0, 0, it & 3, 0, it >> 2, lane); }
            else { const int pc = (int)t - ns; attn_chunk<false>(p, lds, qb, pc & 3, kvh, kvh * 8 + (pc >> 2), 0, lane); }
        }
        samp_next += gridDim.x * 2;
        asm volatile("s_waitcnt vmcnt(0)" ::: "memory");
        __syncthreads();
        __builtin_amdgcn_fence(__ATOMIC_ACQUIRE, "agent");
        {
            const int c8 = tid & 63, rbase = tid >> 6, col = kvh * 512 + 8 * c8;
            f32x4 w[3][2];
#pragma unroll
            for (int k = 0; k < 3; ++k) { w[k][0] = *(const f32x4*)(p.conv_w + k * DM + col); w[k][1] = *(const f32x4*)(p.conv_w + k * DM + col + 4); }
#pragma unroll
            for (int ib = 0; ib < 4; ++ib) {
                u32x4 la[4], ls[4], lb[4], l0[4], l1[4], l2[4];
#pragma unroll
                for (int ii = 0; ii < 4; ++ii) {
                    const int tok = 128 * qb + rbase + 8 * (4 * ib + ii); const size_t off = (size_t)tok * DM + col;
                    la[ii] = *(const u32x4*)(MIX + off); ls[ii] = *(const u32x4*)(SGA + off); lb[ii] = *(const u32x4*)(BG + off); l0[ii] = *(const u32x4*)(U + off);
                    l1[ii] = (u32x4){0u, 0u, 0u, 0u}; l2[ii] = (u32x4){0u, 0u, 0u, 0u};
                    if (tok >= 1) l1[ii] = *(const u32x4*)(U + off - DM);
                    if (tok >= 2) l2[ii] = *(const u32x4*)(U + off - 2 * DM);
                }
#pragma unroll
                for (int ii = 0; ii < 4; ++ii) {
                    const int tok = 128 * qb + rbase + 8 * (4 * ib + ii); const size_t off = (size_t)tok * DM + col;
                    f32x4 a0, a1, s0, s1, b0, b1, x0, x1, y0, y1, z0, z1;
                    unpk8(la[ii], a0, a1); unpk8(ls[ii], s0, s1); unpk8(lb[ii], b0, b1); unpk8(l0[ii], x0, x1); unpk8(l1[ii], y0, y1); unpk8(l2[ii], z0, z1);
                    const f32x4 m0 = s0 * a0 + b0 * (w[0][0] * z0 + w[1][0] * y0 + w[2][0] * x0);
                    const f32x4 m1 = s1 * a1 + b1 * (w[0][1] * z1 + w[1][1] * y1 + w[2][1] * x1);
                    u32x4 o; o.x = pk2(m0[0], m0[1]); o.y = pk2(m0[2], m0[3]); o.z = pk2(m1[0], m1[1]); o.w = pk2(m1[2], m1[3]);
                    *(u32x4*)(MIX + off) = o;
                }
            }
        }
    }
    for (int it = samp_next + (wid & 1); it < 512 && wid < 2; it += gridDim.x * 2) attn_chunk<true>(p, lds, 0, 0, it & 3, 0, it >> 2, lane);
}

DI void p3_reduce(const Params& p, int wid, int lane) {
    const float* PB = (const float*)(p.ws + WS_PB); bf16_t* A2 = (bf16_t*)(p.ws + WS_A2); const float* SSQ = (const float*)(p.ws + WS_SSQ); float* RSTD = (float*)(p.ws + WS_RSTD);
    for (int r = blockIdx.x * 8 + wid; r < TS; r += gridDim.x * 8) {
        const int row = TP + r; f32x4 y[8]; float s = 0.f;
#pragma unroll
        for (int j = 0; j < 8; ++j) { const size_t o = (size_t)r * DM + 256 * j + 4 * lane;
            y[j] = *(const f32x4*)(p.xs + o) + ((*(const f32x4*)(PB + o) + *(const f32x4*)(PB + (size_t)TS * DM + o)) + (*(const f32x4*)(PB + (size_t)2 * TS * DM + o) + *(const f32x4*)(PB + (size_t)3 * TS * DM + o)));
            s += (y[j][0] * y[j][0] + y[j][1] * y[j][1]) + (y[j][2] * y[j][2] + y[j][3] * y[j][3]); }
        s = wave_sum(s);
#pragma unroll
        for (int j = 0; j < 8; ++j) { const int col = 256 * j + 4 * lane; *(f32x4*)(p.out + (size_t)row * DM + col) = y[j];
            *(u32x2*)(A2 + (size_t)row * DM + col) = pk4(y[j] * *(const f32x4*)(p.norm_ffn + col)); }
        if (lane == 0) RSTD[row] = __builtin_amdgcn_rsqf(s * (1.0f / DM) + EPS);
    }
    for (int row = blockIdx.x * 512 + wid * 64 + lane; row < TP; row += gridDim.x * 512) {
        const f32x4* sp = (const f32x4*)(SSQ + (size_t)row * 32); f32x4 a = sp[0];
#pragma unroll
        for (int k = 1; k < 8; ++k) a += sp[k];
        RSTD[row] = __builtin_amdgcn_rsqf(((a[0] + a[1]) + (a[2] + a[3])) * (1.0f / DM) + EPS);
    }
}
DI void p5_reduce(const Params& p) {
    const float* PB = (const float*)(p.ws + WS_PB);
    for (int i = blockIdx.x * 512 + threadIdx.x; i < TS * DM / 4; i += gridDim.x * 512) { const size_t o = (size_t)i * 4; float* yp = p.out + (size_t)TP * DM + o;
        *(f32x4*)yp = *(const f32x4*)yp + ((*(const f32x4*)(PB + o) + *(const f32x4*)(PB + (size_t)TS * DM + o)) + (*(const f32x4*)(PB + (size_t)2 * TS * DM + o) + *(const f32x4*)(PB + (size_t)3 * TS * DM + o))); }
}

constexpr int LDS_BYTES = pg8::STAGE_BYTES + 16;

__global__ void __launch_bounds__(512, 2) fwd_megakernel(Params p) {
    extern __shared__ __attribute__((aligned(16))) unsigned char lds_raw[];
    LAS unsigned char* lds = (LAS unsigned char*)lds_raw;
    cg::grid_group grid = cg::this_grid();
    if (p.never) grid.sync();
    if (threadIdx.x < 4) ((LAS unsigned*)(lds + pg8::STAGE_BYTES))[threadIdx.x] = 0u;
    __syncthreads();
    const XcdBarrier xb = xcd_barrier_post((unsigned*)(p.ws + WS_BAR), (volatile LAS unsigned*)(lds + pg8::STAGE_BYTES));
    const int tid = threadIdx.x, wid = __builtin_amdgcn_readfirstlane(tid >> 6), lane = tid & 63;
    const int G = gridDim.x, bid = blockIdx.x;
    unsigned char* ws = p.ws;

    p0_prologue(p, lds, wid, lane);
    xcd_barrier(xb);
    {
        pg8::Gemm g{(const bf16_t*)(ws + WS_XN), (const bf16_t*)(ws + WS_WIN), MT, DIN, DM}; pg8::StaticOrder S; S.init(MT, DIN, G, bid);
        Epi1 E{(bf16_t*)(ws + WS_Q), (bf16_t*)(ws + WS_K), (bf16_t*)(ws + WS_V), (bf16_t*)(ws + WS_U), (bf16_t*)(ws + WS_BG), (bf16_t*)(ws + WS_SGA),
               p.q_norm, p.k_norm, (const float*)(ws + WS_COS), (const float*)(ws + WS_SIN), p.out};
        pg8::gemm_phase<Epi1, pg8::StaticOrder>(lds, g, S, E);
        {
            const int nfull = ((MT / 256) * (DIN / 256)) % G;
            if (nfull == 0) p0_rest(p, lds, wid, lane, bid, G);
            else if (bid >= nfull) p0_rest(p, lds, wid, lane, bid - nfull, G - nfull);
        }
    }
    xcd_barrier(xb);
    p2_attention(p, lds, tid, wid, lane);
    xcd_barrier(xb);
    {
        pg8::Gemm g{(const bf16_t*)(ws + WS_MIX), (const bf16_t*)(ws + WS_WOUT), MT, DM, DM}; pg8::SplitOrder S; S.init(DM, G, bid, DM / 64);
        Epi3 E{p.xp, p.xs, p.norm_ffn, p.out, (bf16_t*)(ws + WS_A2), (float*)(ws + WS_SSQ), (float*)(ws + WS_PB)};
        pg8::gemm_phase<Epi3, pg8::SplitOrder>(lds, g, S, E);
    }
    xcd_barrier(xb);
    p3_reduce(p, wid, lane);
    xcd_barrier(xb);
    {
        pg8::Gemm g{(const bf16_t*)(ws + WS_A2), (const bf16_t*)(ws + WS_WGU), MT, NGU, DM}; pg8::StaticOrder S; S.init(MT, NGU, G, bid);
        Epi4 E{(const float*)(ws + WS_RSTD), (bf16_t*)(ws + WS_HID)};
        pg8::gemm_phase<Epi4, pg8::StaticOrder>(lds, g, S, E);
    }
    xcd_barrier(xb);
    {
        pg8::Gemm g{(const bf16_t*)(ws + WS_HID), (const bf16_t*)(ws + WS_WDN), MT, DM, DFF}; pg8::SplitOrder S; S.init(DM, G, bid, DFF / 64);
        Epi5 E{p.out, (float*)(ws + WS_PB)};
        pg8::gemm_phase<Epi5, pg8::SplitOrder>(lds, g, S, E);
        {   const int nfull = S.total() % G;
            if (nfull == 0) cache_copy(p, bid, G); else if (bid >= nfull) cache_copy(p, bid - nfull, G - nfull);
        }
    }
    xcd_barrier(xb);
    p5_reduce(p);
}

extern "C" void kernel_launch(void* const* d_in, const int* in_sizes, int n_in, void* d_out, int out_size, void* d_ws, size_t ws_size, hipStream_t stream) {
    static int grid = 0;
    if (!grid) {
        int dev = 0, cus = 0, per_cu = 0;
        (void)hipGetDevice(&dev);
        (void)hipDeviceGetAttribute(&cus, hipDeviceAttributeMultiprocessorCount, dev);
        (void)hipFuncSetAttribute((const void*)fwd_megakernel, hipFuncAttributeMaxDynamicSharedMemorySize, LDS_BYTES);
        (void)hipOccupancyMaxActiveBlocksPerMultiprocessor(&per_cu, (const void*)fwd_megakernel, 512, LDS_BYTES);
        if (per_cu < 1) per_cu = 1;
        grid = cus * per_cu;
        if (ws_size < WS_END) fprintf(stderr, "kernel_launch: workspace too small (%zu < %zu)\n", ws_size, (size_t)WS_END);
    }
    Params p{};
    p.xp = (const float*)d_in[0]; p.xs = (const float*)d_in[1]; p.ck = (const float*)d_in[2]; p.cv = (const float*)d_in[3]; p.sconv = (const float*)d_in[4];
    p.norm_mix = (const float*)d_in[5]; p.w_in = (const float*)d_in[6]; p.q_norm = (const float*)d_in[7]; p.k_norm = (const float*)d_in[8]; p.sinks = (const float*)d_in[9];
    p.conv_w = (const float*)d_in[10]; p.w_out = (const float*)d_in[11]; p.norm_ffn = (const float*)d_in[12]; p.w_gu = (const float*)d_in[13]; p.w_dn = (const float*)d_in[14];
    p.out = (float*)d_out; p.ws = (unsigned char*)d_ws;
    p.never = 0;
    (void)hipMemsetAsync((char*)d_ws + WS_BAR, 0, 16384, stream);
    void* args[] = {&p};
    hipError_t e = hipLaunchCooperativeKernel((const void*)fwd_megakernel, dim3(grid), dim3(512), args, LDS_BYTES, stream);
    if (e != hipSuccess) fprintf(stderr, "cooperative launch failed: %s (grid %d)\n", hipGetErrorString(e), grid);
}
```

```cpp
#include <hip/hip_runtime.h>
#include <hip/hip_cooperative_groups.h>
#include <cstdio>
namespace cg = cooperative_groups;
#define REP_P0 1
#define REP_P1 1
#define REP_P2 1
#define REP_P3 1
#define REP_P4 1
#define REP_SYNC 0

#define LAS __attribute__((address_space(3)))
#define DI __device__ __forceinline__
typedef unsigned short bf16_t;
typedef short bf16x8 __attribute__((ext_vector_type(8)));
typedef short s16x4 __attribute__((ext_vector_type(4)));
typedef float f32x4 __attribute__((ext_vector_type(4)));
typedef float f32x16 __attribute__((ext_vector_type(16)));
typedef unsigned u32x4 __attribute__((ext_vector_type(4)));
typedef unsigned u32x2 __attribute__((ext_vector_type(2)));

constexpr int DM = 2048, TP = 8192, TS = 512, MT = TP + TS, DIN = 12800, DFF = 5632, NGU = 2 * DFF;
constexpr float EPS = 1e-6f;
constexpr int NPOS = 8196;
constexpr size_t O_YP = 0, O_YS = (size_t)TP * DM, O_PK = O_YS + (size_t)TS * DM, O_PV = O_PK + 32768, O_PC = O_PV + 32768,
                 O_SK = O_PC + 4096, O_SV = O_SK + 4194304, O_SC = O_SV + 4194304;
constexpr size_t WS_WIN = 0, WS_WOUT = WS_WIN + (size_t)DIN * DM * 2, WS_WGU = WS_WOUT + (size_t)DM * DM * 2, WS_WDN = WS_WGU + (size_t)NGU * DM * 2,
                 WS_XN = WS_WDN + (size_t)DM * DFF * 2, WS_Q = WS_XN + (size_t)MT * DM * 2, WS_K = WS_Q + (size_t)MT * DM * 2, WS_V = WS_K + (size_t)MT * 256 * 2,
                 WS_U = WS_V + (size_t)MT * 256 * 2, WS_BG = WS_U + (size_t)MT * DM * 2, WS_SGA = WS_BG + (size_t)MT * DM * 2, WS_COS = WS_SGA + (size_t)MT * DM * 2,
                 WS_SIN = WS_COS + (size_t)NPOS * 32 * 4, WS_SSQ = WS_SIN + (size_t)NPOS * 32 * 4, WS_BAR = WS_SSQ + (size_t)MT * 32 * 4, WS_RSTD = WS_BAR + 16384, WS_PB = WS_RSTD + 65536, WS_END = WS_PB + (size_t)4 * TS * DM * 4;
constexpr size_t WS_MIX = WS_XN, WS_A2 = WS_Q, WS_HID = WS_U;
static_assert((size_t)MT * DFF * 2 <= 3 * (size_t)MT * DM * 2, "hidden fits in U|BG|SGA");

struct Params {
    const float *xp, *xs, *ck, *cv, *sconv, *norm_mix, *w_in, *q_norm, *k_norm, *sinks, *conv_w, *w_out, *norm_ffn, *w_gu, *w_dn;
    float* out; unsigned char* ws; long never;
};

typedef float f32x2 __attribute__((ext_vector_type(2)));
typedef __bf16 bf16x2v __attribute__((ext_vector_type(2)));
DI unsigned pk2(float lo, float hi) { const f32x2 f = {lo, hi}; return __builtin_bit_cast(unsigned, __builtin_convertvector(f, bf16x2v)); }
DI u32x2 pk4(f32x4 v) { u32x2 r; r.x = pk2(v[0], v[1]); r.y = pk2(v[2], v[3]); return r; }
DI float bf_lo(unsigned w) { return __uint_as_float(w << 16); }
DI float bf_hi(unsigned w) { return __uint_as_float(w & 0xffff0000u); }
DI f32x4 unpk4(u32x2 w) { return (f32x4){bf_lo(w.x), bf_hi(w.x), bf_lo(w.y), bf_hi(w.y)}; }
DI float sigmoidf_(float x) { return __builtin_amdgcn_rcpf(1.0f + __builtin_amdgcn_exp2f(-1.44269504089f * x)); }
DI float wave_sum(float v) {
#pragma unroll
    for (int o = 1; o < 64; o <<= 1) v += __shfl_xor(v, o);
    return v;
}


#define XB_TMO      128
#define XB_XCNT(j)  (256  + 64 * (j))
#define XB_XSUB(j)  (1280 + 64 * (j))
#define XB_XGEN(j)  (2304 + 64 * (j))
#define XB_TOP      3328
#define XB_TOPGEN   3392
#define XCD_BAR_WORDS 3456
#define XB_SPIN_CAP (1u << 20)
DI unsigned xb_ld(unsigned* p)              { return __hip_atomic_load(p, __ATOMIC_RELAXED, __HIP_MEMORY_SCOPE_AGENT); }
DI unsigned xb_add(unsigned* p, unsigned v) { return __hip_atomic_fetch_add(p, v, __ATOMIC_RELAXED, __HIP_MEMORY_SCOPE_AGENT); }
DI unsigned xb_xcc_id() { return (unsigned)__builtin_amdgcn_s_getreg((3 << 11) | 20) & 0xFu; }
#define XB_SPIN(cond, bar) do { unsigned _sp = 0; while (cond) { __builtin_amdgcn_s_sleep(1); \
    if ((++_sp & 255u) == 0u) { if (xb_ld(&(bar)[XB_TMO])) break; if (_sp > XB_SPIN_CAP) { atomicAdd(&(bar)[XB_TMO], 1u); break; } } } } while (0)
struct XcdBarrier { unsigned* bar; unsigned x; volatile LAS unsigned* st; };
DI XcdBarrier xcd_barrier_post(unsigned* bar, volatile LAS unsigned* st) {
    XcdBarrier b; b.bar = bar; b.x = xb_xcc_id(); b.st = st;
    if (threadIdx.x == 0) (void)xb_add(&bar[XB_XCNT(b.x)], 1u);
    return b;
}
DI void xcd_barrier_complete(unsigned* bar, unsigned x, unsigned& nloc, unsigned& nx) {
    const unsigned G = gridDim.x * gridDim.y * gridDim.z;
    unsigned sum, cnt, mine, sp = 0u;
    for (;;) {
        sum = 0u; cnt = 0u; mine = 0u;
#pragma unroll
        for (unsigned j = 0; j < 16; ++j) { const unsigned c = xb_ld(&bar[XB_XCNT(j)]); sum += c; cnt += (c > 0u) ? 1u : 0u; mine = (j == x) ? c : mine; }
        if (sum == G) break;
        __builtin_amdgcn_s_sleep(1);
        if ((++sp & 255u) == 0u) { if (xb_ld(&bar[XB_TMO])) break; if (sp > XB_SPIN_CAP) { atomicAdd(&bar[XB_TMO], 1u); break; } }
    }
    nloc = mine > 0u ? mine : 1u; nx = cnt > 0u ? cnt : 1u;
}
DI void xcd_barrier(const XcdBarrier& b) {
    asm volatile("s_waitcnt vmcnt(0)" ::: "memory");
    __syncthreads();
    if (threadIdx.x == 0) {
        unsigned* bar = b.bar;
        __builtin_amdgcn_s_waitcnt(0);
        unsigned nloc = b.st[0], nx = b.st[1];
        if (nloc == 0u) { xcd_barrier_complete(bar, b.x, nloc, nx); b.st[0] = nloc; b.st[1] = nx; }
        const unsigned old = xb_add(&bar[XB_XSUB(b.x)], 1u);
        const unsigned gen = old / nloc;
        if (old + 1u == (gen + 1u) * nloc) {
            __builtin_amdgcn_fence(__ATOMIC_RELEASE, "agent");
            asm volatile("s_waitcnt vmcnt(0)" ::: "memory");
            const unsigned og = xb_add(&bar[XB_TOP], 1u);
            const unsigned tg = og / nx;
            if (og + 1u == (tg + 1u) * nx) xb_add(&bar[XB_TOPGEN], 1u);
            else XB_SPIN(xb_ld(&bar[XB_TOPGEN]) == tg, bar);
            __builtin_amdgcn_fence(__ATOMIC_ACQUIRE, "agent");
            xb_add(&bar[XB_XGEN(b.x)], 1u);
            asm volatile("s_waitcnt vmcnt(0)" ::: "memory");
        } else {
            XB_SPIN(xb_ld(&bar[XB_XGEN(b.x)]) == gen, bar);
            __builtin_amdgcn_fence(__ATOMIC_ACQUIRE, "agent");
            asm volatile("s_waitcnt vmcnt(0)" ::: "memory");
        }
    }
    __syncthreads();
}

namespace pg8 {
constexpr int BM = 256, BK = 64, HALF = 128, HTB = HALF * BK * 2, STAGE_BYTES = 8 * HTB, NXCD = 8, WGM = 8;
DI int lds_byte(int r, int c) { const int st = (r >> 4) * 2 + (c >> 5), rr = r & 15, cc = c & 31, ob = rr * 64 + cc * 2; return st * 1024 + (ob ^ (((ob >> 9) & 1) << 5)); }
DI void stage_rc(int b, int& R, int& C) { const int st = b / 1024, sb = b % 1024, swz = sb ^ (((sb >> 9) & 1) << 5); R = (st >> 1) * 16 + swz / 64; C = (st & 1) * 32 + (swz % 64) / 2; }
struct Unit { int pm, pn, k0, nt, split; };
struct Gemm { const bf16_t* A; const bf16_t* Bt; int M, N, K; };
struct StaticOrder {
    int nM, nN, nwg, G, c, ntk;
    DI void init(int M, int N, int G_, int c_, int ntk_ = 32) { nM = M / BM; nN = N / BM; nwg = nM * nN; G = G_; c = c_; ntk = ntk_; }
    DI void map(int L, Unit& u) const {
        int wgid = L; { const int q = nwg / NXCD, r = nwg % NXCD, xcd = wgid % NXCD, off = wgid / NXCD; wgid = (xcd < r ? xcd * (q + 1) : r * (q + 1) + (xcd - r) * q) + off; }
        const int nig = WGM * nN, gid = wgid / nig, fm = gid * WGM, gsz = (nM - fm) < WGM ? (nM - fm) : WGM;
        u.pm = fm + ((wgid % nig) % gsz); u.pn = (wgid % nig) / gsz; u.k0 = 0; u.nt = ntk; u.split = -1;
    }
    DI bool next(int i, Unit& u) const { const long L = (long)i * G + c; if (L >= nwg) return false; map((int)L, u); return true; }
};
struct SplitOrder {
    StaticOrder base;
    DI void init(int N, int G_, int c_, int ntk_) { base.init(TP, N, G_, c_, ntk_); }
    DI int total() const { return base.nwg + 16 * 4; }
    DI bool next(int i, Unit& u) const {
        const int L = i * base.G + base.c;
        if (L >= base.nwg + 64) return false;
        const bool sp = L >= base.nwg;
        Unit a; base.map(sp ? 0 : L, a);
        const int j = L - base.nwg, tile = j >> 2, s4 = j & 3, q = base.ntk >> 2;
        u.pm = sp ? (TP / BM + (tile >> 3)) : a.pm; u.pn = sp ? (tile & 7) : a.pn; u.nt = sp ? q : a.nt; u.k0 = sp ? s4 * q : 0; u.split = sp ? s4 : -1;
        return true;
    }
};

template <class Epi, class Sched>
DI void gemm_phase(LAS unsigned char* lds, const Gemm g, const Sched& S, const Epi& E) {
    const int tid = threadIdx.x, wid = __builtin_amdgcn_readfirstlane(tid >> 6), lane = tid & 63, wr = wid >> 2, wc = wid & 3, fr = lane & 15, fq = lane >> 4;
    const int K = g.K;
    unsigned voffA[2];
#pragma unroll
    for (int i = 0; i < 2; ++i) { int R, C; stage_rc(tid * 16 + i * 8192, R, C); voffA[i] = (unsigned)(R * K + C) * 2u; }
    const size_t kstep = (size_t)(BK * 2);
    const size_t hstep = (size_t)HALF * K * 2;
    const size_t tstep = 2 * hstep;
    const unsigned ldsw = (unsigned)wid * 1024u;
    const int aoff = lds_byte(wr * 64 + fr, fq * 8), boff = lds_byte(wc * 32 + fr, fq * 8);
#define PG8_SA(b, h) (((b) * 2 + (h)) * HTB)
#define PG8_SB(b, h) ((4 + (b) * 2 + (h)) * HTB)
#define PG8_STAGE(bufoff, gbase) do { _Pragma("unroll") for (int _i = 0; _i < 2; ++_i) \
        __builtin_amdgcn_global_load_lds((const unsigned*)((const char*)(gbase) + voffA[_i]), (LAS unsigned*)(lds + (bufoff) + ldsw + _i * 8192), 16, 0, 0); } while (0)
#define PG8_LDA(dst, b, h) do { _Pragma("unroll") for (int m = 0; m < 4; ++m) _Pragma("unroll") for (int k = 0; k < 2; ++k) dst[m][k] = *(const LAS bf16x8*)(lds + PG8_SA(b, h) + aoff + m * 2048 + k * 1024); } while (0)
#define PG8_LDB(dst, b, h) do { _Pragma("unroll") for (int n = 0; n < 2; ++n) _Pragma("unroll") for (int k = 0; k < 2; ++k) dst[n][k] = *(const LAS bf16x8*)(lds + PG8_SB(b, h) + boff + n * 2048 + k * 1024); } while (0)
#define PG8_MMA(ai, bj, At, Bt) do { __builtin_amdgcn_s_setprio(1); _Pragma("unroll") for (int m = 0; m < 4; ++m) _Pragma("unroll") for (int n = 0; n < 2; ++n) _Pragma("unroll") for (int k = 0; k < 2; ++k) \
        acc[ai][bj][m][n] = __builtin_amdgcn_mfma_f32_16x16x32_bf16(Bt[n][k], At[m][k], acc[ai][bj][m][n], 0, 0, 0); __builtin_amdgcn_s_setprio(0); } while (0)
#define PG8_WAIT_V(n) asm volatile("s_waitcnt vmcnt(" #n ")" ::: "memory")
#define PG8_WAIT_L(n) asm volatile("s_waitcnt lgkmcnt(" #n ")" ::: "memory")
#define PG8_BAR __builtin_amdgcn_s_barrier()
#define PG8_SCHED __builtin_amdgcn_sched_barrier(0)
    Unit cur, nxt; int ui = 0;
    if (!S.next(0, cur)) return;
    f32x4 acc[2][2][4][2];
#pragma unroll
    for (int a = 0; a < 2; ++a)
#pragma unroll
        for (int b = 0; b < 2; ++b)
#pragma unroll
            for (int m = 0; m < 4; ++m)
#pragma unroll
                for (int n = 0; n < 2; ++n) acc[a][b][m][n] = (f32x4){0.f, 0.f, 0.f, 0.f};
    bf16x8 At[4][2], B0[2][2], B1[2][2];
    const char* cA = (const char*)g.A + (size_t)cur.pm * tstep + (size_t)cur.k0 * kstep; const char* cB = (const char*)g.Bt + (size_t)cur.pn * tstep + (size_t)cur.k0 * kstep;
    PG8_STAGE(PG8_SB(0, 0), cB); PG8_STAGE(PG8_SA(0, 0), cA); PG8_STAGE(PG8_SB(0, 1), cB + hstep); PG8_STAGE(PG8_SA(0, 1), cA + hstep);
    if (wr == 1) PG8_BAR;
    PG8_WAIT_V(4); PG8_BAR;
    PG8_STAGE(PG8_SB(1, 0), cB + kstep); PG8_STAGE(PG8_SA(1, 0), cA + kstep); PG8_STAGE(PG8_SB(1, 1), cB + hstep + kstep);
    PG8_WAIT_V(6); PG8_BAR;
    for (;;) {
        const bool has_next = S.next(ui + 1, nxt);
        const char* nA = has_next ? (const char*)g.A + (size_t)nxt.pm * tstep + (size_t)nxt.k0 * kstep : cA; const char* nB = has_next ? (const char*)g.Bt + (size_t)nxt.pn * tstep + (size_t)nxt.k0 * kstep : cB;
        const int nt = cur.nt;
        for (int t = 0; t < nt; t += 2) {
            const bool last = (t == nt - 2);
            const char* a1 = cA + (size_t)(t + 1) * kstep;
            const char* a2 = last ? nA : cA + (size_t)(t + 2) * kstep; const char* b2 = last ? nB : cB + (size_t)(t + 2) * kstep;
            const char* a3 = a2 + kstep; const char* b3 = b2 + kstep;
            PG8_LDB(B0, 0, 0); PG8_SCHED; PG8_LDA(At, 0, 0); PG8_STAGE(PG8_SA(1, 1), a1 + hstep);
            PG8_WAIT_L(8); PG8_BAR; PG8_WAIT_L(0); PG8_MMA(0, 0, At, B0); PG8_BAR; PG8_SCHED;
            PG8_LDB(B1, 0, 1); PG8_STAGE(PG8_SB(0, 0), b2);
            PG8_BAR; PG8_WAIT_L(0); PG8_MMA(0, 1, At, B1); PG8_BAR;
            PG8_LDA(At, 0, 1); PG8_STAGE(PG8_SA(0, 0), a2);
            PG8_BAR; PG8_WAIT_L(0); PG8_MMA(1, 0, At, B0); PG8_BAR; PG8_SCHED;
            PG8_STAGE(PG8_SB(0, 1), b2 + hstep);
            PG8_WAIT_V(6); PG8_BAR; PG8_MMA(1, 1, At, B1); PG8_BAR;
            PG8_LDB(B0, 1, 0); PG8_SCHED; PG8_LDA(At, 1, 0); PG8_STAGE(PG8_SA(0, 1), a2 + hstep);
            PG8_WAIT_L(8); PG8_BAR; PG8_WAIT_L(0); PG8_MMA(0, 0, At, B0); PG8_BAR; PG8_SCHED;
            PG8_LDB(B1, 1, 1); PG8_STAGE(PG8_SB(1, 0), b3);
            PG8_BAR; PG8_WAIT_L(0); PG8_MMA(0, 1, At, B1); PG8_BAR;
            PG8_LDA(At, 1, 1); PG8_STAGE(PG8_SA(1, 0), a3);
            PG8_BAR; PG8_WAIT_L(0); PG8_MMA(1, 0, At, B0); PG8_BAR; PG8_SCHED;
            PG8_STAGE(PG8_SB(1, 1), b3 + hstep);
            PG8_WAIT_V(6); PG8_BAR; PG8_MMA(1, 1, At, B1); PG8_BAR;
        }
        E(acc, cur, wr, wc, fr, fq);
        if (!has_next) break;
#pragma unroll
        for (int a = 0; a < 2; ++a)
#pragma unroll
            for (int b = 0; b < 2; ++b)
#pragma unroll
                for (int m = 0; m < 4; ++m)
#pragma unroll
                    for (int n = 0; n < 2; ++n) acc[a][b][m][n] = (f32x4){0.f, 0.f, 0.f, 0.f};
        cur = nxt; cA = nA; cB = nB; ++ui;
    }
    PG8_WAIT_V(0);
    if (wr == 0) PG8_BAR;
    PG8_BAR;
#undef PG8_SA
#undef PG8_SB
#undef PG8_STAGE
#undef PG8_LDA
#undef PG8_LDB
#undef PG8_MMA
#undef PG8_WAIT_V
#undef PG8_WAIT_L
#undef PG8_BAR
#undef PG8_SCHED
}
}

typedef f32x4 AccT[2][2][4][2];

DI int src_col_in(int R) {
    const int pn = R >> 8, c = R & 255, bj = c >> 7, wc = (c >> 5) & 3, r5 = c & 31;
    if (pn < 8) return (4 * pn + wc) * 64 + 32 * bj + r5;
    if (pn == 8) return 2048 + wc * 64 + 32 * bj + r5;
    if (pn == 9) return 2304 + c;
    if (pn < 26) return (bj ? 6656 : 2560) + 128 * (pn - 10) + (c & 127);
    if (pn < 42) return (bj ? 10752 : 4608) + 128 * (pn - 26) + (c & 127);
    return 8704 + 256 * (pn - 42) + c;
}
DI int src_col_gu(int R) { const int t = R >> 8, c = R & 255; return ((c >> 7) ? DFF : 0) + 128 * t + (c & 127); }

DI unsigned bperm(int src4, unsigned v) { return (unsigned)__builtin_amdgcn_ds_bpermute(src4, (int)v); }
DI u32x2 perm2(int src4, u32x2 v) { u32x2 r; r.x = bperm(src4, v.x); r.y = bperm(src4, v.y); return r; }
DI f32x4 perm4(int src4, f32x4 v) { f32x4 r; r[0] = __uint_as_float(bperm(src4, __float_as_uint(v[0]))); r[1] = __uint_as_float(bperm(src4, __float_as_uint(v[1])));
    r[2] = __uint_as_float(bperm(src4, __float_as_uint(v[2]))); r[3] = __uint_as_float(bperm(src4, __float_as_uint(v[3]))); return r; }

struct Epi1 {
    bf16_t *Q, *Kb, *Vb, *U, *BG, *SGA; const float *qg, *kg, *cosT, *sinT; float* out;
    DI void side_kv(float* pwin, float* swin, int row, int col, f32x4 v) const {
        if (row >= TP - 128 && row < TP) *(f32x4*)(pwin + (size_t)(row - (TP - 128)) * 256 + col) = v;
        if (row >= TP) { const int b = (row - TP) >> 2, i = (row - TP) & 3; *(f32x4*)(swin + (size_t)b * 32768 + (size_t)(124 + i) * 256 + col) = v; }
    }
    DI void operator()(const AccT& acc, const pg8::Unit& u, int wr, int wc, int fr, int fq) const {
        asm volatile("" : "+v"(fr), "+v"(fq));
        const int lane = fr + 16 * fq, tr = lane >> 2, tq = lane & 3, src4 = (tr + 16 * tq) * 4;
        const int pn = u.pn, row0 = u.pm * 256 + wr * 64 + fr, rowT0 = u.pm * 256 + wr * 64 + tr;
        const bool side = u.pm >= 31;
        if (pn < 9) {
            const float* g = pn < 8 ? qg : kg;
            f32x4 gv[2][2];
#pragma unroll
            for (int bj = 0; bj < 2; ++bj)
#pragma unroll
                for (int n = 0; n < 2; ++n) gv[bj][n] = *(const f32x4*)(g + 32 * bj + 16 * n + 4 * fq);
#pragma unroll
            for (int aim = 0; aim < 4; ++aim) {
                const int ai = aim >> 1, mh = (aim & 1) * 2;
                f32x4 cs[4][2], sn[4][2];
#pragma unroll
                for (int m = mh; m < mh + 2; ++m) {
                    const int row = row0 + 128 * ai + 16 * m;
                    const int pos = row < TP ? row : TP + ((row - TP) & 3);
#pragma unroll
                    for (int n = 0; n < 2; ++n) { cs[m][n] = *(const f32x4*)(cosT + (size_t)pos * 32 + 16 * n + 4 * fq); sn[m][n] = *(const f32x4*)(sinT + (size_t)pos * 32 + 16 * n + 4 * fq); }
                }
#pragma unroll
                for (int m = mh; m < mh + 2; ++m) {
                    const int rowT = rowT0 + 128 * ai + 16 * m;
                    float ssq = 0.f;
#pragma unroll
                    for (int bj = 0; bj < 2; ++bj)
#pragma unroll
                        for (int n = 0; n < 2; ++n) { const f32x4 x = acc[ai][bj][m][n]; ssq += (x[0] * x[0] + x[1] * x[1]) + (x[2] * x[2] + x[3] * x[3]); }
                    ssq += __shfl_xor(ssq, 16); ssq += __shfl_xor(ssq, 32);
                    const float rs = __builtin_amdgcn_rsqf(ssq * (1.0f / 64.0f) + EPS);
#pragma unroll
                    for (int n = 0; n < 2; ++n) {
                        const f32x4 y1 = acc[ai][0][m][n] * rs * gv[0][n], y2 = acc[ai][1][m][n] * rs * gv[1][n];
                        const f32x4 o1 = y1 * cs[m][n] - y2 * sn[m][n], o2 = y2 * cs[m][n] + y1 * sn[m][n];
                        const int d = 16 * n + 4 * tq;
                        const u32x2 w1 = perm2(src4, pk4(o1)), w2 = perm2(src4, pk4(o2));
                        if (pn < 8) {
                            bf16_t* qp = Q + (size_t)rowT * DM + (4 * pn + wc) * 64 + d;
                            *(u32x2*)qp = w1; *(u32x2*)(qp + 32) = w2;
                        } else {
                            bf16_t* kp = Kb + (size_t)rowT * 256 + wc * 64 + d;
                            *(u32x2*)kp = w1; *(u32x2*)(kp + 32) = w2;
                            if (side) { const f32x4 t1 = perm4(src4, o1), t2 = perm4(src4, o2);
                                side_kv(out + O_PK, out + O_SK, rowT, wc * 64 + d, t1); side_kv(out + O_PK, out + O_SK, rowT, wc * 64 + d + 32, t2); }
                        }
                    }
                }
            }
        } else if (pn == 9) {
#pragma unroll
            for (int ai = 0; ai < 2; ++ai)
#pragma unroll
                for (int m = 0; m < 4; ++m) {
                    const int rowT = rowT0 + 128 * ai + 16 * m;
#pragma unroll
                    for (int bj = 0; bj < 2; ++bj)
#pragma unroll
                        for (int n = 0; n < 2; ++n) { const int col = 128 * bj + 32 * wc + 16 * n + 4 * tq; const f32x4 v = acc[ai][bj][m][n];
                            *(u32x2*)(Vb + (size_t)rowT * 256 + col) = perm2(src4, pk4(v));
                            if (side) side_kv(out + O_PV, out + O_SV, rowT, col, perm4(src4, v)); }
                }
        } else if (pn < 26) {
            const int t = pn - 10;
#pragma unroll
            for (int ai = 0; ai < 2; ++ai)
#pragma unroll
                for (int m = 0; m < 4; ++m) {
                    const int rowT = rowT0 + 128 * ai + 16 * m;
#pragma unroll
                    for (int n = 0; n < 2; ++n) { const int col = 128 * t + 32 * wc + 16 * n + 4 * tq; const f32x4 v = acc[ai][0][m][n] * acc[ai][1][m][n];
                        *(u32x2*)(U + (size_t)rowT * DM + col) = perm2(src4, pk4(v));
                        if (side) { const f32x4 vt = perm4(src4, v);
                            if (rowT >= TP - 2 && rowT < TP) *(f32x4*)(out + O_PC + (size_t)(rowT - (TP - 2)) * DM + col) = vt;
                            if (rowT >= TP && ((rowT - TP) & 3) >= 2) { const int b = (rowT - TP) >> 2, i = (rowT - TP) & 3; *(f32x4*)(out + O_SC + (size_t)b * 4096 + (size_t)(i - 2) * DM + col) = vt; } } }
                }
        } else if (pn < 42) {
            const int t = pn - 26;
#pragma unroll
            for (int ai = 0; ai < 2; ++ai)
#pragma unroll
                for (int m = 0; m < 4; ++m) {
                    const int rowT = rowT0 + 128 * ai + 16 * m;
#pragma unroll
                    for (int n = 0; n < 2; ++n) { const int col = 128 * t + 32 * wc + 16 * n + 4 * tq; const f32x4 b = acc[ai][0][m][n], gc = acc[ai][1][m][n];
                        f32x4 v; v[0] = b[0] * sigmoidf_(gc[0]); v[1] = b[1] * sigmoidf_(gc[1]); v[2] = b[2] * sigmoidf_(gc[2]); v[3] = b[3] * sigmoidf_(gc[3]);
                        *(u32x2*)(BG + (size_t)rowT * DM + col) = perm2(src4, pk4(v)); }
                }
        } else {
#pragma unroll
            for (int ai = 0; ai < 2; ++ai)
#pragma unroll
                for (int m = 0; m < 4; ++m) {
                    const int rowT = rowT0 + 128 * ai + 16 * m;
#pragma unroll
                    for (int bj = 0; bj < 2; ++bj)
#pragma unroll
                        for (int n = 0; n < 2; ++n) { const int col = 256 * (pn - 42) + 128 * bj + 32 * wc + 16 * n + 4 * tq; const f32x4 a = acc[ai][bj][m][n];
                            f32x4 v; v[0] = sigmoidf_(a[0]); v[1] = sigmoidf_(a[1]); v[2] = sigmoidf_(a[2]); v[3] = sigmoidf_(a[3]);
                            *(u32x2*)(SGA + (size_t)rowT * DM + col) = perm2(src4, pk4(v)); }
                }
        }
    }
};

DI void store_partial(float* PB, const AccT& acc, const pg8::Unit& u, int wr, int wc, int tr, int tq, int src4) {
    float* pb = PB + ((size_t)u.split * TS + (size_t)(u.pm * 256 - TP) + wr * 64 + tr) * DM + u.pn * 256 + wc * 32 + 4 * tq;
#pragma unroll
    for (int ai = 0; ai < 2; ++ai)
#pragma unroll
        for (int m = 0; m < 4; ++m)
#pragma unroll
            for (int bj = 0; bj < 2; ++bj)
#pragma unroll
                for (int n = 0; n < 2; ++n) *(f32x4*)(pb + (size_t)(128 * ai + 16 * m) * DM + 128 * bj + 16 * n) = perm4(src4, acc[ai][bj][m][n]);
}

struct Epi3 {
    const float *xp, *xs, *gffn; float* Y; bf16_t* A2; float* SSQ; float* PB;
    DI void operator()(const AccT& acc, const pg8::Unit& u, int wr, int wc, int fr, int fq) const {
        asm volatile("" : "+v"(fr), "+v"(fq));
        const int lane = fr + 16 * fq, tr = lane >> 2, tq = lane & 3, src4 = (tr + 16 * tq) * 4;
        if (u.split >= 0) { store_partial(PB, acc, u, wr, wc, tr, tq, src4); return; }
        const int rowT0 = u.pm * 256 + wr * 64 + tr, colT0 = u.pn * 256 + wc * 32 + 4 * tq;
        const float* xb = u.pm < 32 ? xp : xs - (size_t)TP * DM;
        f32x4 gv[2][2];
#pragma unroll
        for (int bj = 0; bj < 2; ++bj)
#pragma unroll
            for (int n = 0; n < 2; ++n) gv[bj][n] = *(const f32x4*)(gffn + colT0 + 128 * bj + 16 * n);
#pragma unroll
        for (int aim = 0; aim < 4; ++aim) {
            const int ai = aim >> 1, mh = (aim & 1) * 2;
            f32x4 xv[4][2][2];
#pragma unroll
            for (int m = mh; m < mh + 2; ++m)
#pragma unroll
                for (int bj = 0; bj < 2; ++bj)
#pragma unroll
                    for (int n = 0; n < 2; ++n) xv[m][bj][n] = *(const f32x4*)(xb + (size_t)(rowT0 + 128 * ai + 16 * m) * DM + colT0 + 128 * bj + 16 * n);
#pragma unroll
            for (int m = mh; m < mh + 2; ++m) {
                const int rowT = rowT0 + 128 * ai + 16 * m; float ssq = 0.f;
#pragma unroll
                for (int bj = 0; bj < 2; ++bj)
#pragma unroll
                    for (int n = 0; n < 2; ++n) { const size_t off = (size_t)rowT * DM + colT0 + 128 * bj + 16 * n;
                        const f32x4 y = xv[m][bj][n] + perm4(src4, acc[ai][bj][m][n]);
                        ssq += (y[0] * y[0] + y[1] * y[1]) + (y[2] * y[2] + y[3] * y[3]);
                        *(f32x4*)(Y + off) = y; *(u32x2*)(A2 + off) = pk4(y * gv[bj][n]); }
                ssq += __shfl_xor(ssq, 1); ssq += __shfl_xor(ssq, 2);
                if (tq == 0) SSQ[(size_t)rowT * 32 + u.pn * 4 + wc] = ssq;
            }
        }
    }
};

struct Epi4 {
    const float* RSTD; bf16_t* HID;
    DI void operator()(const AccT& acc, const pg8::Unit& u, int wr, int wc, int fr, int fq) const {
        asm volatile("" : "+v"(fr), "+v"(fq));
        const int lane = fr + 16 * fq, tr = lane >> 2, tq = lane & 3, src4 = (tr + 16 * tq) * 4;
        const int row0 = u.pm * 256 + wr * 64 + fr, rowT0 = u.pm * 256 + wr * 64 + tr, colT0 = u.pn * 128 + wc * 32 + 4 * tq;
        float rs[2][4];
#pragma unroll
        for (int ai = 0; ai < 2; ++ai)
#pragma unroll
            for (int m = 0; m < 4; ++m) rs[ai][m] = RSTD[row0 + 128 * ai + 16 * m];
#pragma unroll
        for (int ai = 0; ai < 2; ++ai)
#pragma unroll
            for (int m = 0; m < 4; ++m) {
                const int rowT = rowT0 + 128 * ai + 16 * m;
                const float rstd = rs[ai][m];
#pragma unroll
                for (int n = 0; n < 2; ++n) { const f32x4 g = acc[ai][0][m][n] * rstd, up = acc[ai][1][m][n] * rstd;
                    f32x4 h; h[0] = g[0] * sigmoidf_(g[0]) * up[0]; h[1] = g[1] * sigmoidf_(g[1]) * up[1]; h[2] = g[2] * sigmoidf_(g[2]) * up[2]; h[3] = g[3] * sigmoidf_(g[3]) * up[3];
                    *(u32x2*)(HID + (size_t)rowT * DFF + colT0 + 16 * n) = perm2(src4, pk4(h)); }
            }
    }
};

struct Epi5 {
    float* Y; float* PB;
    DI void operator()(const AccT& acc, const pg8::Unit& u, int wr, int wc, int fr, int fq) const {
        asm volatile("" : "+v"(fr), "+v"(fq));
        const int lane = fr + 16 * fq, tr = lane >> 2, tq = lane & 3, src4 = (tr + 16 * tq) * 4;
        if (u.split >= 0) { store_partial(PB, acc, u, wr, wc, tr, tq, src4); return; }
        float* yb = Y + (size_t)(u.pm * 256 + wr * 64 + tr) * DM + u.pn * 256 + wc * 32 + 4 * tq;
        f32x4 cur[2][2], nxt[2][2];
#pragma unroll
        for (int bj = 0; bj < 2; ++bj)
#pragma unroll
            for (int n = 0; n < 2; ++n) cur[bj][n] = *(const f32x4*)(yb + 128 * bj + 16 * n);
#pragma unroll
        for (int k = 0; k < 8; ++k) {
            const int ai = k >> 2, m = k & 3;
            if (k < 7) { const int a2 = (k + 1) >> 2, m2 = (k + 1) & 3;
#pragma unroll
                for (int bj = 0; bj < 2; ++bj)
#pragma unroll
                    for (int n = 0; n < 2; ++n) nxt[bj][n] = *(const f32x4*)(yb + (size_t)(128 * a2 + 16 * m2) * DM + 128 * bj + 16 * n); }
#pragma unroll
            for (int bj = 0; bj < 2; ++bj)
#pragma unroll
                for (int n = 0; n < 2; ++n) *(f32x4*)(yb + (size_t)(128 * ai + 16 * m) * DM + 128 * bj + 16 * n) = cur[bj][n] + perm4(src4, acc[ai][bj][m][n]);
#pragma unroll
            for (int bj = 0; bj < 2; ++bj)
#pragma unroll
                for (int n = 0; n < 2; ++n) cur[bj][n] = nxt[bj][n];
        }
    }
};

DI void p0_transpose_item(const float* W, int K, int N, bf16_t* WT, int src_n0, int dst_n0, int k0, LAS float* scr, int lane) {
#pragma unroll 8
    for (int i = 0; i < 32; ++i) { const int kk = 2 * i + (lane >> 5); scr[kk * 33 + (lane & 31)] = W[(size_t)(k0 + kk) * N + src_n0 + (lane & 31)]; }
    asm volatile("s_waitcnt lgkmcnt(0)" ::: "memory");
    const int c = lane & 7;
#pragma unroll
    for (int j = 0; j < 4; ++j) { const int n = (lane >> 3) + 8 * j; const LAS float* s = scr + (8 * c) * 33 + n;
        u32x4 o; o.x = pk2(s[0 * 33], s[1 * 33]); o.y = pk2(s[2 * 33], s[3 * 33]); o.z = pk2(s[4 * 33], s[5 * 33]); o.w = pk2(s[6 * 33], s[7 * 33]);
        *(u32x4*)(WT + (size_t)(dst_n0 + n) * K + k0 + 8 * c) = o; }
    asm volatile("s_waitcnt lgkmcnt(0)" ::: "memory");
}

DI void p0_rest(const Params& p, LAS unsigned char* lds, int wid, int lane, int worker, int nworkers, int part) {
    LAS float* scr = (LAS float*)(lds + wid * 8704);
    const int gw = worker * 8 + wid, NGW = nworkers * 8;
    bf16_t* WoutT = (bf16_t*)(p.ws + WS_WOUT); bf16_t* WguT = (bf16_t*)(p.ws + WS_WGU); bf16_t* WdnT = (bf16_t*)(p.ws + WS_WDN);
    constexpr int I_OUT = (DM / 64) * (DM / 32), I_GU = (DM / 64) * (NGU / 32), I_DN = (DFF / 64) * (DM / 32);
    if (part == 0) {
        for (int r = gw; r < I_OUT; r += NGW) { const int nblk = DM / 32, kb = r / nblk, nb = r % nblk; p0_transpose_item(p.w_out, DM, DM, WoutT, 32 * nb, 32 * nb, 64 * kb, scr, lane); }
    } else if (part == 1) {
        for (int r = gw; r < I_GU; r += NGW) { const int nblk = NGU / 32, kb = r / nblk, nb = r % nblk; p0_transpose_item(p.w_gu, DM, NGU, WguT, src_col_gu(32 * nb), 32 * nb, 64 * kb, scr, lane); }
    } else {
        for (int r = gw; r < I_DN; r += NGW) { const int nblk = DM / 32, kb = r / nblk, nb = r % nblk; p0_transpose_item(p.w_dn, DFF, DM, WdnT, 32 * nb, 32 * nb, 64 * kb, scr, lane); }
    }
}

DI void p0_prologue(const Params& p, LAS unsigned char* lds, int wid, int lane) {
    LAS float* scr = (LAS float*)(lds + wid * 8704);
    const int gw = blockIdx.x * 8 + wid, NGW = gridDim.x * 8;
    bf16_t* WinT = (bf16_t*)(p.ws + WS_WIN);
    constexpr int I_IN = (DM / 64) * (DIN / 32);
    for (int it = gw; it < I_IN; it += NGW) { const int nblk = DIN / 32, kb = it / nblk, nb = it % nblk; p0_transpose_item(p.w_in, DM, DIN, WinT, src_col_in(32 * nb), 32 * nb, 64 * kb, scr, lane); }
    bf16_t* XN = (bf16_t*)(p.ws + WS_XN);
    for (int m = gw; m < MT; m += NGW) {
        const float* xrow = m < TP ? p.xp + (size_t)m * DM : p.xs + (size_t)(m - TP) * DM;
        const f32x4* xr = (const f32x4*)xrow + lane; f32x4 v[8]; float s = 0.f;
#pragma unroll
        for (int j = 0; j < 8; ++j) { v[j] = xr[64 * j]; s += (v[j][0] * v[j][0] + v[j][1] * v[j][1]) + (v[j][2] * v[j][2] + v[j][3] * v[j][3]); }
        const float rstd = 1.0f / sqrtf(wave_sum(s) * (1.0f / DM) + EPS);
        u32x2* o8 = (u32x2*)(XN + (size_t)m * DM) + lane;
#pragma unroll
        for (int j = 0; j < 8; ++j) { const f32x4 gv = ((const f32x4*)p.norm_mix)[64 * j + lane]; o8[64 * j] = pk4(v[j] * rstd * gv); }
    }
    float* cosT = (float*)(p.ws + WS_COS); float* sinT = (float*)(p.ws + WS_SIN);
    const int gt = blockIdx.x * 512 + threadIdx.x, GT = gridDim.x * 512;
    for (int idx = gt; idx < NPOS * 32; idx += GT) {
        const int pos = idx >> 5, i = idx & 31;
        const float inv = __builtin_amdgcn_exp2f(-(float)i * (13.287712379549449f / 32.0f));
        const float ang = (float)pos * inv;
        const double rev = (double)ang * 0.15915494309189535; const float fr = (float)(rev - __builtin_floor(rev));
        cosT[idx] = __builtin_amdgcn_cosf(fr); sinT[idx] = __builtin_amdgcn_sinf(fr);
    }
}

DI void cache_copy(const Params& p, int worker, int nworkers) {
    const int gt = worker * 512 + threadIdx.x, GT = nworkers * 512;
    for (int idx = gt; idx < 128 * 7936; idx += GT) {
        const int b = idx / 7936, e = idx - b * 7936;
        ((f32x4*)(p.out + O_SK + (size_t)b * 32768))[e] = ((const f32x4*)(p.ck + (size_t)b * 32768 + 1024))[e];
        ((f32x4*)(p.out + O_SV + (size_t)b * 32768))[e] = ((const f32x4*)(p.cv + (size_t)b * 32768 + 1024))[e];
    }
}

#define MFMA32(a, b, c) __builtin_amdgcn_mfma_f32_32x32x16_bf16((a), (b), (c), 0, 0, 0)
DI int crow(int reg, int h) { return (reg & 3) + 8 * (reg >> 2) + 4 * h; }
DI bf16x8 pack8(const f32x16& x, int s) {
    u32x4 p; p.x = pk2(x[8 * s], x[8 * s + 1]); p.y = pk2(x[8 * s + 2], x[8 * s + 3]); p.z = pk2(x[8 * s + 4], x[8 * s + 5]); p.w = pk2(x[8 * s + 6], x[8 * s + 7]);
    return __builtin_bit_cast(bf16x8, p);
}
DI bf16x8 cvt8(f32x4 a, f32x4 b) { u32x4 p; p.x = pk2(a[0], a[1]); p.y = pk2(a[2], a[3]); p.z = pk2(b[0], b[1]); p.w = pk2(b[2], b[3]); return __builtin_bit_cast(bf16x8, p); }

constexpr int KS_STRIDE = 72, VT_STRIDE = 260, VT_OFF = 256 * KS_STRIDE * 2;

template <bool SAMPLE>
DI void attn_chunk(const Params& p, LAS unsigned char* lds, int qb, int c, int kvh, int head_w, int b_s, int lane) {
    const bf16_t* Q = (const bf16_t*)(p.ws + WS_Q); const bf16_t* Kb = (const bf16_t*)(p.ws + WS_K); const bf16_t* Vb = (const bf16_t*)(p.ws + WS_V);
    const bf16_t* U = (const bf16_t*)(p.ws + WS_U); const bf16_t* BG = (const bf16_t*)(p.ws + WS_BG); const bf16_t* SGA = (const bf16_t*)(p.ws + WS_SGA);
    bf16_t* MIX = (bf16_t*)(p.ws + WS_MIX);
    const int r = lane & 31, g = lane >> 5;
    int tok, head, itok = 0;
    if (SAMPLE) { itok = r >> 3; head = kvh * 8 + (r & 7); tok = TP + 4 * b_s + itok; }
    else { head = head_w; tok = 128 * qb + 32 * c + r; }
    const LAS bf16_t* Ks = (const LAS bf16_t*)lds; const LAS bf16_t* Vt = (const LAS bf16_t*)(lds + VT_OFF);
    bf16x8 qf[4];
#pragma unroll
    for (int ks = 0; ks < 4; ++ks) qf[ks] = *(const bf16x8*)(Q + (size_t)tok * DM + head * 64 + 16 * ks + 8 * g);
    f32x16 s[5];
#pragma unroll
    for (int kbr = 0; kbr < 5; ++kbr) {
#pragma unroll
        for (int i = 0; i < 16; ++i) s[kbr][i] = 0.f;
#pragma unroll
        for (int ks = 0; ks < 4; ++ks) {
            bf16x8 a;
            if (SAMPLE) {
                if (kbr < 4) { const float* kp = p.ck + ((size_t)(b_s * 128 + 32 * kbr + r) * 4 + kvh) * 64 + 16 * ks + 8 * g; a = cvt8(*(const f32x4*)kp, *(const f32x4*)(kp + 4)); }
                else { u32x4 z = (u32x4){0u, 0u, 0u, 0u}; if (r < 4) z = *(const u32x4*)(Kb + (size_t)(TP + 4 * b_s + r) * 256 + kvh * 64 + 16 * ks + 8 * g); a = __builtin_bit_cast(bf16x8, z); }
            } else a = *(const LAS bf16x8*)(Ks + (32 * (c + kbr) + r) * KS_STRIDE + 16 * ks + 8 * g);
            s[kbr] = MFMA32(a, qf[ks], s[kbr]);
        }
    }
    const float sc = 0.125f * 1.44269504089f;
    const float sink2 = p.sinks[head] * 1.44269504089f;
    float mraw = -1e30f;
#pragma unroll
    for (int kbr = 0; kbr < 5; ++kbr)
#pragma unroll
        for (int i = 0; i < 16; ++i) {
            const int kr = crow(i, g); bool valid;
            if (SAMPLE) valid = kbr < 4 ? (32 * kbr + kr > itok) : (kr <= itok);
            else { valid = kbr == 0 ? (kr > r) : (kbr == 4 ? (kr <= r) : true); if (qb == 0 && c + kbr < 4) valid = false; }
            const float t = valid ? s[kbr][i] : -1e30f; s[kbr][i] = t; mraw = fmaxf(mraw, t);
        }
    mraw = fmaxf(mraw, __shfl_xor(mraw, 32));
    const float mx = fmaxf(mraw * sc, sink2);
    float sum = 0.f;
#pragma unroll
    for (int kbr = 0; kbr < 5; ++kbr)
#pragma unroll
        for (int i = 0; i < 16; ++i) { const float e = __builtin_amdgcn_exp2f(__builtin_fmaf(s[kbr][i], sc, -mx)); s[kbr][i] = e; sum += e; }
    sum += __shfl_xor(sum, 32);
    const float inv = 1.0f / (sum + __builtin_amdgcn_exp2f(sink2 - mx));
    f32x16 o[2];
#pragma unroll
    for (int dt = 0; dt < 2; ++dt)
#pragma unroll
        for (int i = 0; i < 16; ++i) o[dt][i] = 0.f;
#pragma unroll
    for (int kbr = 0; kbr < 5; ++kbr)
#pragma unroll
        for (int kk = 0; kk < 2; ++kk) {
            const bf16x8 pb = pack8(s[kbr], kk);
#pragma unroll
            for (int dt = 0; dt < 2; ++dt) {
                bf16x8 a; const int d = 32 * dt + r;
                if (SAMPLE) {
                    if (kbr < 4) { float f[8];
#pragma unroll
                        for (int j = 0; j < 8; ++j) { const int key = 32 * kbr + 16 * kk + 8 * (j >> 2) + 4 * g + (j & 3); f[j] = p.cv[((size_t)(b_s * 128 + key) * 4 + kvh) * 64 + d]; }
                        a = cvt8((f32x4){f[0], f[1], f[2], f[3]}, (f32x4){f[4], f[5], f[6], f[7]});
                    } else { u32x4 z = (u32x4){0u, 0u, 0u, 0u};
                        if (kk == 0 && g == 0) { const bf16_t* vp = Vb + (size_t)(TP + 4 * b_s) * 256 + kvh * 64 + d; z.x = (unsigned)vp[0] | ((unsigned)vp[256] << 16); z.y = (unsigned)vp[512] | ((unsigned)vp[768] << 16); }
                        a = __builtin_bit_cast(bf16x8, z); }
                } else {
                    const LAS bf16_t* vp = Vt + d * VT_STRIDE + 32 * (c + kbr) + 16 * kk + 4 * g;
                    const s16x4 lo = *(const LAS s16x4*)vp, hi = *(const LAS s16x4*)(vp + 8);
                    a = __builtin_shufflevector(lo, hi, 0, 1, 2, 3, 4, 5, 6, 7);
                }
                o[dt] = MFMA32(a, pb, o[dt]);
            }
        }
    if (!SAMPLE) {
#pragma unroll
        for (int dt = 0; dt < 2; ++dt)
#pragma unroll
            for (int i4 = 0; i4 < 4; ++i4) {
                const int col = head * 64 + 32 * dt + 8 * i4 + 4 * g;
                const f32x4 at = (f32x4){o[dt][4 * i4], o[dt][4 * i4 + 1], o[dt][4 * i4 + 2], o[dt][4 * i4 + 3]} * inv;
                *(u32x2*)(MIX + (size_t)tok * DM + col) = pk4(at);
            }
        return;
    }
#pragma unroll
    for (int dt = 0; dt < 2; ++dt) {
        u32x2 lsga[4], lbg[4], lu0[4]; f32x4 lu1[4], lu2[4], w0[4], w1[4], w2[4];
#pragma unroll
        for (int i4 = 0; i4 < 4; ++i4) {
            const int col = head * 64 + 32 * dt + 8 * i4 + 4 * g; const size_t off = (size_t)tok * DM + col;
            lsga[i4] = *(const u32x2*)(SGA + off); lbg[i4] = *(const u32x2*)(BG + off); lu0[i4] = *(const u32x2*)(U + off);
            lu1[i4] = itok >= 1 ? unpk4(*(const u32x2*)(U + off - DM)) : *(const f32x4*)(p.sconv + (size_t)b_s * 4096 + DM + col);
            lu2[i4] = itok >= 2 ? unpk4(*(const u32x2*)(U + off - 2 * DM)) : *(const f32x4*)(p.sconv + (size_t)b_s * 4096 + (size_t)itok * DM + col);
            w0[i4] = *(const f32x4*)(p.conv_w + col); w1[i4] = *(const f32x4*)(p.conv_w + DM + col); w2[i4] = *(const f32x4*)(p.conv_w + 2 * DM + col);
        }
#pragma unroll
        for (int i4 = 0; i4 < 4; ++i4) {
            const int col = head * 64 + 32 * dt + 8 * i4 + 4 * g; const size_t off = (size_t)tok * DM + col;
            const f32x4 at = (f32x4){o[dt][4 * i4], o[dt][4 * i4 + 1], o[dt][4 * i4 + 2], o[dt][4 * i4 + 3]} * inv;
            const f32x4 conv = w0[i4] * lu2[i4] + w1[i4] * lu1[i4] + w2[i4] * unpk4(lu0[i4]);
            *(u32x2*)(MIX + off) = pk4(unpk4(lsga[i4]) * at + unpk4(lbg[i4]) * conv);
        }
    }
}

DI void unpk8(u32x4 w, f32x4& lo, f32x4& hi) { lo = (f32x4){bf_lo(w.x), bf_hi(w.x), bf_lo(w.y), bf_hi(w.y)}; hi = (f32x4){bf_lo(w.z), bf_hi(w.z), bf_lo(w.w), bf_hi(w.w)}; }

constexpr int P2_CNT_OFF = 120000;
DI void p2_attention(const Params& p, LAS unsigned char* lds, int tid, int wid, int lane) {
    const bf16_t* Kb = (const bf16_t*)(p.ws + WS_K); const bf16_t* Vb = (const bf16_t*)(p.ws + WS_V);
    const bf16_t* U = (const bf16_t*)(p.ws + WS_U); const bf16_t* BG = (const bf16_t*)(p.ws + WS_BG); const bf16_t* SGA = (const bf16_t*)(p.ws + WS_SGA);
    bf16_t* MIX = (bf16_t*)(p.ws + WS_MIX);
    LAS bf16_t* Ks = (LAS bf16_t*)lds; LAS bf16_t* Vt = (LAS bf16_t*)(lds + VT_OFF);
    LAS unsigned* cnt = (LAS unsigned*)(lds + P2_CNT_OFF);
    int samp_next = blockIdx.x * 2;
    for (int item = blockIdx.x; item < 256; item += gridDim.x) {
        const int qb = item >> 2, kvh = item & 3;
        __syncthreads();
#pragma unroll
        for (int i = 0; i < 4; ++i) {
            const int e = tid + 512 * i, row = e >> 3, c8 = e & 7, tok = 128 * (qb - 1) + row;
            u32x4 kv = (u32x4){0u, 0u, 0u, 0u}, vv = (u32x4){0u, 0u, 0u, 0u};
            if (tok >= 0) { kv = *(const u32x4*)(Kb + (size_t)tok * 256 + kvh * 64 + 8 * c8); vv = *(const u32x4*)(Vb + (size_t)tok * 256 + kvh * 64 + 8 * c8); }
            *(LAS u32x4*)(Ks + row * KS_STRIDE + 8 * c8) = kv;
#pragma unroll
            for (int jj = 0; jj < 8; ++jj) Vt[(8 * c8 + jj) * VT_STRIDE + row] = (bf16_t)(vv[jj >> 1] >> (16 * (jj & 1)));
        }
        if (tid == 0) *cnt = 0u;
        __syncthreads();
        const int ns = (samp_next < 512) ? ((samp_next + 1 < 512) ? 2 : 1) : 0;
        for (;;) {
            unsigned t = 0; if (lane == 0) t = __hip_atomic_fetch_add(cnt, 1u, __ATOMIC_RELAXED, __HIP_MEMORY_SCOPE_WORKGROUP);
            t = __builtin_amdgcn_readfirstlane(t);
            if ((int)t >= ns + 32) break;
            if ((int)t < ns) { const int it = samp_next + (int)t; attn_chunk<true>(p, lds, 0, 0, it & 3, 0, it >> 2, lane); }
            else { const int pc = (int)t - ns; attn_chunk<false>(p, lds, qb, pc & 3, kvh, kvh * 8 + (pc >> 2), 0, lane); }
        }
        samp_next += gridDim.x * 2;
        asm volatile("s_waitcnt vmcnt(0)" ::: "memory");
        __syncthreads();
        __builtin_amdgcn_fence(__ATOMIC_ACQUIRE, "agent");
        {
            const int c8 = tid & 63, rbase = tid >> 6, col = kvh * 512 + 8 * c8;
            f32x4 w[3][2];
#pragma unroll
            for (int k = 0; k < 3; ++k) { w[k][0] = *(const f32x4*)(p.conv_w + k * DM + col); w[k][1] = *(const f32x4*)(p.conv_w + k * DM + col + 4); }
#pragma unroll
            for (int ib = 0; ib < 4; ++ib) {
                u32x4 la[4], ls[4], lb[4], l0[4], l1[4], l2[4];
#pragma unroll
                for (int ii = 0; ii < 4; ++ii) {
                    const int tok = 128 * qb + rbase + 8 * (4 * ib + ii); const size_t off = (size_t)tok * DM + col;
                    la[ii] = *(const u32x4*)(MIX + off); ls[ii] = *(const u32x4*)(SGA + off); lb[ii] = *(const u32x4*)(BG + off); l0[ii] = *(const u32x4*)(U + off);
                    l1[ii] = (u32x4){0u, 0u, 0u, 0u}; l2[ii] = (u32x4){0u, 0u, 0u, 0u};
                    if (tok >= 1) l1[ii] = *(const u32x4*)(U + off - DM);
                    if (tok >= 2) l2[ii] = *(const u32x4*)(U + off - 2 * DM);
                }
#pragma unroll
                for (int ii = 0; ii < 4; ++ii) {
                    const int tok = 128 * qb + rbase + 8 * (4 * ib + ii); const size_t off = (size_t)tok * DM + col;
                    f32x4 a0, a1, s0, s1, b0, b1, x0, x1, y0, y1, z0, z1;
                    unpk8(la[ii], a0, a1); unpk8(ls[ii], s0, s1); unpk8(lb[ii], b0, b1); unpk8(l0[ii], x0, x1); unpk8(l1[ii], y0, y1); unpk8(l2[ii], z0, z1);
                    const f32x4 m0 = s0 * a0 + b0 * (w[0][0] * z0 + w[1][0] * y0 + w[2][0] * x0);
                    const f32x4 m1 = s1 * a1 + b1 * (w[0][1] * z1 + w[1][1] * y1 + w[2][1] * x1);
                    u32x4 o; o.x = pk2(m0[0], m0[1]); o.y = pk2(m0[2], m0[3]); o.z = pk2(m1[0], m1[1]); o.w = pk2(m1[2], m1[3]);
                    *(u32x4*)(MIX + off) = o;
                }
            }
        }
    }
    for (int it = samp_next + (wid & 1); it < 512 && wid < 2; it += gridDim.x * 2) attn_chunk<true>(p, lds, 0, 0, it & 3, 0, it >> 2, lane);
}

DI void p3_reduce(const Params& p, int wid, int lane) {
    const float* PB = (const float*)(p.ws + WS_PB); bf16_t* A2 = (bf16_t*)(p.ws + WS_A2); const float* SSQ = (const float*)(p.ws + WS_SSQ); float* RSTD = (float*)(p.ws + WS_RSTD);
    for (int r = blockIdx.x * 8 + wid; r < TS; r += gridDim.x * 8) {
        const int row = TP + r; f32x4 y[8]; float s = 0.f;
#pragma unroll
        for (int j = 0; j < 8; ++j) { const size_t o = (size_t)r * DM + 256 * j + 4 * lane;
            y[j] = *(const f32x4*)(p.xs + o) + ((*(const f32x4*)(PB + o) + *(const f32x4*)(PB + (size_t)TS * DM + o)) + (*(const f32x4*)(PB + (size_t)2 * TS * DM + o) + *(const f32x4*)(PB + (size_t)3 * TS * DM + o)));
            s += (y[j][0] * y[j][0] + y[j][1] * y[j][1]) + (y[j][2] * y[j][2] + y[j][3] * y[j][3]); }
        s = wave_sum(s);
#pragma unroll
        for (int j = 0; j < 8; ++j) { const int col = 256 * j + 4 * lane; *(f32x4*)(p.out + (size_t)row * DM + col) = y[j];
            *(u32x2*)(A2 + (size_t)row * DM + col) = pk4(y[j] * *(const f32x4*)(p.norm_ffn + col)); }
        if (lane == 0) RSTD[row] = __builtin_amdgcn_rsqf(s * (1.0f / DM) + EPS);
    }
    for (int row = blockIdx.x * 512 + wid * 64 + lane; row < TP; row += gridDim.x * 512) {
        const f32x4* sp = (const f32x4*)(SSQ + (size_t)row * 32); f32x4 a = sp[0];
#pragma unroll
        for (int k = 1; k < 8; ++k) a += sp[k];
        RSTD[row] = __builtin_amdgcn_rsqf(((a[0] + a[1]) + (a[2] + a[3])) * (1.0f / DM) + EPS);
    }
}
DI void p5_reduce(const Params& p) {
    const float* PB = (const float*)(p.ws + WS_PB);
    for (int i = blockIdx.x * 512 + threadIdx.x; i < TS * DM / 4; i += gridDim.x * 512) { const size_t o = (size_t)i * 4; float* yp = p.out + (size_t)TP * DM + o;
        *(f32x4*)yp = *(const f32x4*)yp + ((*(const f32x4*)(PB + o) + *(const f32x4*)(PB + (size_t)TS * DM + o)) + (*(const f32x4*)(PB + (size_t)2 * TS * DM + o) + *(const f32x4*)(PB + (size_t)3 * TS * DM + o))); }
}

constexpr int LDS_BYTES = pg8::STAGE_BYTES + 16;

__global__ void __launch_bounds__(512, 2) fwd_megakernel(Params p) {
    extern __shared__ __attribute__((aligned(16))) unsigned char lds_raw[];
    LAS unsigned char* lds = (LAS unsigned char*)lds_raw;
    cg::grid_group grid = cg::this_grid();
    if (p.never) grid.sync();
    if (threadIdx.x < 4) ((LAS unsigned*)(lds + pg8::STAGE_BYTES))[threadIdx.x] = 0u;
    __syncthreads();
    const XcdBarrier xb = xcd_barrier_post((unsigned*)(p.ws + WS_BAR), (volatile LAS unsigned*)(lds + pg8::STAGE_BYTES));
    const int tid = threadIdx.x, wid = __builtin_amdgcn_readfirstlane(tid >> 6), lane = tid & 63;
    const int G = gridDim.x, bid = blockIdx.x;
    unsigned char* ws = p.ws;

    p0_prologue(p, lds, wid, lane);
    xcd_barrier(xb);
    {
        pg8::Gemm g{(const bf16_t*)(ws + WS_XN), (const bf16_t*)(ws + WS_WIN), MT, DIN, DM}; pg8::StaticOrder S; S.init(MT, DIN, G, bid);
        Epi1 E{(bf16_t*)(ws + WS_Q), (bf16_t*)(ws + WS_K), (bf16_t*)(ws + WS_V), (bf16_t*)(ws + WS_U), (bf16_t*)(ws + WS_BG), (bf16_t*)(ws + WS_SGA),
               p.q_norm, p.k_norm, (const float*)(ws + WS_COS), (const float*)(ws + WS_SIN), p.out};
        pg8::gemm_phase<Epi1, pg8::StaticOrder>(lds, g, S, E);
        {
            const int nfull = ((MT / 256) * (DIN / 256)) % G;
            if (nfull == 0) { p0_rest(p, lds, wid, lane, bid, G, 0); p0_rest(p, lds, wid, lane, bid, G, 1); }
            else if (bid >= nfull) { p0_rest(p, lds, wid, lane, bid - nfull, G - nfull, 0); p0_rest(p, lds, wid, lane, bid - nfull, G - nfull, 1); }
        }
    }
    xcd_barrier(xb);
    p2_attention(p, lds, tid, wid, lane);
    xcd_barrier(xb);
    {
        pg8::Gemm g{(const bf16_t*)(ws + WS_MIX), (const bf16_t*)(ws + WS_WOUT), MT, DM, DM}; pg8::SplitOrder S; S.init(DM, G, bid, DM / 64);
        Epi3 E{p.xp, p.xs, p.norm_ffn, p.out, (bf16_t*)(ws + WS_A2), (float*)(ws + WS_SSQ), (float*)(ws + WS_PB)};
        pg8::gemm_phase<Epi3, pg8::SplitOrder>(lds, g, S, E);
    }
    xcd_barrier(xb);
    p3_reduce(p, wid, lane);
    xcd_barrier(xb);
    {
        pg8::Gemm g{(const bf16_t*)(ws + WS_A2), (const bf16_t*)(ws + WS_WGU), MT, NGU, DM}; pg8::StaticOrder S; S.init(MT, NGU, G, bid);
        Epi4 E{(const float*)(ws + WS_RSTD), (bf16_t*)(ws + WS_HID)};
        pg8::gemm_phase<Epi4, pg8::StaticOrder>(lds, g, S, E);
        {   const int nfull = ((MT / 256) * (NGU / 256)) % G;
            if (nfull == 0) p0_rest(p, lds, wid, lane, bid, G, 2); else if (bid >= nfull) p0_rest(p, lds, wid, lane, bid - nfull, G - nfull, 2);
        }
    }
    xcd_barrier(xb);
    {
        pg8::Gemm g{(const bf16_t*)(ws + WS_HID), (const bf16_t*)(ws + WS_WDN), MT, DM, DFF}; pg8::SplitOrder S; S.init(DM, G, bid, DFF / 64);
        Epi5 E{p.out, (float*)(ws + WS_PB)};
        pg8::gemm_phase<Epi5, pg8::SplitOrder>(lds, g, S, E);
        {   const int nfull = S.total() % G;
            if (nfull == 0) cache_copy(p, bid, G); else if (bid >= nfull) cache_copy(p, bid - nfull, G - nfull);
        }
    }
    xcd_barrier(xb);
    p5_reduce(p);
}

extern "C" void kernel_launch(void* const* d_in, const int* in_sizes, int n_in, void* d_out, int out_size, void* d_ws, size_t ws_size, hipStream_t stream) {
    static int grid = 0;
    if (!grid) {
        int dev = 0, cus = 0, per_cu = 0;
        (void)hipGetDevice(&dev);
        (void)hipDeviceGetAttribute(&cus, hipDeviceAttributeMultiprocessorCount, dev);
        (void)hipFuncSetAttribute((const void*)fwd_megakernel, hipFuncAttributeMaxDynamicSharedMemorySize, LDS_BYTES);
        (void)hipOccupancyMaxActiveBlocksPerMultiprocessor(&per_cu, (const void*)fwd_megakernel, 512, LDS_BYTES);
        if (per_cu < 1) per_cu = 1;
        grid = cus * per_cu;
        if (ws_size < WS_END) fprintf(stderr, "kernel_launch: workspace too small (%zu < %zu)\n", ws_size, (size_t)WS_END);
    }
    Params p{};
    p.xp = (const float*)d_in[0]; p.xs = (const float*)d_in[1]; p.ck = (const float*)d_in[2]; p.cv = (const float*)d_in[3]; p.sconv = (const float*)d_in[4];
    p.norm_mix = (const float*)d_in[5]; p.w_in = (const float*)d_in[6]; p.q_norm = (const float*)d_in[7]; p.k_norm = (const float*)d_in[8]; p.sinks = (const float*)d_in[9];
    p.conv_w = (const float*)d_in[10]; p.w_out = (const float*)d_in[11]; p.norm_ffn = (const float*)d_in[12]; p.w_gu = (const float*)d_in[13]; p.w_dn = (const float*)d_in[14];
    p.out = (float*)d_out; p.ws = (unsigned char*)d_ws;
    p.never = 0;
    (void)hipMemsetAsync((char*)d_ws + WS_BAR, 0, 16384, stream);
    void* args[] = {&p};
    hipError_t e = hipLaunchCooperativeKernel((const void*)fwd_megakernel, dim3(grid), dim3(512), args, LDS_BYTES, stream);
    if (e != hipSuccess) fprintf(stderr, "cooperative launch failed: %s (grid %d)\n", hipGetErrorString(e), grid);
}
```

```cpp
#include <hip/hip_runtime.h>
#include <hip/hip_cooperative_groups.h>
#include <cstdio>
namespace cg = cooperative_groups;
#define REP_P0 1
#define REP_P1 1
#define REP_P2 1
#define REP_P3 1
#define REP_P4 1
#define REP_SYNC 0

#define LAS __attribute__((address_space(3)))
#define DI __device__ __forceinline__
typedef unsigned short bf16_t;
typedef short bf16x8 __attribute__((ext_vector_type(8)));
typedef short s16x4 __attribute__((ext_vector_type(4)));
typedef float f32x4 __attribute__((ext_vector_type(4)));
typedef float f32x16 __attribute__((ext_vector_type(16)));
typedef unsigned u32x4 __attribute__((ext_vector_type(4)));
typedef unsigned u32x2 __attribute__((ext_vector_type(2)));

constexpr int DM = 2048, TP = 8192, TS = 512, MT = TP + TS, DIN = 12800, DFF = 5632, NGU = 2 * DFF;
constexpr float EPS = 1e-6f;
constexpr int NPOS = 8196;
constexpr size_t O_YP = 0, O_YS = (size_t)TP * DM, O_PK = O_YS + (size_t)TS * DM, O_PV = O_PK + 32768, O_PC = O_PV + 32768,
                 O_SK = O_PC + 4096, O_SV = O_SK + 4194304, O_SC = O_SV + 4194304;
constexpr size_t WS_WIN = 0, WS_WOUT = WS_WIN + (size_t)DIN * DM * 2, WS_WGU = WS_WOUT + (size_t)DM * DM * 2, WS_WDN = WS_WGU + (size_t)NGU * DM * 2,
                 WS_XN = WS_WDN + (size_t)DM * DFF * 2, WS_Q = WS_XN + (size_t)MT * DM * 2, WS_K = WS_Q + (size_t)MT * DM * 2, WS_V = WS_K + (size_t)MT * 256 * 2,
                 WS_U = WS_V + (size_t)MT * 256 * 2, WS_BG = WS_U + (size_t)MT * DM * 2, WS_SGA = WS_BG + (size_t)MT * DM * 2, WS_COS = WS_SGA + (size_t)MT * DM * 2,
                 WS_SIN = WS_COS + (size_t)NPOS * 32 * 4, WS_SSQ = WS_SIN + (size_t)NPOS * 32 * 4, WS_BAR = WS_SSQ + (size_t)MT * 32 * 4, WS_RSTD = WS_BAR + 16384, WS_PB = WS_RSTD + 65536, WS_END = WS_PB + (size_t)4 * TS * DM * 4;
constexpr size_t WS_MIX = WS_XN, WS_A2 = WS_Q, WS_HID = WS_U;
static_assert((size_t)MT * DFF * 2 <= 3 * (size_t)MT * DM * 2, "hidden fits in U|BG|SGA");

struct Params {
    const float *xp, *xs, *ck, *cv, *sconv, *norm_mix, *w_in, *q_norm, *k_norm, *sinks, *conv_w, *w_out, *norm_ffn, *w_gu, *w_dn;
    float* out; unsigned char* ws; long never;
};

typedef float f32x2 __attribute__((ext_vector_type(2)));
typedef __bf16 bf16x2v __attribute__((ext_vector_type(2)));
DI unsigned pk2(float lo, float hi) { const f32x2 f = {lo, hi}; return __builtin_bit_cast(unsigned, __builtin_convertvector(f, bf16x2v)); }
DI u32x2 pk4(f32x4 v) { u32x2 r; r.x = pk2(v[0], v[1]); r.y = pk2(v[2], v[3]); return r; }
DI float bf_lo(unsigned w) { return __uint_as_float(w << 16); }
DI float bf_hi(unsigned w) { return __uint_as_float(w & 0xffff0000u); }
DI f32x4 unpk4(u32x2 w) { return (f32x4){bf_lo(w.x), bf_hi(w.x), bf_lo(w.y), bf_hi(w.y)}; }
DI float sigmoidf_(float x) { return __builtin_amdgcn_rcpf(1.0f + __builtin_amdgcn_exp2f(-1.44269504089f * x)); }
DI float wave_sum(float v) {
#pragma unroll
    for (int o = 1; o < 64; o <<= 1) v += __shfl_xor(v, o);
    return v;
}


#define XB_TMO      128
#define XB_XCNT(j)  (256  + 64 * (j))
#define XB_XSUB(j)  (1280 + 64 * (j))
#define XB_XGEN(j)  (2304 + 64 * (j))
#define XB_TOP      3328
#define XB_TOPGEN   3392
#define XCD_BAR_WORDS 3456
#define XB_SPIN_CAP (1u << 20)
DI unsigned xb_ld(unsigned* p)              { return __hip_atomic_load(p, __ATOMIC_RELAXED, __HIP_MEMORY_SCOPE_AGENT); }
DI unsigned xb_add(unsigned* p, unsigned v) { return __hip_atomic_fetch_add(p, v, __ATOMIC_RELAXED, __HIP_MEMORY_SCOPE_AGENT); }
DI unsigned xb_xcc_id() { return (unsigned)__builtin_amdgcn_s_getreg((3 << 11) | 20) & 0xFu; }
#define XB_SPIN(cond, bar) do { unsigned _sp = 0; while (cond) { __builtin_amdgcn_s_sleep(1); \
    if ((++_sp & 255u) == 0u) { if (xb_ld(&(bar)[XB_TMO])) break; if (_sp > XB_SPIN_CAP) { atomicAdd(&(bar)[XB_TMO], 1u); break; } } } } while (0)
struct XcdBarrier { unsigned* bar; unsigned x; volatile LAS unsigned* st; };
DI XcdBarrier xcd_barrier_post(unsigned* bar, volatile LAS unsigned* st) {
    XcdBarrier b; b.bar = bar; b.x = xb_xcc_id(); b.st = st;
    if (threadIdx.x == 0) (void)xb_add(&bar[XB_XCNT(b.x)], 1u);
    return b;
}
DI void xcd_barrier_complete(unsigned* bar, unsigned x, unsigned& nloc, unsigned& nx) {
    const unsigned G = gridDim.x * gridDim.y * gridDim.z;
    unsigned sum, cnt, mine, sp = 0u;
    for (;;) {
        sum = 0u; cnt = 0u; mine = 0u;
#pragma unroll
        for (unsigned j = 0; j < 16; ++j) { const unsigned c = xb_ld(&bar[XB_XCNT(j)]); sum += c; cnt += (c > 0u) ? 1u : 0u; mine = (j == x) ? c : mine; }
        if (sum == G) break;
        __builtin_amdgcn_s_sleep(1);
        if ((++sp & 255u) == 0u) { if (xb_ld(&bar[XB_TMO])) break; if (sp > XB_SPIN_CAP) { atomicAdd(&bar[XB_TMO], 1u); break; } }
    }
    nloc = mine > 0u ? mine : 1u; nx = cnt > 0u ? cnt : 1u;
}
DI void xcd_barrier(const XcdBarrier& b) {
    asm volatile("s_waitcnt vmcnt(0)" ::: "memory");
    __syncthreads();
    if (threadIdx.x == 0) {
        unsigned* bar = b.bar;
        __builtin_amdgcn_s_waitcnt(0);
        unsigned nloc = b.st[0], nx = b.st[1];
        if (nloc == 0u) { xcd_barrier_complete(bar, b.x, nloc, nx); b.st[0] = nloc; b.st[1] = nx; }
        const unsigned old = xb_add(&bar[XB_XSUB(b.x)], 1u);
        const unsigned gen = old / nloc;
        if (old + 1u == (gen + 1u) * nloc) {
            __builtin_amdgcn_fence(__ATOMIC_RELEASE, "agent");
            asm volatile("s_waitcnt vmcnt(0)" ::: "memory");
            const unsigned og = xb_add(&bar[XB_TOP], 1u);
            const unsigned tg = og / nx;
            if (og + 1u == (tg + 1u) * nx) xb_add(&bar[XB_TOPGEN], 1u);
            else XB_SPIN(xb_ld(&bar[XB_TOPGEN]) == tg, bar);
            __builtin_amdgcn_fence(__ATOMIC_ACQUIRE, "agent");
            xb_add(&bar[XB_XGEN(b.x)], 1u);
            asm volatile("s_waitcnt vmcnt(0)" ::: "memory");
        } else {
            XB_SPIN(xb_ld(&bar[XB_XGEN(b.x)]) == gen, bar);
            __builtin_amdgcn_fence(__ATOMIC_ACQUIRE, "agent");
            asm volatile("s_waitcnt vmcnt(0)" ::: "memory");
        }
    }
    __syncthreads();
}

namespace pg8 {
constexpr int BM = 256, BK = 64, HALF = 128, HTB = HALF * BK * 2, STAGE_BYTES = 8 * HTB, NXCD = 8, WGM = 8;
DI int lds_byte(int r, int c) { const int st = (r >> 4) * 2 + (c >> 5), rr = r & 15, cc = c & 31, ob = rr * 64 + cc * 2; return st * 1024 + (ob ^ (((ob >> 9) & 1) << 5)); }
DI void stage_rc(int b, int& R, int& C) { const int st = b / 1024, sb = b % 1024, swz = sb ^ (((sb >> 9) & 1) << 5); R = (st >> 1) * 16 + swz / 64; C = (st & 1) * 32 + (swz % 64) / 2; }
struct Unit { int pm, pn, k0, nt, split; };
struct Gemm { const bf16_t* A; const bf16_t* Bt; int M, N, K; };
struct StaticOrder {
    int nM, nN, nwg, G, c, ntk;
    DI void init(int M, int N, int G_, int c_, int ntk_ = 32) { nM = M / BM; nN = N / BM; nwg = nM * nN; G = G_; c = c_; ntk = ntk_; }
    DI void map(int L, Unit& u) const {
        int wgid = L; { const int q = nwg / NXCD, r = nwg % NXCD, xcd = wgid % NXCD, off = wgid / NXCD; wgid = (xcd < r ? xcd * (q + 1) : r * (q + 1) + (xcd - r) * q) + off; }
        const int nig = WGM * nN, gid = wgid / nig, fm = gid * WGM, gsz = (nM - fm) < WGM ? (nM - fm) : WGM;
        u.pm = fm + ((wgid % nig) % gsz); u.pn = (wgid % nig) / gsz; u.k0 = 0; u.nt = ntk; u.split = -1;
    }
    DI bool next(int i, Unit& u) const { const long L = (long)i * G + c; if (L >= nwg) return false; map((int)L, u); return true; }
};
struct SplitOrder {
    StaticOrder base;
    DI void init(int N, int G_, int c_, int ntk_) { base.init(TP, N, G_, c_, ntk_); }
    DI int total() const { return base.nwg + 16 * 4; }
    DI bool next(int i, Unit& u) const {
        int ii = i;
        if (base.G == 256 && base.c < 64 && i < 2) ii = 1 - i;
        const int L = ii * base.G + base.c;
        if (L >= base.nwg + 64) return false;
        const bool sp = L >= base.nwg;
        Unit a; base.map(sp ? 0 : L, a);
        const int j = L - base.nwg, tile = j >> 2, s4 = j & 3, q = base.ntk >> 2;
        u.pm = sp ? (TP / BM + (tile >> 3)) : a.pm; u.pn = sp ? (tile & 7) : a.pn; u.nt = sp ? q : a.nt; u.k0 = sp ? s4 * q : 0; u.split = sp ? s4 : -1;
        return true;
    }
};

template <class Epi, class Sched>
DI void gemm_phase(LAS unsigned char* lds, const Gemm g, const Sched& S, const Epi& E) {
    const int tid = threadIdx.x, wid = __builtin_amdgcn_readfirstlane(tid >> 6), lane = tid & 63, wr = wid >> 2, wc = wid & 3, fr = lane & 15, fq = lane >> 4;
    const int K = g.K;
    unsigned voffA[2];
#pragma unroll
    for (int i = 0; i < 2; ++i) { int R, C; stage_rc(tid * 16 + i * 8192, R, C); voffA[i] = (unsigned)(R * K + C) * 2u; }
    const size_t kstep = (size_t)(BK * 2);
    const size_t hstep = (size_t)HALF * K * 2;
    const size_t tstep = 2 * hstep;
    const unsigned ldsw = (unsigned)wid * 1024u;
    const int aoff = lds_byte(wr * 64 + fr, fq * 8), boff = lds_byte(wc * 32 + fr, fq * 8);
#define PG8_SA(b, h) (((b) * 2 + (h)) * HTB)
#define PG8_SB(b, h) ((4 + (b) * 2 + (h)) * HTB)
#define PG8_STAGE(bufoff, gbase) do { _Pragma("unroll") for (int _i = 0; _i < 2; ++_i) \
        __builtin_amdgcn_global_load_lds((const unsigned*)((const char*)(gbase) + voffA[_i]), (LAS unsigned*)(lds + (bufoff) + ldsw + _i * 8192), 16, 0, 0); } while (0)
#define PG8_LDA(dst, b, h) do { _Pragma("unroll") for (int m = 0; m < 4; ++m) _Pragma("unroll") for (int k = 0; k < 2; ++k) dst[m][k] = *(const LAS bf16x8*)(lds + PG8_SA(b, h) + aoff + m * 2048 + k * 1024); } while (0)
#define PG8_LDB(dst, b, h) do { _Pragma("unroll") for (int n = 0; n < 2; ++n) _Pragma("unroll") for (int k = 0; k < 2; ++k) dst[n][k] = *(const LAS bf16x8*)(lds + PG8_SB(b, h) + boff + n * 2048 + k * 1024); } while (0)
#define PG8_MMA(ai, bj, At, Bt) do { __builtin_amdgcn_s_setprio(1); _Pragma("unroll") for (int m = 0; m < 4; ++m) _Pragma("unroll") for (int n = 0; n < 2; ++n) _Pragma("unroll") for (int k = 0; k < 2; ++k) \
        acc[ai][bj][m][n] = __builtin_amdgcn_mfma_f32_16x16x32_bf16(Bt[n][k], At[m][k], acc[ai][bj][m][n], 0, 0, 0); __builtin_amdgcn_s_setprio(0); } while (0)
#define PG8_WAIT_V(n) asm volatile("s_waitcnt vmcnt(" #n ")" ::: "memory")
#define PG8_WAIT_L(n) asm volatile("s_waitcnt lgkmcnt(" #n ")" ::: "memory")
#define PG8_BAR __builtin_amdgcn_s_barrier()
#define PG8_SCHED __builtin_amdgcn_sched_barrier(0)
    Unit cur, nxt; int ui = 0;
    if (!S.next(0, cur)) return;
    f32x4 acc[2][2][4][2];
#pragma unroll
    for (int a = 0; a < 2; ++a)
#pragma unroll
        for (int b = 0; b < 2; ++b)
#pragma unroll
            for (int m = 0; m < 4; ++m)
#pragma unroll
                for (int n = 0; n < 2; ++n) acc[a][b][m][n] = (f32x4){0.f, 0.f, 0.f, 0.f};
    bf16x8 At[4][2], B0[2][2], B1[2][2];
    const char* cA = (const char*)g.A + (size_t)cur.pm * tstep + (size_t)cur.k0 * kstep; const char* cB = (const char*)g.Bt + (size_t)cur.pn * tstep + (size_t)cur.k0 * kstep;
    PG8_STAGE(PG8_SB(0, 0), cB); PG8_STAGE(PG8_SA(0, 0), cA); PG8_STAGE(PG8_SB(0, 1), cB + hstep); PG8_STAGE(PG8_SA(0, 1), cA + hstep);
    if (wr == 1) PG8_BAR;
    PG8_WAIT_V(4); PG8_BAR;
    PG8_STAGE(PG8_SB(1, 0), cB + kstep); PG8_STAGE(PG8_SA(1, 0), cA + kstep); PG8_STAGE(PG8_SB(1, 1), cB + hstep + kstep);
    PG8_WAIT_V(6); PG8_BAR;
    for (;;) {
        const bool has_next = S.next(ui + 1, nxt);
        const char* nA = has_next ? (const char*)g.A + (size_t)nxt.pm * tstep + (size_t)nxt.k0 * kstep : cA; const char* nB = has_next ? (const char*)g.Bt + (size_t)nxt.pn * tstep + (size_t)nxt.k0 * kstep : cB;
        const int nt = cur.nt;
        for (int t = 0; t < nt; t += 2) {
            const bool last = (t == nt - 2);
            const char* a1 = cA + (size_t)(t + 1) * kstep;
            const char* a2 = last ? nA : cA + (size_t)(t + 2) * kstep; const char* b2 = last ? nB : cB + (size_t)(t + 2) * kstep;
            const char* a3 = a2 + kstep; const char* b3 = b2 + kstep;
            PG8_LDB(B0, 0, 0); PG8_SCHED; PG8_LDA(At, 0, 0); PG8_STAGE(PG8_SA(1, 1), a1 + hstep);
            PG8_WAIT_L(8); PG8_BAR; PG8_WAIT_L(0); PG8_MMA(0, 0, At, B0); PG8_BAR; PG8_SCHED;
            PG8_LDB(B1, 0, 1); PG8_STAGE(PG8_SB(0, 0), b2);
            PG8_BAR; PG8_WAIT_L(0); PG8_MMA(0, 1, At, B1); PG8_BAR;
            PG8_LDA(At, 0, 1); PG8_STAGE(PG8_SA(0, 0), a2);
            PG8_BAR; PG8_WAIT_L(0); PG8_MMA(1, 0, At, B0); PG8_BAR; PG8_SCHED;
            PG8_STAGE(PG8_SB(0, 1), b2 + hstep);
            PG8_WAIT_V(6); PG8_BAR; PG8_MMA(1, 1, At, B1); PG8_BAR;
            PG8_LDB(B0, 1, 0); PG8_SCHED; PG8_LDA(At, 1, 0); PG8_STAGE(PG8_SA(0, 1), a2 + hstep);
            PG8_WAIT_L(8); PG8_BAR; PG8_WAIT_L(0); PG8_MMA(0, 0, At, B0); PG8_BAR; PG8_SCHED;
            PG8_LDB(B1, 1, 1); PG8_STAGE(PG8_SB(1, 0), b3);
            PG8_BAR; PG8_WAIT_L(0); PG8_MMA(0, 1, At, B1); PG8_BAR;
            PG8_LDA(At, 1, 1); PG8_STAGE(PG8_SA(1, 0), a3);
            PG8_BAR; PG8_WAIT_L(0); PG8_MMA(1, 0, At, B0); PG8_BAR; PG8_SCHED;
            PG8_STAGE(PG8_SB(1, 1), b3 + hstep);
            PG8_WAIT_V(6); PG8_BAR; PG8_MMA(1, 1, At, B1); PG8_BAR;
        }
        E(acc, cur, wr, wc, fr, fq);
        if (!has_next) break;
#pragma unroll
        for (int a = 0; a < 2; ++a)
#pragma unroll
            for (int b = 0; b < 2; ++b)
#pragma unroll
                for (int m = 0; m < 4; ++m)
#pragma unroll
                    for (int n = 0; n < 2; ++n) acc[a][b][m][n] = (f32x4){0.f, 0.f, 0.f, 0.f};
        cur = nxt; cA = nA; cB = nB; ++ui;
    }
    PG8_WAIT_V(0);
    if (wr == 0) PG8_BAR;
    PG8_BAR;
#undef PG8_SA
#undef PG8_SB
#undef PG8_STAGE
#undef PG8_LDA
#undef PG8_LDB
#undef PG8_MMA
#undef PG8_WAIT_V
#undef PG8_WAIT_L
#undef PG8_BAR
#undef PG8_SCHED
}
}

typedef f32x4 AccT[2][2][4][2];

DI int src_col_in(int R) {
    const int pn = R >> 8, c = R & 255, bj = c >> 7, wc = (c >> 5) & 3, r5 = c & 31;
    if (pn < 8) return (4 * pn + wc) * 64 + 32 * bj + r5;
    if (pn == 8) return 2048 + wc * 64 + 32 * bj + r5;
    if (pn == 9) return 2304 + c;
    if (pn < 26) return (bj ? 6656 : 2560) + 128 * (pn - 10) + (c & 127);
    if (pn < 42) return (bj ? 10752 : 4608) + 128 * (pn - 26) + (c & 127);
    return 8704 + 256 * (pn - 42) + c;
}
DI int src_col_gu(int R) { const int t = R >> 8, c = R & 255; return ((c >> 7) ? DFF : 0) + 128 * t + (c & 127); }

DI unsigned bperm(int src4, unsigned v) { return (unsigned)__builtin_amdgcn_ds_bpermute(src4, (int)v); }
DI u32x2 perm2(int src4, u32x2 v) { u32x2 r; r.x = bperm(src4, v.x); r.y = bperm(src4, v.y); return r; }
DI f32x4 perm4(int src4, f32x4 v) { f32x4 r; r[0] = __uint_as_float(bperm(src4, __float_as_uint(v[0]))); r[1] = __uint_as_float(bperm(src4, __float_as_uint(v[1])));
    r[2] = __uint_as_float(bperm(src4, __float_as_uint(v[2]))); r[3] = __uint_as_float(bperm(src4, __float_as_uint(v[3]))); return r; }

struct Epi1 {
    bf16_t *Q, *Kb, *Vb, *U, *BG, *SGA; const float *qg, *kg, *cosT, *sinT; float* out;
    DI void side_kv(float* pwin, float* swin, int row, int col, f32x4 v) const {
        if (row >= TP - 128 && row < TP) *(f32x4*)(pwin + (size_t)(row - (TP - 128)) * 256 + col) = v;
        if (row >= TP) { const int b = (row - TP) >> 2, i = (row - TP) & 3; *(f32x4*)(swin + (size_t)b * 32768 + (size_t)(124 + i) * 256 + col) = v; }
    }
    DI void operator()(const AccT& acc, const pg8::Unit& u, int wr, int wc, int fr, int fq) const {
        asm volatile("" : "+v"(fr), "+v"(fq));
        const int lane = fr + 16 * fq, tr = lane >> 2, tq = lane & 3, src4 = (tr + 16 * tq) * 4;
        const int pn = u.pn, row0 = u.pm * 256 + wr * 64 + fr, rowT0 = u.pm * 256 + wr * 64 + tr;
        const bool side = u.pm >= 31;
        if (pn < 9) {
            const float* g = pn < 8 ? qg : kg;
            f32x4 gv[2][2];
#pragma unroll
            for (int bj = 0; bj < 2; ++bj)
#pragma unroll
                for (int n = 0; n < 2; ++n) gv[bj][n] = *(const f32x4*)(g + 32 * bj + 16 * n + 4 * fq);
#pragma unroll
            for (int aim = 0; aim < 4; ++aim) {
                const int ai = aim >> 1, mh = (aim & 1) * 2;
                f32x4 cs[4][2], sn[4][2];
#pragma unroll
                for (int m = mh; m < mh + 2; ++m) {
                    const int row = row0 + 128 * ai + 16 * m;
                    const int pos = row < TP ? row : TP + ((row - TP) & 3);
#pragma unroll
                    for (int n = 0; n < 2; ++n) { cs[m][n] = *(const f32x4*)(cosT + (size_t)pos * 32 + 16 * n + 4 * fq); sn[m][n] = *(const f32x4*)(sinT + (size_t)pos * 32 + 16 * n + 4 * fq); }
                }
#pragma unroll
                for (int m = mh; m < mh + 2; ++m) {
                    const int rowT = rowT0 + 128 * ai + 16 * m;
                    float ssq = 0.f;
#pragma unroll
                    for (int bj = 0; bj < 2; ++bj)
#pragma unroll
                        for (int n = 0; n < 2; ++n) { const f32x4 x = acc[ai][bj][m][n]; ssq += (x[0] * x[0] + x[1] * x[1]) + (x[2] * x[2] + x[3] * x[3]); }
                    ssq += __shfl_xor(ssq, 16); ssq += __shfl_xor(ssq, 32);
                    const float rs = __builtin_amdgcn_rsqf(ssq * (1.0f / 64.0f) + EPS);
#pragma unroll
                    for (int n = 0; n < 2; ++n) {
                        const f32x4 y1 = acc[ai][0][m][n] * rs * gv[0][n], y2 = acc[ai][1][m][n] * rs * gv[1][n];
                        const f32x4 o1 = y1 * cs[m][n] - y2 * sn[m][n], o2 = y2 * cs[m][n] + y1 * sn[m][n];
                        const int d = 16 * n + 4 * tq;
                        const u32x2 w1 = perm2(src4, pk4(o1)), w2 = perm2(src4, pk4(o2));
                        if (pn < 8) {
                            bf16_t* qp = Q + (size_t)rowT * DM + (4 * pn + wc) * 64 + d;
                            *(u32x2*)qp = w1; *(u32x2*)(qp + 32) = w2;
                        } else {
                            bf16_t* kp = Kb + (size_t)rowT * 256 + wc * 64 + d;
                            *(u32x2*)kp = w1; *(u32x2*)(kp + 32) = w2;
                            if (side) { const f32x4 t1 = perm4(src4, o1), t2 = perm4(src4, o2);
                                side_kv(out + O_PK, out + O_SK, rowT, wc * 64 + d, t1); side_kv(out + O_PK, out + O_SK, rowT, wc * 64 + d + 32, t2); }
                        }
                    }
                }
            }
        } else if (pn == 9) {
#pragma unroll
            for (int ai = 0; ai < 2; ++ai)
#pragma unroll
                for (int m = 0; m < 4; ++m) {
                    const int rowT = rowT0 + 128 * ai + 16 * m;
#pragma unroll
                    for (int bj = 0; bj < 2; ++bj)
#pragma unroll
                        for (int n = 0; n < 2; ++n) { const int col = 128 * bj + 32 * wc + 16 * n + 4 * tq; const f32x4 v = acc[ai][bj][m][n];
                            *(u32x2*)(Vb + (size_t)rowT * 256 + col) = perm2(src4, pk4(v));
                            if (side) side_kv(out + O_PV, out + O_SV, rowT, col, perm4(src4, v)); }
                }
        } else if (pn < 26) {
            const int t = pn - 10;
#pragma unroll
            for (int ai = 0; ai < 2; ++ai)
#pragma unroll
                for (int m = 0; m < 4; ++m) {
                    const int rowT = rowT0 + 128 * ai + 16 * m;
#pragma unroll
                    for (int n = 0; n < 2; ++n) { const int col = 128 * t + 32 * wc + 16 * n + 4 * tq; const f32x4 v = acc[ai][0][m][n] * acc[ai][1][m][n];
                        *(u32x2*)(U + (size_t)rowT * DM + col) = perm2(src4, pk4(v));
                        if (side) { const f32x4 vt = perm4(src4, v);
                            if (rowT >= TP - 2 && rowT < TP) *(f32x4*)(out + O_PC + (size_t)(rowT - (TP - 2)) * DM + col) = vt;
                            if (rowT >= TP && ((rowT - TP) & 3) >= 2) { const int b = (rowT - TP) >> 2, i = (rowT - TP) & 3; *(f32x4*)(out + O_SC + (size_t)b * 4096 + (size_t)(i - 2) * DM + col) = vt; } } }
                }
        } else if (pn < 42) {
            const int t = pn - 26;
#pragma unroll
            for (int ai = 0; ai < 2; ++ai)
#pragma unroll
                for (int m = 0; m < 4; ++m) {
                    const int rowT = rowT0 + 128 * ai + 16 * m;
#pragma unroll
                    for (int n = 0; n < 2; ++n) { const int col = 128 * t + 32 * wc + 16 * n + 4 * tq; const f32x4 b = acc[ai][0][m][n], gc = acc[ai][1][m][n];
                        f32x4 v; v[0] = b[0] * sigmoidf_(gc[0]); v[1] = b[1] * sigmoidf_(gc[1]); v[2] = b[2] * sigmoidf_(gc[2]); v[3] = b[3] * sigmoidf_(gc[3]);
                        *(u32x2*)(BG + (size_t)rowT * DM + col) = perm2(src4, pk4(v)); }
                }
        } else {
#pragma unroll
            for (int ai = 0; ai < 2; ++ai)
#pragma unroll
                for (int m = 0; m < 4; ++m) {
                    const int rowT = rowT0 + 128 * ai + 16 * m;
#pragma unroll
                    for (int bj = 0; bj < 2; ++bj)
#pragma unroll
                        for (int n = 0; n < 2; ++n) { const int col = 256 * (pn - 42) + 128 * bj + 32 * wc + 16 * n + 4 * tq; const f32x4 a = acc[ai][bj][m][n];
                            f32x4 v; v[0] = sigmoidf_(a[0]); v[1] = sigmoidf_(a[1]); v[2] = sigmoidf_(a[2]); v[3] = sigmoidf_(a[3]);
                            *(u32x2*)(SGA + (size_t)rowT * DM + col) = perm2(src4, pk4(v)); }
                }
        }
    }
};

DI void store_partial(float* PB, const AccT& acc, const pg8::Unit& u, int wr, int wc, int tr, int tq, int src4) {
    float* pb = PB + ((size_t)u.split * TS + (size_t)(u.pm * 256 - TP) + wr * 64 + tr) * DM + u.pn * 256 + wc * 32 + 4 * tq;
#pragma unroll
    for (int ai = 0; ai < 2; ++ai)
#pragma unroll
        for (int m = 0; m < 4; ++m)
#pragma unroll
            for (int bj = 0; bj < 2; ++bj)
#pragma unroll
                for (int n = 0; n < 2; ++n) *(f32x4*)(pb + (size_t)(128 * ai + 16 * m) * DM + 128 * bj + 16 * n) = perm4(src4, acc[ai][bj][m][n]);
}

struct Epi3 {
    const float *xp, *xs, *gffn; float* Y; bf16_t* A2; float* SSQ; float* PB;
    DI void operator()(const AccT& acc, const pg8::Unit& u, int wr, int wc, int fr, int fq) const {
        asm volatile("" : "+v"(fr), "+v"(fq));
        const int lane = fr + 16 * fq, tr = lane >> 2, tq = lane & 3, src4 = (tr + 16 * tq) * 4;
        if (u.split >= 0) { store_partial(PB, acc, u, wr, wc, tr, tq, src4); return; }
        const int rowT0 = u.pm * 256 + wr * 64 + tr, colT0 = u.pn * 256 + wc * 32 + 4 * tq;
        const float* xb = u.pm < 32 ? xp : xs - (size_t)TP * DM;
        f32x4 gv[2][2];
#pragma unroll
        for (int bj = 0; bj < 2; ++bj)
#pragma unroll
            for (int n = 0; n < 2; ++n) gv[bj][n] = *(const f32x4*)(gffn + colT0 + 128 * bj + 16 * n);
#pragma unroll
        for (int aim = 0; aim < 4; ++aim) {
            const int ai = aim >> 1, mh = (aim & 1) * 2;
            f32x4 xv[4][2][2];
#pragma unroll
            for (int m = mh; m < mh + 2; ++m)
#pragma unroll
                for (int bj = 0; bj < 2; ++bj)
#pragma unroll
                    for (int n = 0; n < 2; ++n) xv[m][bj][n] = *(const f32x4*)(xb + (size_t)(rowT0 + 128 * ai + 16 * m) * DM + colT0 + 128 * bj + 16 * n);
#pragma unroll
            for (int m = mh; m < mh + 2; ++m) {
                const int rowT = rowT0 + 128 * ai + 16 * m; float ssq = 0.f;
#pragma unroll
                for (int bj = 0; bj < 2; ++bj)
#pragma unroll
                    for (int n = 0; n < 2; ++n) { const size_t off = (size_t)rowT * DM + colT0 + 128 * bj + 16 * n;
                        const f32x4 y = xv[m][bj][n] + perm4(src4, acc[ai][bj][m][n]);
                        ssq += (y[0] * y[0] + y[1] * y[1]) + (y[2] * y[2] + y[3] * y[3]);
                        *(f32x4*)(Y + off) = y; *(u32x2*)(A2 + off) = pk4(y * gv[bj][n]); }
                ssq += __shfl_xor(ssq, 1); ssq += __shfl_xor(ssq, 2);
                if (tq == 0) SSQ[(size_t)rowT * 32 + u.pn * 4 + wc] = ssq;
            }
        }
    }
};

struct Epi4 {
    const float* RSTD; bf16_t* HID;
    DI void operator()(const AccT& acc, const pg8::Unit& u, int wr, int wc, int fr, int fq) const {
        asm volatile("" : "+v"(fr), "+v"(fq));
        const int lane = fr + 16 * fq, tr = lane >> 2, tq = lane & 3, src4 = (tr + 16 * tq) * 4;
        const int row0 = u.pm * 256 + wr * 64 + fr, rowT0 = u.pm * 256 + wr * 64 + tr, colT0 = u.pn * 128 + wc * 32 + 4 * tq;
        float rs[2][4];
#pragma unroll
        for (int ai = 0; ai < 2; ++ai)
#pragma unroll
            for (int m = 0; m < 4; ++m) rs[ai][m] = RSTD[row0 + 128 * ai + 16 * m];
#pragma unroll
        for (int ai = 0; ai < 2; ++ai)
#pragma unroll
            for (int m = 0; m < 4; ++m) {
                const int rowT = rowT0 + 128 * ai + 16 * m;
                const float rstd = rs[ai][m];
#pragma unroll
                for (int n = 0; n < 2; ++n) { const f32x4 g = acc[ai][0][m][n] * rstd, up = acc[ai][1][m][n] * rstd;
                    f32x4 h; h[0] = g[0] * sigmoidf_(g[0]) * up[0]; h[1] = g[1] * sigmoidf_(g[1]) * up[1]; h[2] = g[2] * sigmoidf_(g[2]) * up[2]; h[3] = g[3] * sigmoidf_(g[3]) * up[3];
                    *(u32x2*)(HID + (size_t)rowT * DFF + colT0 + 16 * n) = perm2(src4, pk4(h)); }
            }
    }
};

struct Epi5 {
    float* Y; float* PB;
    DI void operator()(const AccT& acc, const pg8::Unit& u, int wr, int wc, int fr, int fq) const {
        asm volatile("" : "+v"(fr), "+v"(fq));
        const int lane = fr + 16 * fq, tr = lane >> 2, tq = lane & 3, src4 = (tr + 16 * tq) * 4;
        if (u.split >= 0) { store_partial(PB, acc, u, wr, wc, tr, tq, src4); return; }
        float* yb = Y + (size_t)(u.pm * 256 + wr * 64 + tr) * DM + u.pn * 256 + wc * 32 + 4 * tq;
        f32x4 cur[2][2], nxt[2][2];
#pragma unroll
        for (int bj = 0; bj < 2; ++bj)
#pragma unroll
            for (int n = 0; n < 2; ++n) cur[bj][n] = *(const f32x4*)(yb + 128 * bj + 16 * n);
#pragma unroll
        for (int k = 0; k < 8; ++k) {
            const int ai = k >> 2, m = k & 3;
            if (k < 7) { const int a2 = (k + 1) >> 2, m2 = (k + 1) & 3;
#pragma unroll
                for (int bj = 0; bj < 2; ++bj)
#pragma unroll
                    for (int n = 0; n < 2; ++n) nxt[bj][n] = *(const f32x4*)(yb + (size_t)(128 * a2 + 16 * m2) * DM + 128 * bj + 16 * n); }
#pragma unroll
            for (int bj = 0; bj < 2; ++bj)
#pragma unroll
                for (int n = 0; n < 2; ++n) *(f32x4*)(yb + (size_t)(128 * ai + 16 * m) * DM + 128 * bj + 16 * n) = cur[bj][n] + perm4(src4, acc[ai][bj][m][n]);
#pragma unroll
            for (int bj = 0; bj < 2; ++bj)
#pragma unroll
                for (int n = 0; n < 2; ++n) cur[bj][n] = nxt[bj][n];
        }
    }
};

DI void p0_transpose_item(const float* W, int K, int N, bf16_t* WT, int src_n0, int dst_n0, int k0, LAS float* scr, int lane) {
#pragma unroll 8
    for (int i = 0; i < 32; ++i) { const int kk = 2 * i + (lane >> 5); scr[kk * 33 + (lane & 31)] = W[(size_t)(k0 + kk) * N + src_n0 + (lane & 31)]; }
    asm volatile("s_waitcnt lgkmcnt(0)" ::: "memory");
    const int c = lane & 7;
#pragma unroll
    for (int j = 0; j < 4; ++j) { const int n = (lane >> 3) + 8 * j; const LAS float* s = scr + (8 * c) * 33 + n;
        u32x4 o; o.x = pk2(s[0 * 33], s[1 * 33]); o.y = pk2(s[2 * 33], s[3 * 33]); o.z = pk2(s[4 * 33], s[5 * 33]); o.w = pk2(s[6 * 33], s[7 * 33]);
        *(u32x4*)(WT + (size_t)(dst_n0 + n) * K + k0 + 8 * c) = o; }
    asm volatile("s_waitcnt lgkmcnt(0)" ::: "memory");
}

DI void p0_rest(const Params& p, LAS unsigned char* lds, int wid, int lane, int worker, int nworkers, int part) {
    LAS float* scr = (LAS float*)(lds + wid * 8704);
    const int gw = worker * 8 + wid, NGW = nworkers * 8;
    bf16_t* WoutT = (bf16_t*)(p.ws + WS_WOUT); bf16_t* WguT = (bf16_t*)(p.ws + WS_WGU); bf16_t* WdnT = (bf16_t*)(p.ws + WS_WDN);
    constexpr int I_OUT = (DM / 64) * (DM / 32), I_GU = (DM / 64) * (NGU / 32), I_DN = (DFF / 64) * (DM / 32);
    if (part == 0) {
        for (int r = gw; r < I_OUT; r += NGW) { const int nblk = DM / 32, kb = r / nblk, nb = r % nblk; p0_transpose_item(p.w_out, DM, DM, WoutT, 32 * nb, 32 * nb, 64 * kb, scr, lane); }
    } else if (part == 1) {
        for (int r = gw; r < I_GU; r += NGW) { const int nblk = NGU / 32, kb = r / nblk, nb = r % nblk; p0_transpose_item(p.w_gu, DM, NGU, WguT, src_col_gu(32 * nb), 32 * nb, 64 * kb, scr, lane); }
    } else {
        for (int r = gw; r < I_DN; r += NGW) { const int nblk = DM / 32, kb = r / nblk, nb = r % nblk; p0_transpose_item(p.w_dn, DFF, DM, WdnT, 32 * nb, 32 * nb, 64 * kb, scr, lane); }
    }
}

DI void p0_prologue(const Params& p, LAS unsigned char* lds, int wid, int lane) {
    LAS float* scr = (LAS float*)(lds + wid * 8704);
    const int gw = blockIdx.x * 8 + wid, NGW = gridDim.x * 8;
    bf16_t* WinT = (bf16_t*)(p.ws + WS_WIN);
    constexpr int I_IN = (DM / 64) * (DIN / 32);
    for (int it = gw; it < I_IN; it += NGW) { const int nblk = DIN / 32, kb = it / nblk, nb = it % nblk; p0_transpose_item(p.w_in, DM, DIN, WinT, src_col_in(32 * nb), 32 * nb, 64 * kb, scr, lane); }
    bf16_t* XN = (bf16_t*)(p.ws + WS_XN);
    for (int m = gw; m < MT; m += NGW) {
        const float* xrow = m < TP ? p.xp + (size_t)m * DM : p.xs + (size_t)(m - TP) * DM;
        const f32x4* xr = (const f32x4*)xrow + lane; f32x4 v[8]; float s = 0.f;
#pragma unroll
        for (int j = 0; j < 8; ++j) { v[j] = xr[64 * j]; s += (v[j][0] * v[j][0] + v[j][1] * v[j][1]) + (v[j][2] * v[j][2] + v[j][3] * v[j][3]); }
        const float rstd = 1.0f / sqrtf(wave_sum(s) * (1.0f / DM) + EPS);
        u32x2* o8 = (u32x2*)(XN + (size_t)m * DM) + lane;
#pragma unroll
        for (int j = 0; j < 8; ++j) { const f32x4 gv = ((const f32x4*)p.norm_mix)[64 * j + lane]; o8[64 * j] = pk4(v[j] * rstd * gv); }
    }
    float* cosT = (float*)(p.ws + WS_COS); float* sinT = (float*)(p.ws + WS_SIN);
    const int gt = blockIdx.x * 512 + threadIdx.x, GT = gridDim.x * 512;
    for (int idx = gt; idx < NPOS * 32; idx += GT) {
        const int pos = idx >> 5, i = idx & 31;
        const float inv = __builtin_amdgcn_exp2f(-(float)i * (13.287712379549449f / 32.0f));
        const float ang = (float)pos * inv;
        const double rev = (double)ang * 0.15915494309189535; const float fr = (float)(rev - __builtin_floor(rev));
        cosT[idx] = __builtin_amdgcn_cosf(fr); sinT[idx] = __builtin_amdgcn_sinf(fr);
    }
}

DI void cache_copy(const Params& p, int worker, int nworkers) {
    const int gt = worker * 512 + threadIdx.x, GT = nworkers * 512;
    for (int idx = gt; idx < 128 * 7936; idx += GT) {
        const int b = idx / 7936, e = idx - b * 7936;
        ((f32x4*)(p.out + O_SK + (size_t)b * 32768))[e] = ((const f32x4*)(p.ck + (size_t)b * 32768 + 1024))[e];
        ((f32x4*)(p.out + O_SV + (size_t)b * 32768))[e] = ((const f32x4*)(p.cv + (size_t)b * 32768 + 1024))[e];
    }
}

#define MFMA32(a, b, c) __builtin_amdgcn_mfma_f32_32x32x16_bf16((a), (b), (c), 0, 0, 0)
DI int crow(int reg, int h) { return (reg & 3) + 8 * (reg >> 2) + 4 * h; }
DI bf16x8 pack8(const f32x16& x, int s) {
    u32x4 p; p.x = pk2(x[8 * s], x[8 * s + 1]); p.y = pk2(x[8 * s + 2], x[8 * s + 3]); p.z = pk2(x[8 * s + 4], x[8 * s + 5]); p.w = pk2(x[8 * s + 6], x[8 * s + 7]);
    return __builtin_bit_cast(bf16x8, p);
}
DI bf16x8 cvt8(f32x4 a, f32x4 b) { u32x4 p; p.x = pk2(a[0], a[1]); p.y = pk2(a[2], a[3]); p.z = pk2(b[0], b[1]); p.w = pk2(b[2], b[3]); return __builtin_bit_cast(bf16x8, p); }

constexpr int KS_STRIDE = 72, VT_STRIDE = 260, VT_OFF = 256 * KS_STRIDE * 2;

template <bool SAMPLE>
DI void attn_chunk(const Params& p, LAS unsigned char* lds, int qb, int c, int kvh, int head_w, int b_s, int lane) {
    const bf16_t* Q = (const bf16_t*)(p.ws + WS_Q); const bf16_t* Kb = (const bf16_t*)(p.ws + WS_K); const bf16_t* Vb = (const bf16_t*)(p.ws + WS_V);
    const bf16_t* U = (const bf16_t*)(p.ws + WS_U); const bf16_t* BG = (const bf16_t*)(p.ws + WS_BG); const bf16_t* SGA = (const bf16_t*)(p.ws + WS_SGA);
    bf16_t* MIX = (bf16_t*)(p.ws + WS_MIX);
    const int r = lane & 31, g = lane >> 5;
    int tok, head, itok = 0;
    if (SAMPLE) { itok = r >> 3; head = kvh * 8 + (r & 7); tok = TP + 4 * b_s + itok; }
    else { head = head_w; tok = 128 * qb + 32 * c + r; }
    const LAS bf16_t* Ks = (const LAS bf16_t*)lds; const LAS bf16_t* Vt = (const LAS bf16_t*)(lds + VT_OFF);
    bf16x8 qf[4];
#pragma unroll
    for (int ks = 0; ks < 4; ++ks) qf[ks] = *(const bf16x8*)(Q + (size_t)tok * DM + head * 64 + 16 * ks + 8 * g);
    f32x16 s[5];
#pragma unroll
    for (int kbr = 0; kbr < 5; ++kbr) {
#pragma unroll
        for (int i = 0; i < 16; ++i) s[kbr][i] = 0.f;
#pragma unroll
        for (int ks = 0; ks < 4; ++ks) {
            bf16x8 a;
            if (SAMPLE) {
                if (kbr < 4) { const float* kp = p.ck + ((size_t)(b_s * 128 + 32 * kbr + r) * 4 + kvh) * 64 + 16 * ks + 8 * g; a = cvt8(*(const f32x4*)kp, *(const f32x4*)(kp + 4)); }
                else { u32x4 z = (u32x4){0u, 0u, 0u, 0u}; if (r < 4) z = *(const u32x4*)(Kb + (size_t)(TP + 4 * b_s + r) * 256 + kvh * 64 + 16 * ks + 8 * g); a = __builtin_bit_cast(bf16x8, z); }
            } else a = *(const LAS bf16x8*)(Ks + (32 * (c + kbr) + r) * KS_STRIDE + 16 * ks + 8 * g);
            s[kbr] = MFMA32(a, qf[ks], s[kbr]);
        }
    }
    const float sc = 0.125f * 1.44269504089f;
    const float sink2 = p.sinks[head] * 1.44269504089f;
    float mraw = -1e30f;
#pragma unroll
    for (int kbr = 0; kbr < 5; ++kbr)
#pragma unroll
        for (int i = 0; i < 16; ++i) {
            const int kr = crow(i, g); bool valid;
            if (SAMPLE) valid = kbr < 4 ? (32 * kbr + kr > itok) : (kr <= itok);
            else { valid = kbr == 0 ? (kr > r) : (kbr == 4 ? (kr <= r) : true); if (qb == 0 && c + kbr < 4) valid = false; }
            const float t = valid ? s[kbr][i] : -1e30f; s[kbr][i] = t; mraw = fmaxf(mraw, t);
        }
    mraw = fmaxf(mraw, __shfl_xor(mraw, 32));
    const float mx = fmaxf(mraw * sc, sink2);
    float sum = 0.f;
#pragma unroll
    for (int kbr = 0; kbr < 5; ++kbr)
#pragma unroll
        for (int i = 0; i < 16; ++i) { const float e = __builtin_amdgcn_exp2f(__builtin_fmaf(s[kbr][i], sc, -mx)); s[kbr][i] = e; sum += e; }
    sum += __shfl_xor(sum, 32);
    const float inv = 1.0f / (sum + __builtin_amdgcn_exp2f(sink2 - mx));
    f32x16 o[2];
#pragma unroll
    for (int dt = 0; dt < 2; ++dt)
#pragma unroll
        for (int i = 0; i < 16; ++i) o[dt][i] = 0.f;
#pragma unroll
    for (int kbr = 0; kbr < 5; ++kbr)
#pragma unroll
        for (int kk = 0; kk < 2; ++kk) {
            const bf16x8 pb = pack8(s[kbr], kk);
#pragma unroll
            for (int dt = 0; dt < 2; ++dt) {
                bf16x8 a; const int d = 32 * dt + r;
                if (SAMPLE) {
                    if (kbr < 4) { float f[8];
#pragma unroll
                        for (int j = 0; j < 8; ++j) { const int key = 32 * kbr + 16 * kk + 8 * (j >> 2) + 4 * g + (j & 3); f[j] = p.cv[((size_t)(b_s * 128 + key) * 4 + kvh) * 64 + d]; }
                        a = cvt8((f32x4){f[0], f[1], f[2], f[3]}, (f32x4){f[4], f[5], f[6], f[7]});
                    } else { u32x4 z = (u32x4){0u, 0u, 0u, 0u};
                        if (kk == 0 && g == 0) { const bf16_t* vp = Vb + (size_t)(TP + 4 * b_s) * 256 + kvh * 64 + d; z.x = (unsigned)vp[0] | ((unsigned)vp[256] << 16); z.y = (unsigned)vp[512] | ((unsigned)vp[768] << 16); }
                        a = __builtin_bit_cast(bf16x8, z); }
                } else {
                    const LAS bf16_t* vp = Vt + d * VT_STRIDE + 32 * (c + kbr) + 16 * kk + 4 * g;
                    const s16x4 lo = *(const LAS s16x4*)vp, hi = *(const LAS s16x4*)(vp + 8);
                    a = __builtin_shufflevector(lo, hi, 0, 1, 2, 3, 4, 5, 6, 7);
                }
                o[dt] = MFMA32(a, pb, o[dt]);
            }
        }
    if (!SAMPLE) {
#pragma unroll
        for (int dt = 0; dt < 2; ++dt)
#pragma unroll
            for (int i4 = 0; i4 < 4; ++i4) {
                const int col = head * 64 + 32 * dt + 8 * i4 + 4 * g;
                const f32x4 at = (f32x4){o[dt][4 * i4], o[dt][4 * i4 + 1], o[dt][4 * i4 + 2], o[dt][4 * i4 + 3]} * inv;
                *(u32x2*)(MIX + (size_t)tok * DM + col) = pk4(at);
            }
        return;
    }
#pragma unroll
    for (int dt = 0; dt < 2; ++dt) {
        u32x2 lsga[4], lbg[4], lu0[4]; f32x4 lu1[4], lu2[4], w0[4], w1[4], w2[4];
#pragma unroll
        for (int i4 = 0; i4 < 4; ++i4) {
            const int col = head * 64 + 32 * dt + 8 * i4 + 4 * g; const size_t off = (size_t)tok * DM + col;
            lsga[i4] = *(const u32x2*)(SGA + off); lbg[i4] = *(const u32x2*)(BG + off); lu0[i4] = *(const u32x2*)(U + off);
            lu1[i4] = itok >= 1 ? unpk4(*(const u32x2*)(U + off - DM)) : *(const f32x4*)(p.sconv + (size_t)b_s * 4096 + DM + col);
            lu2[i4] = itok >= 2 ? unpk4(*(const u32x2*)(U + off - 2 * DM)) : *(const f32x4*)(p.sconv + (size_t)b_s * 4096 + (size_t)itok * DM + col);
            w0[i4] = *(const f32x4*)(p.conv_w + col); w1[i4] = *(const f32x4*)(p.conv_w + DM + col); w2[i4] = *(const f32x4*)(p.conv_w + 2 * DM + col);
        }
#pragma unroll
        for (int i4 = 0; i4 < 4; ++i4) {
            const int col = head * 64 + 32 * dt + 8 * i4 + 4 * g; const size_t off = (size_t)tok * DM + col;
            const f32x4 at = (f32x4){o[dt][4 * i4], o[dt][4 * i4 + 1], o[dt][4 * i4 + 2], o[dt][4 * i4 + 3]} * inv;
            const f32x4 conv = w0[i4] * lu2[i4] + w1[i4] * lu1[i4] + w2[i4] * unpk4(lu0[i4]);
            *(u32x2*)(MIX + off) = pk4(unpk4(lsga[i4]) * at + unpk4(lbg[i4]) * conv);
        }
    }
}

DI void unpk8(u32x4 w, f32x4& lo, f32x4& hi) { lo = (f32x4){bf_lo(w.x), bf_hi(w.x), bf_lo(w.y), bf_hi(w.y)}; hi = (f32x4){bf_lo(w.z), bf_hi(w.z), bf_lo(w.w), bf_hi(w.w)}; }

constexpr int P2_CNT_OFF = 120000;
DI void p2_attention(const Params& p, LAS unsigned char* lds, int tid, int wid, int lane) {
    const bf16_t* Kb = (const bf16_t*)(p.ws + WS_K); const bf16_t* Vb = (const bf16_t*)(p.ws + WS_V);
    const bf16_t* U = (const bf16_t*)(p.ws + WS_U); const bf16_t* BG = (const bf16_t*)(p.ws + WS_BG); const bf16_t* SGA = (const bf16_t*)(p.ws + WS_SGA);
    bf16_t* MIX = (bf16_t*)(p.ws + WS_MIX);
    LAS bf16_t* Ks = (LAS bf16_t*)lds; LAS bf16_t* Vt = (LAS bf16_t*)(lds + VT_OFF);
    LAS unsigned* cnt = (LAS unsigned*)(lds + P2_CNT_OFF);
    int samp_next = blockIdx.x * 2;
    for (int item = blockIdx.x; item < 256; item += gridDim.x) {
        const int qb = item >> 2, kvh = item & 3;
        __syncthreads();
#pragma unroll
        for (int i = 0; i < 4; ++i) {
            const int e = tid + 512 * i, row = e >> 3, c8 = e & 7, tok = 128 * (qb - 1) + row;
            u32x4 kv = (u32x4){0u, 0u, 0u, 0u}, vv = (u32x4){0u, 0u, 0u, 0u};
            if (tok >= 0) { kv = *(const u32x4*)(Kb + (size_t)tok * 256 + kvh * 64 + 8 * c8); vv = *(const u32x4*)(Vb + (size_t)tok * 256 + kvh * 64 + 8 * c8); }
            *(LAS u32x4*)(Ks + row * KS_STRIDE + 8 * c8) = kv;
#pragma unroll
            for (int jj = 0; jj < 8; ++jj) Vt[(8 * c8 + jj) * VT_STRIDE + row] = (bf16_t)(vv[jj >> 1] >> (16 * (jj & 1)));
        }
        if (tid == 0) *cnt = 0u;
        __syncthreads();
        const int ns = (samp_next < 512) ? ((samp_next + 1 < 512) ? 2 : 1) : 0;
        for (;;) {
            unsigned t = 0; if (lane == 0) t = __hip_atomic_fetch_add(cnt, 1u, __ATOMIC_RELAXED, __HIP_MEMORY_SCOPE_WORKGROUP);
            t = __builtin_amdgcn_readfirstlane(t);
            if ((int)t >= ns + 32) break;
            if ((int)t < ns) { const int it = samp_next + (int)t; attn_chunk<true>(p, lds, 0, 0, it & 3, 0, it >> 2, lane); }
            else { const int pc = (int)t - ns; attn_chunk<false>(p, lds, qb, pc & 3, kvh, kvh * 8 + (pc >> 2), 0, lane); }
        }
        samp_next += gridDim.x * 2;
        asm volatile("s_waitcnt vmcnt(0)" ::: "memory");
        __syncthreads();
        __builtin_amdgcn_fence(__ATOMIC_ACQUIRE, "agent");
        {
            const int c8 = tid & 63, rbase = tid >> 6, col = kvh * 512 + 8 * c8;
            f32x4 w[3][2];
#pragma unroll
            for (int k = 0; k < 3; ++k) { w[k][0] = *(const f32x4*)(p.conv_w + k * DM + col); w[k][1] = *(const f32x4*)(p.conv_w + k * DM + col + 4); }
#pragma unroll
            for (int ib = 0; ib < 4; ++ib) {
                u32x4 la[4], ls[4], lb[4], l0[4], l1[4], l2[4];
#pragma unroll
                for (int ii = 0; ii < 4; ++ii) {
                    const int tok = 128 * qb + rbase + 8 * (4 * ib + ii); const size_t off = (size_t)tok * DM + col;
                    la[ii] = *(const u32x4*)(MIX + off); ls[ii] = *(const u32x4*)(SGA + off); lb[ii] = *(const u32x4*)(BG + off); l0[ii] = *(const u32x4*)(U + off);
                    l1[ii] = (u32x4){0u, 0u, 0u, 0u}; l2[ii] = (u32x4){0u, 0u, 0u, 0u};
                    if (tok >= 1) l1[ii] = *(const u32x4*)(U + off - DM);
                    if (tok >= 2) l2[ii] = *(const u32x4*)(U + off - 2 * DM);
                }
#pragma unroll
                for (int ii = 0; ii < 4; ++ii) {
                    const int tok = 128 * qb + rbase + 8 * (4 * ib + ii); const size_t off = (size_t)tok * DM + col;
                    f32x4 a0, a1, s0, s1, b0, b1, x0, x1, y0, y1, z0, z1;
                    unpk8(la[ii], a0, a1); unpk8(ls[ii], s0, s1); unpk8(lb[ii], b0, b1); unpk8(l0[ii], x0, x1); unpk8(l1[ii], y0, y1); unpk8(l2[ii], z0, z1);
                    const f32x4 m0 = s0 * a0 + b0 * (w[0][0] * z0 + w[1][0] * y0 + w[2][0] * x0);
                    const f32x4 m1 = s1 * a1 + b1 * (w[0][1] * z1 + w[1][1] * y1 + w[2][1] * x1);
                    u32x4 o; o.x = pk2(m0[0], m0[1]); o.y = pk2(m0[2], m0[3]); o.z = pk2(m1[0], m1[1]); o.w = pk2(m1[2], m1[3]);
                    *(u32x4*)(MIX + off) = o;
                }
            }
        }
    }
    for (int it = samp_next + (wid & 1); it < 512 && wid < 2; it += gridDim.x * 2) attn_chunk<true>(p, lds, 0, 0, it & 3, 0, it >> 2, lane);
}

DI void p3_reduce(const Params& p, int wid, int lane) {
    const float* PB = (const float*)(p.ws + WS_PB); bf16_t* A2 = (bf16_t*)(p.ws + WS_A2); const float* SSQ = (const float*)(p.ws + WS_SSQ); float* RSTD = (float*)(p.ws + WS_RSTD);
    for (int r = blockIdx.x * 8 + wid; r < TS; r += gridDim.x * 8) {
        const int row = TP + r; f32x4 y[8]; float s = 0.f;
#pragma unroll
        for (int j = 0; j < 8; ++j) { const size_t o = (size_t)r * DM + 256 * j + 4 * lane;
            y[j] = *(const f32x4*)(p.xs + o) + ((*(const f32x4*)(PB + o) + *(const f32x4*)(PB + (size_t)TS * DM + o)) + (*(const f32x4*)(PB + (size_t)2 * TS * DM + o) + *(const f32x4*)(PB + (size_t)3 * TS * DM + o)));
            s += (y[j][0] * y[j][0] + y[j][1] * y[j][1]) + (y[j][2] * y[j][2] + y[j][3] * y[j][3]); }
        s = wave_sum(s);
#pragma unroll
        for (int j = 0; j < 8; ++j) { const int col = 256 * j + 4 * lane; *(f32x4*)(p.out + (size_t)row * DM + col) = y[j];
            *(u32x2*)(A2 + (size_t)row * DM + col) = pk4(y[j] * *(const f32x4*)(p.norm_ffn + col)); }
        if (lane == 0) RSTD[row] = __builtin_amdgcn_rsqf(s * (1.0f / DM) + EPS);
    }
    for (int row = blockIdx.x * 512 + wid * 64 + lane; row < TP; row += gridDim.x * 512) {
        const f32x4* sp = (const f32x4*)(SSQ + (size_t)row * 32); f32x4 a = sp[0];
#pragma unroll
        for (int k = 1; k < 8; ++k) a += sp[k];
        RSTD[row] = __builtin_amdgcn_rsqf(((a[0] + a[1]) + (a[2] + a[3])) * (1.0f / DM) + EPS);
    }
}
DI void p5_reduce(const Params& p) {
    const float* PB = (const float*)(p.ws + WS_PB);
    for (int i = blockIdx.x * 512 + threadIdx.x; i < TS * DM / 4; i += gridDim.x * 512) { const size_t o = (size_t)i * 4; float* yp = p.out + (size_t)TP * DM + o;
        *(f32x4*)yp = *(const f32x4*)yp + ((*(const f32x4*)(PB + o) + *(const f32x4*)(PB + (size_t)TS * DM + o)) + (*(const f32x4*)(PB + (size_t)2 * TS * DM + o) + *(const f32x4*)(PB + (size_t)3 * TS * DM + o))); }
}

constexpr int LDS_BYTES = pg8::STAGE_BYTES + 16;

__global__ void __launch_bounds__(512, 2) fwd_megakernel(Params p) {
    extern __shared__ __attribute__((aligned(16))) unsigned char lds_raw[];
    LAS unsigned char* lds = (LAS unsigned char*)lds_raw;
    cg::grid_group grid = cg::this_grid();
    if (p.never) grid.sync();
    if (threadIdx.x < 4) ((LAS unsigned*)(lds + pg8::STAGE_BYTES))[threadIdx.x] = 0u;
    __syncthreads();
    const XcdBarrier xb = xcd_barrier_post((unsigned*)(p.ws + WS_BAR), (volatile LAS unsigned*)(lds + pg8::STAGE_BYTES));
    const int tid = threadIdx.x, wid = __builtin_amdgcn_readfirstlane(tid >> 6), lane = tid & 63;
    const int G = gridDim.x, bid = blockIdx.x;
    unsigned char* ws = p.ws;

    p0_prologue(p, lds, wid, lane);
    xcd_barrier(xb);
    {
        pg8::Gemm g{(const bf16_t*)(ws + WS_XN), (const bf16_t*)(ws + WS_WIN), MT, DIN, DM}; pg8::StaticOrder S; S.init(MT, DIN, G, bid);
        Epi1 E{(bf16_t*)(ws + WS_Q), (bf16_t*)(ws + WS_K), (bf16_t*)(ws + WS_V), (bf16_t*)(ws + WS_U), (bf16_t*)(ws + WS_BG), (bf16_t*)(ws + WS_SGA),
               p.q_norm, p.k_norm, (const float*)(ws + WS_COS), (const float*)(ws + WS_SIN), p.out};
        pg8::gemm_phase<Epi1, pg8::StaticOrder>(lds, g, S, E);
        {
            const int nfull = ((MT / 256) * (DIN / 256)) % G;
            if (nfull == 0) { p0_rest(p, lds, wid, lane, bid, G, 0); p0_rest(p, lds, wid, lane, bid, G, 1); }
            else if (bid >= nfull) { p0_rest(p, lds, wid, lane, bid - nfull, G - nfull, 0); p0_rest(p, lds, wid, lane, bid - nfull, G - nfull, 1); }
        }
    }
    xcd_barrier(xb);
    p2_attention(p, lds, tid, wid, lane);
    xcd_barrier(xb);
    {
        pg8::Gemm g{(const bf16_t*)(ws + WS_MIX), (const bf16_t*)(ws + WS_WOUT), MT, DM, DM}; pg8::SplitOrder S; S.init(DM, G, bid, DM / 64);
        Epi3 E{p.xp, p.xs, p.norm_ffn, p.out, (bf16_t*)(ws + WS_A2), (float*)(ws + WS_SSQ), (float*)(ws + WS_PB)};
        pg8::gemm_phase<Epi3, pg8::SplitOrder>(lds, g, S, E);
    }
    xcd_barrier(xb);
    p3_reduce(p, wid, lane);
    xcd_barrier(xb);
    {
        pg8::Gemm g{(const bf16_t*)(ws + WS_A2), (const bf16_t*)(ws + WS_WGU), MT, NGU, DM}; pg8::StaticOrder S; S.init(MT, NGU, G, bid);
        Epi4 E{(const float*)(ws + WS_RSTD), (bf16_t*)(ws + WS_HID)};
        pg8::gemm_phase<Epi4, pg8::StaticOrder>(lds, g, S, E);
        {   const int nfull = ((MT / 256) * (NGU / 256)) % G;
            if (nfull == 0) p0_rest(p, lds, wid, lane, bid, G, 2); else if (bid >= nfull) p0_rest(p, lds, wid, lane, bid - nfull, G - nfull, 2);
        }
    }
    xcd_barrier(xb);
    {
        pg8::Gemm g{(const bf16_t*)(ws + WS_HID), (const bf16_t*)(ws + WS_WDN), MT, DM, DFF}; pg8::SplitOrder S; S.init(DM, G, bid, DFF / 64);
        Epi5 E{p.out, (float*)(ws + WS_PB)};
        pg8::gemm_phase<Epi5, pg8::SplitOrder>(lds, g, S, E);
        {   const int nfull = S.total() % G;
            if (nfull == 0) cache_copy(p, bid, G); else if (bid >= nfull) cache_copy(p, bid - nfull, G - nfull);
        }
    }
    xcd_barrier(xb);
    p5_reduce(p);
}

extern "C" void kernel_launch(void* const* d_in, const int* in_sizes, int n_in, void* d_out, int out_size, void* d_ws, size_t ws_size, hipStream_t stream) {
    static int grid = 0;
    if (!grid) {
        int dev = 0, cus = 0, per_cu = 0;
        (void)hipGetDevice(&dev);
        (void)hipDeviceGetAttribute(&cus, hipDeviceAttributeMultiprocessorCount, dev);
        (void)hipFuncSetAttribute((const void*)fwd_megakernel, hipFuncAttributeMaxDynamicSharedMemorySize, LDS_BYTES);
        (void)hipOccupancyMaxActiveBlocksPerMultiprocessor(&per_cu, (const void*)fwd_megakernel, 512, LDS_BYTES);
        if (per_cu < 1) per_cu = 1;
        grid = cus * per_cu;
        if (ws_size < WS_END) fprintf(stderr, "kernel_launch: workspace too small (%zu < %zu)\n", ws_size, (size_t)WS_END);
    }
    Params p{};
    p.xp = (const float*)d_in[0]; p.xs = (const float*)d_in[1]; p.ck = (const float*)d_in[2]; p.cv = (const float*)d_in[3]; p.sconv = (const float*)d_in[4];
    p.norm_mix = (const float*)d_in[5]; p.w_in = (const float*)d_in[6]; p.q_norm = (const float*)d_in[7]; p.k_norm = (const float*)d_in[8]; p.sinks = (const float*)d_in[9];
    p.conv_w = (const float*)d_in[10]; p.w_out = (const float*)d_in[11]; p.norm_ffn = (const float*)d_in[12]; p.w_gu = (const float*)d_in[13]; p.w_dn = (const float*)d_in[14];
    p.out = (float*)d_out; p.ws = (unsigned char*)d_ws;
    p.never = 0;
    (void)hipMemsetAsync((char*)d_ws + WS_BAR, 0, 16384, stream);
    void* args[] = {&p};
    hipError_t e = hipLaunchCooperativeKernel((const void*)fwd_megakernel, dim3(grid), dim3(512), args, LDS_BYTES, stream);
    if (e != hipSuccess) fprintf(stderr, "cooperative launch failed: %s (grid %d)\n", hipGetErrorString(e), grid);
}
```
